# Optimizing an MI355X kernel written in HIP

```python
import math
import jax, jax.numpy as jnp
from jax import lax
import numpy as np

D_MODEL = 2048
BATCH = 8
SEQ = 2048
DEPTH = 1

HEAD_DIM = 128
A_HEADS = 12
DILATED_PATTERNS = ((128, 1), (512, 4), (2048, 16))
B_HEADS = 8
M_HEADS = 4
M_HEAD_DIM = 256
MEM_LEN = 256
A_WIDTH = A_HEADS * HEAD_DIM
B_WIDTH = B_HEADS * HEAD_DIM
M_WIDTH = M_HEADS * M_HEAD_DIM
N_BRANCH = 3
BLK = 128
REL_BUCKETS = 32
REL_MAX_DIST = 2048
EPS = 1e-6
IN_WIDTHS = (A_WIDTH, A_WIDTH, A_WIDTH, A_WIDTH,
             B_WIDTH, B_WIDTH, B_WIDTH, B_WIDTH, B_HEADS,
             M_WIDTH, M_WIDTH, N_BRANCH * D_MODEL)
IN_COLS = 4 * A_WIDTH + 4 * B_WIDTH + B_HEADS + 2 * M_WIDTH + N_BRANCH * D_MODEL

kernel_name = "hybrid_gated_dilated_fox_memory_block"


def _rmsnorm(x, g):
    xf = x.astype(jnp.float32)
    y = xf * lax.rsqrt(jnp.mean(xf * xf, axis=-1, keepdims=True) + EPS)
    return (y * g.astype(jnp.float32)).astype(x.dtype)


def _split_cols(a, widths):
    outs, off = [], 0
    for w in widths:
        outs.append(a[..., off:off + w])
        off += w
    return outs


def _rel_bucket(dist):
    max_exact = REL_BUCKETS // 2
    d_f = jnp.maximum(dist, 1).astype(jnp.float32)
    large = max_exact + (jnp.log(d_f / max_exact) / math.log(REL_MAX_DIST / max_exact)
                         * (REL_BUCKETS - max_exact)).astype(jnp.int32)
    large = jnp.minimum(large, REL_BUCKETS - 1)
    return jnp.where(dist < max_exact, dist, large)


def _dilated_pattern(q, k, v, rel_table, window, dil):
    B, S, H, d = q.shape
    L = S // dil
    w_sub = window // dil
    nb = -(-L // BLK)
    Lp = nb * BLK
    N = B * dil

    def to_classes(a):
        return a.reshape(B, L, dil, H, d).transpose(0, 2, 1, 3, 4).reshape(N, L, H, d)

    qs = jnp.pad(to_classes(q), ((0, 0), (0, Lp - L), (0, 0), (0, 0)))
    ks = jnp.pad(to_classes(k), ((0, 0), (BLK, Lp - L), (0, 0), (0, 0)))
    vs = jnp.pad(to_classes(v), ((0, 0), (BLK, Lp - L), (0, 0), (0, 0)))
    qb = qs.reshape(N, nb, BLK, H, d)
    kb = ks.reshape(N, nb + 1, BLK, H, d)
    vb = vs.reshape(N, nb + 1, BLK, H, d)
    kw = jnp.concatenate([kb[:, :-1], kb[:, 1:]], axis=2)
    vw = jnp.concatenate([vb[:, :-1], vb[:, 1:]], axis=2)

    logits = jnp.einsum('nbqhd,nbkhd->nbhqk', qb, kw,
                        preferred_element_type=jnp.float32) * (1.0 / math.sqrt(d))
    delta = jnp.arange(BLK)[:, None] - jnp.arange(2 * BLK)[None, :] + BLK
    key_pos = (jnp.arange(nb) * BLK)[:, None, None] + jnp.arange(2 * BLK)[None, None, :] - BLK
    valid = (delta >= 0)[None] & (delta <= w_sub)[None] & (key_pos >= 0)
    bucket = _rel_bucket(jnp.clip(delta, 0, w_sub) * dil)
    bias = jnp.transpose(rel_table[bucket], (2, 0, 1)).astype(jnp.float32)
    logits = jnp.where(valid[None, :, None], logits + bias[None, None], -jnp.inf)
    mx = jnp.max(logits, axis=-1, keepdims=True)
    p = jnp.exp(logits - mx)
    den = jnp.sum(p, axis=-1)
    o = jnp.einsum('nbhqk,nbkhd->nbqhd', p.astype(v.dtype), vw,
                   preferred_element_type=jnp.float32) / jnp.swapaxes(den, 2, 3)[..., None]
    lse = jnp.swapaxes(mx[..., 0] + jnp.log(den), 2, 3)

    def from_classes(a):
        tail = a.shape[3:]
        a = a.reshape((N, Lp) + tail)[:, :L]
        a = a.reshape((B, dil, L) + tail)
        return jnp.swapaxes(a, 1, 2).reshape((B, S) + tail)

    return from_classes(o), from_classes(lse)


def _dilated_mixture(q, k, v, rel_table):
    outs, lses = [], []
    for window, dil in DILATED_PATTERNS:
        o, lse = _dilated_pattern(q, k, v, rel_table, window, dil)
        outs.append(o)
        lses.append(lse)
    alpha = jax.nn.softmax(jnp.stack(lses, axis=0), axis=0)
    return jnp.einsum('pbsh,pbshd->bshd', alpha, jnp.stack(outs, axis=0))


def _forgetting_attention(q, k, v, log_f):
    B, S, H, d = q.shape
    qt, kt, vt = jnp.swapaxes(q, 1, 2), jnp.swapaxes(k, 1, 2), jnp.swapaxes(v, 1, 2)
    c = jnp.cumsum(jnp.swapaxes(log_f, 1, 2), axis=-1)
    kpos = jnp.arange(S)
    scale = 1.0 / math.sqrt(d)

    def block(n):
        start = n * BLK
        qn = lax.dynamic_slice_in_dim(qt, start, BLK, axis=2)
        cq = lax.dynamic_slice_in_dim(c, start, BLK, axis=2)
        s = jnp.einsum('bhqd,bhkd->bhqk', qn, kt, preferred_element_type=jnp.float32) * scale
        s = s + cq[..., :, None] - c[..., None, :]
        qpos = start + jnp.arange(BLK)
        s = jnp.where(kpos[None, :] <= qpos[:, None], s, -jnp.inf)
        p = jax.nn.softmax(s, axis=-1)
        return jnp.einsum('bhqk,bhkd->bqhd', p.astype(vt.dtype), vt)

    o = lax.map(block, jnp.arange(S // BLK))
    return jnp.swapaxes(o, 0, 1).reshape(B, S, H, d)


def _memory_attention(q, k, v):
    s = jnp.einsum('bshd,bmhd->bhsm', q, k, preferred_element_type=jnp.float32) * (1.0 / math.sqrt(q.shape[-1]))
    p = jax.nn.softmax(s, axis=-1)
    return jnp.einsum('bhsm,bmhd->bshd', p.astype(v.dtype), v)


def setup_inputs(seed: int = 0) -> dict:
    key = jax.random.key(seed)
    ks = jax.random.split(key, 20)
    f32 = jnp.float32

    def gain(k, shape):
        return 1.0 + 0.02 * jax.random.normal(k, shape, f32)

    return {
        "x": jax.random.normal(ks[0], (BATCH, SEQ, D_MODEL), f32),
        "mem": jax.random.normal(ks[1], (BATCH, MEM_LEN, D_MODEL), f32),
        "norm_g": gain(ks[2], (DEPTH, D_MODEL)),
        "mem_norm_g": gain(ks[3], (DEPTH, D_MODEL)),
        "w_in": jax.random.normal(ks[4], (DEPTH, D_MODEL, IN_COLS), f32) * D_MODEL ** -0.5,
        "b_forget": jnp.linspace(2.0, 6.0, B_HEADS, dtype=f32)[None]
                    + 0.1 * jax.random.normal(ks[5], (DEPTH, B_HEADS), f32),
        "b_gate": 0.02 * jax.random.normal(ks[6], (DEPTH, N_BRANCH, D_MODEL), f32),
        "rel_bias": 0.1 * jax.random.normal(ks[7], (REL_BUCKETS, A_HEADS), f32),
        "q_norm_a": gain(ks[8], (DEPTH, HEAD_DIM)),
        "k_norm_a": gain(ks[9], (DEPTH, HEAD_DIM)),
        "q_norm_b": gain(ks[10], (DEPTH, HEAD_DIM)),
        "k_norm_b": gain(ks[11], (DEPTH, HEAD_DIM)),
        "q_norm_m": gain(ks[12], (DEPTH, M_HEAD_DIM)),
        "k_norm_m": gain(ks[13], (DEPTH, M_HEAD_DIM)),
        "w_mem_kv": jax.random.normal(ks[14], (DEPTH, D_MODEL, 2 * M_WIDTH), f32) * D_MODEL ** -0.5,
        "w_proj_a": jax.random.normal(ks[15], (DEPTH, A_WIDTH, D_MODEL), f32) * A_WIDTH ** -0.5,
        "w_proj_b": jax.random.normal(ks[16], (DEPTH, B_WIDTH, D_MODEL), f32) * B_WIDTH ** -0.5,
        "w_proj_m": jax.random.normal(ks[17], (DEPTH, M_WIDTH, D_MODEL), f32) * M_WIDTH ** -0.5,
        "w_out": jax.random.normal(ks[18], (DEPTH, D_MODEL, D_MODEL), f32) * D_MODEL ** -0.5,
    }


def reference(x, mem, norm_g, mem_norm_g, w_in, b_forget, b_gate, rel_bias,
              q_norm_a, k_norm_a, q_norm_b, k_norm_b, q_norm_m, k_norm_m,
              w_mem_kv, w_proj_a, w_proj_b, w_proj_m, w_out):
    B, S, _ = x.shape
    M = mem.shape[1]
    for l in range(DEPTH):
        h = _rmsnorm(x, norm_g[l])
        proj = h @ w_in[l]
        qa, ka, va, za, qb, kb, vb, zb, fb, qm, zm, gl = _split_cols(proj, IN_WIDTHS)

        qa = _rmsnorm(qa.reshape(B, S, A_HEADS, HEAD_DIM), q_norm_a[l])
        ka = _rmsnorm(ka.reshape(B, S, A_HEADS, HEAD_DIM), k_norm_a[l])
        va = va.reshape(B, S, A_HEADS, HEAD_DIM)
        oa = _dilated_mixture(qa, ka, va, rel_bias).reshape(B, S, A_WIDTH).astype(x.dtype)
        ua = (oa * jax.nn.silu(za)) @ w_proj_a[l]

        qb = _rmsnorm(qb.reshape(B, S, B_HEADS, HEAD_DIM), q_norm_b[l])
        kb = _rmsnorm(kb.reshape(B, S, B_HEADS, HEAD_DIM), k_norm_b[l])
        vb = vb.reshape(B, S, B_HEADS, HEAD_DIM)
        log_f = jax.nn.log_sigmoid(fb.astype(jnp.float32) + b_forget[l].astype(jnp.float32))
        ob = _forgetting_attention(qb, kb, vb, log_f).reshape(B, S, B_WIDTH).astype(x.dtype)
        ub = (ob * jax.nn.silu(zb)) @ w_proj_b[l]

        mh = _rmsnorm(mem, mem_norm_g[l])
        km, vm = _split_cols(mh @ w_mem_kv[l], (M_WIDTH, M_WIDTH))
        qm = _rmsnorm(qm.reshape(B, S, M_HEADS, M_HEAD_DIM), q_norm_m[l])
        km = _rmsnorm(km.reshape(B, M, M_HEADS, M_HEAD_DIM), k_norm_m[l])
        vm = vm.reshape(B, M, M_HEADS, M_HEAD_DIM)
        om = _memory_attention(qm, km, vm).reshape(B, S, M_WIDTH).astype(x.dtype)
        um = (om * jax.nn.silu(zm)) @ w_proj_m[l]

        g = jax.nn.sigmoid(gl.reshape(B, S, N_BRANCH, D_MODEL) + b_gate[l])
        merged = g[:, :, 0] * ua + g[:, :, 1] * ub + g[:, :, 2] * um
        x = x + (merged @ w_out[l]).astype(x.dtype)
    return x
```

```cpp
#pragma clang diagnostic ignored "-Winline-asm"
#include <hip/hip_runtime.h>
#include <hip/hip_bf16.h>
#include <cstdio>
#include <cstdint>

#ifndef P3_ROT
#define P3_ROT 1
#endif
#ifndef DUP_EPI
#define DUP_EPI 0
#endif
#ifndef MK_N_LAUNCHES
#define MK_N_LAUNCHES 1
#endif

#define LAS __attribute__((address_space(3)))
#define GAS __attribute__((address_space(1)))
typedef unsigned short bf16_t;
typedef short bf16x8 __attribute__((ext_vector_type(8)));
typedef short s16x4 __attribute__((ext_vector_type(4)));
typedef float f32x4 __attribute__((ext_vector_type(4)));
typedef float f32x2 __attribute__((ext_vector_type(2)));
typedef float f32x16 __attribute__((ext_vector_type(16)));
typedef unsigned u32x4 __attribute__((ext_vector_type(4)));
typedef unsigned u32x2 __attribute__((ext_vector_type(2)));

constexpr int NB = 8, SEQ = 2048, DM = 2048, TOK = NB * SEQ;
constexpr int AW = 1536, BW = 1024, MW = 1024, MEML = 256, INC = 18440;
constexpr int N1 = 8704, N2 = 9728, KP = 3584;
constexpr float EPS = 1e-6f, LOG2E = 1.4426950408889634f;
constexpr float SCQ128 = 0.08838834764831845f * LOG2E, SCQ256 = 0.0625f * LOG2E;

constexpr size_t MiB = 1u << 20;
constexpr size_t WS_CTL = 0, CTL_ZERO_BYTES = 1 * MiB;
constexpr size_t WS_F = 1 * MiB;
constexpr size_t WS_CS = WS_F + 512 * 1024;
constexpr size_t WS_LSE = 2 * MiB;
constexpr size_t WS_KM = 5 * MiB, WS_VM = 9 * MiB;
constexpr size_t WS_WTP = 13 * MiB;
constexpr size_t WS_WTO = 27 * MiB;
constexpr size_t WS_WT2 = 35 * MiB;
constexpr size_t WS_WT1 = 73 * MiB;
constexpr size_t WS_WTKV = 107 * MiB;
constexpr size_t WS_MH = 115 * MiB;
constexpr size_t WS_OA2 = 73 * MiB;
constexpr size_t WS_H = 123 * MiB;
constexpr size_t WS_MRG = 123 * MiB;
constexpr size_t WS_QA = 187 * MiB, WS_KA = 235 * MiB, WS_VA = 283 * MiB;
constexpr size_t WS_KB = 331 * MiB, WS_VB = 363 * MiB;
constexpr size_t WS_G = 187 * MiB;
constexpr size_t WS_QB = 395 * MiB, WS_QM = 427 * MiB;
constexpr size_t WS_Y = 459 * MiB;
constexpr size_t WS_END = 571 * MiB;

constexpr int RING_BYTES = 131072;
constexpr int LDSCTL_OFF = RING_BYTES, MISC_OFF = LDSCTL_OFF + 320;
constexpr int PSUM_OFF = RING_BYTES + 1024;
constexpr int LDS_BYTES = 147456;

#define LDS_WAIT() asm volatile("s_waitcnt lgkmcnt(0)" ::: "memory")
#define VM_WAIT() asm volatile("s_waitcnt vmcnt(0)" ::: "memory")
#define RLX_AGENT __ATOMIC_RELAXED, __HIP_MEMORY_SCOPE_AGENT
typedef GAS unsigned gu32;

#define opaque_tid() opaque_tid_(wave0_)
__device__ __forceinline__ int opaque_tid_(int wave0) { int l; asm volatile("v_mbcnt_lo_u32_b32 %0, -1, 0\n\tv_mbcnt_hi_u32_b32 %0, -1, %0" : "=v"(l)); return wave0 * 64 + l; }
typedef __bf16 bf16x2_t __attribute__((ext_vector_type(2)));
__device__ __forceinline__ unsigned cvt_pk_bf16(float lo, float hi) { f32x2 v = {lo, hi}; bf16x2_t b = __builtin_convertvector(v, bf16x2_t); return __builtin_bit_cast(unsigned, b); }
template <int CTRL> __device__ __forceinline__ float dpp_f(float v) { return __int_as_float(__builtin_amdgcn_update_dpp(0, __float_as_int(v), CTRL, 0xF, 0xF, true)); }
__device__ __forceinline__ float xor16_add(float v) { auto r = __builtin_amdgcn_permlane16_swap(__float_as_uint(v), __float_as_uint(v), false, false); return __uint_as_float(r[0]) + __uint_as_float(r[1]); }
__device__ __forceinline__ float xor32_add(float v) { auto r = __builtin_amdgcn_permlane32_swap(__float_as_uint(v), __float_as_uint(v), false, false); return __uint_as_float(r[0]) + __uint_as_float(r[1]); }
__device__ __forceinline__ float bf_lo(unsigned w) { return __uint_as_float(w << 16); }
__device__ __forceinline__ float bf_hi(unsigned w) { return __uint_as_float(w & 0xffff0000u); }
__device__ __forceinline__ float fast_sigmoid(float x) { return __builtin_amdgcn_rcpf(1.0f + __builtin_amdgcn_exp2f(-x * LOG2E)); }

#define XB_TMO      128
#define XB_XCNT(j)  (256  + 64 * (j))
#define XB_XSUB(j)  (1280 + 64 * (j))
#define XB_XGEN(j)  (2304 + 64 * (j))
#define XB_TOP      3328
#define XB_TOPGEN   3392
#define XCD_BAR_WORDS 3456
#define XB_SPIN_CAP (1u << 18)
__device__ __forceinline__ unsigned xb_ld(unsigned* p)              { return __hip_atomic_load(p, __ATOMIC_RELAXED, __HIP_MEMORY_SCOPE_AGENT); }
__device__ __forceinline__ unsigned xb_add(unsigned* p, unsigned v) { return __hip_atomic_fetch_add(p, v, __ATOMIC_RELAXED, __HIP_MEMORY_SCOPE_AGENT); }
__device__ __forceinline__ unsigned xb_xcc_id() { return (unsigned)__builtin_amdgcn_s_getreg((3 << 11) | 20) & 0xFu; }
#define XB_SPIN(cond, bar) do { unsigned _sp = 0; while (cond) { __builtin_amdgcn_s_sleep(1); \
    if ((++_sp & 255u) == 0u) { if (xb_ld(&(bar)[XB_TMO])) break; if (_sp > XB_SPIN_CAP) { atomicAdd(&(bar)[XB_TMO], 1u); break; } } } } while (0)
struct XcdBarrier { unsigned* bar; unsigned x; volatile LAS unsigned* st; };
__device__ __forceinline__ XcdBarrier xcd_barrier_post(unsigned* bar, volatile LAS unsigned* st, const int wave0_) {
    XcdBarrier b; b.bar = bar; b.x = xb_xcc_id(); b.st = st;
    if (opaque_tid() == 0) (void)xb_add(&bar[XB_XCNT(b.x)], 1u);
    return b;
}
__device__ __forceinline__ void xcd_barrier_complete(unsigned* bar, unsigned x, unsigned& nloc, unsigned& nx) {
    const unsigned G = gridDim.x * gridDim.y * gridDim.z;
    unsigned sum, cnt, mine, sp = 0u;
    for (;;) {
        sum = 0u; cnt = 0u; mine = 0u;
#pragma unroll
        for (unsigned j = 0; j < 16; ++j) { const unsigned c = xb_ld(&bar[XB_XCNT(j)]); sum += c; cnt += (c > 0u) ? 1u : 0u; mine = (j == x) ? c : mine; }
        if (sum == G) break;
        __builtin_amdgcn_s_sleep(1);
        if ((++sp & 255u) == 0u) { if (xb_ld(&bar[XB_TMO])) break; if (sp > XB_SPIN_CAP) { atomicAdd(&bar[XB_TMO], 1u); break; } }
    }
    nloc = mine > 0u ? mine : 1u; nx = cnt > 0u ? cnt : 1u;
}
__device__ __forceinline__ void xcd_barrier(const XcdBarrier& b, const int wave0_) {
    asm volatile("s_waitcnt vmcnt(0)" ::: "memory");
    __syncthreads();
    if (opaque_tid() == 0) {
        unsigned* bar = b.bar;
        __builtin_amdgcn_s_waitcnt(0);
        unsigned nloc = b.st[0], nx = b.st[1];
        if (nloc == 0u) { xcd_barrier_complete(bar, b.x, nloc, nx); b.st[0] = nloc; b.st[1] = nx; }
        const unsigned old = xb_add(&bar[XB_XSUB(b.x)], 1u);
        const unsigned gen = old / nloc;
        if (old + 1u == (gen + 1u) * nloc) {
            __builtin_amdgcn_fence(__ATOMIC_RELEASE, "agent");
            asm volatile("s_waitcnt vmcnt(0)" ::: "memory");
            const unsigned og = xb_add(&bar[XB_TOP], 1u);
            const unsigned tg = og / nx;
            if (og + 1u == (tg + 1u) * nx) xb_add(&bar[XB_TOPGEN], 1u);
            else XB_SPIN(xb_ld(&bar[XB_TOPGEN]) == tg, bar);
            __builtin_amdgcn_fence(__ATOMIC_ACQUIRE, "agent");
            xb_add(&bar[XB_XGEN(b.x)], 1u);
            asm volatile("s_waitcnt vmcnt(0)" ::: "memory");
        } else {
            XB_SPIN(xb_ld(&bar[XB_XGEN(b.x)]) == gen, bar);
            __builtin_amdgcn_fence(__ATOMIC_ACQUIRE, "agent");
            asm volatile("s_waitcnt vmcnt(0)" ::: "memory");
        }
    }
    __syncthreads();
}

__device__ __forceinline__ void xcd_barrier_arrive(const XcdBarrier& b, const int wave0_) {
    asm volatile("s_waitcnt vmcnt(0)" ::: "memory");
    __syncthreads();
    if (opaque_tid() == 0) {
        unsigned* bar = b.bar;
        __builtin_amdgcn_s_waitcnt(0);
        unsigned nloc = b.st[0], nx = b.st[1];
        if (nloc == 0u) { xcd_barrier_complete(bar, b.x, nloc, nx); b.st[0] = nloc; b.st[1] = nx; }
        const unsigned old = xb_add(&bar[XB_XSUB(b.x)], 1u);
        const unsigned gen = old / nloc;
        unsigned role = 0u, tg = 0u;
        if (old + 1u == (gen + 1u) * nloc) {
            __builtin_amdgcn_fence(__ATOMIC_RELEASE, "agent");
            asm volatile("s_waitcnt vmcnt(0)" ::: "memory");
            const unsigned og = xb_add(&bar[XB_TOP], 1u);
            tg = og / nx;
            if (og + 1u == (tg + 1u) * nx) { xb_add(&bar[XB_TOPGEN], 1u); xb_add(&bar[XB_XGEN(b.x)], 1u); role = 2u; } else role = 1u;
        }
        b.st[2] = gen; b.st[3] = tg; b.st[4] = role;
    }
}
__device__ __forceinline__ void xcd_barrier_wait(const XcdBarrier& b, const int wave0_) {
    if (opaque_tid() == 0) {
        unsigned* bar = b.bar; const unsigned gen = b.st[2], tg = b.st[3], role = b.st[4];
        if (role == 1u) { XB_SPIN(xb_ld(&bar[XB_TOPGEN]) == tg, bar); __builtin_amdgcn_fence(__ATOMIC_ACQUIRE, "agent"); xb_add(&bar[XB_XGEN(b.x)], 1u); }
        else if (role == 0u) { XB_SPIN(xb_ld(&bar[XB_XGEN(b.x)]) == gen, bar); __builtin_amdgcn_fence(__ATOMIC_ACQUIRE, "agent"); }
        else __builtin_amdgcn_fence(__ATOMIC_ACQUIRE, "agent");
    }
    __syncthreads();
}

namespace pg8 {
constexpr int BM = 256, BK = 64, HALF = 128, HTB = HALF * BK * 2, STAGE_BYTES = 8 * HTB, NXCD = 8, WGM = 8;
__host__ __device__ __forceinline__ int lds_byte(int r, int c) { const int st = (r >> 4) * 2 + (c >> 5), rr = r & 15, cc = c & 31, ob = rr * 64 + cc * 2; return st * 1024 + (ob ^ (((ob >> 9) & 1) << 5)); }
__host__ __device__ __forceinline__ void stage_rc(int b, int& R, int& C) { const int st = b / 1024, sb = b % 1024, swz = sb ^ (((sb >> 9) & 1) << 5); R = (st >> 1) * 16 + swz / 64; C = (st & 1) * 32 + (swz % 64) / 2; }
__host__ __device__ __forceinline__ int perm32(int rho) { const int n = rho >> 4, i = rho & 15; return 8 * (i >> 2) + 4 * n + (i & 3); }

struct Unit { int pm, pn, koff, nt, first, tag; };
struct Gemm { const bf16_t* A; const bf16_t* Bt; int lda, ldb; };

__device__ __forceinline__ void tile_of(int L, int nM, int nN, int& pm, int& pn) {
    const int nwg = nM * nN; int wgid = L;
    { const int q = nwg / NXCD, r = nwg % NXCD, xcd = wgid % NXCD, off = wgid / NXCD; wgid = (xcd < r ? xcd * (q + 1) : r * (q + 1) + (xcd - r) * q) + off; }
    const int nig = WGM * nN, gid = wgid / nig, fm = gid * WGM, gsz = (nM - fm) < WGM ? (nM - fm) : WGM;
    pm = fm + ((wgid % nig) % gsz); pn = (wgid % nig) / gsz;
}
struct StaticOrder {
    int nM, nN, nwg, G, c, nt, nu, rot;
    __device__ __forceinline__ void init(int M, int N, int K, int G_, int c_, int rot_ = 0) { nM = M / BM; nN = N / BM; nwg = nM * nN; G = G_; c = c_; nt = K / BK;
        nu = c < nwg ? (nwg - 1 - c) / G + 1 : 0; rot = nu > 0 ? rot_ % nu : 0; }
    __device__ __forceinline__ bool next(int i, Unit& u) const {
        if (i >= nu) return false; int ir = i + rot; if (ir >= nu) ir -= nu;
        const long L = (long)ir * G + c;
        tile_of((int)L, nM, nN, u.pm, u.pn); u.koff = 0; u.nt = nt; u.first = 1; u.tag = 0; return true;
    }
};
struct Sub3Order {
    int nM, nN, nwg, G, c, perm;
    __device__ __forceinline__ void init(int M, int N, int G_, int c_, int perm_) { nM = M / BM; nN = N / BM; nwg = nM * nN; G = G_; c = c_; perm = perm_ % 3; }
    __device__ __forceinline__ bool next(int i, Unit& u) const {
        const int ti = i / 3, s = i - 3 * ti; const long L = (long)ti * G + c; if (L >= nwg) return false;
        tile_of((int)L, nM, nN, u.pm, u.pn);
        int br = s + perm; if (br >= 3) br -= 3; int brn = br + 1; if (brn >= 3) brn -= 3;
        u.koff = br == 0 ? 0 : (br == 1 ? 1536 : 2560); u.nt = br == 0 ? 24 : 16; u.first = s == 0; u.tag = br | (brn << 2) | ((s == 2) << 4); return true;
    }
};

template <class Epi, class Sched>
__device__ __forceinline__ void gemm_phase(LAS unsigned char* lds, const Gemm g, const Sched& S, const Epi& E, const int wave0_) {
    const int tid = opaque_tid(), wid = __builtin_amdgcn_readfirstlane(tid >> 6), lane = tid & 63, wr = wid >> 2, wc = wid & 3, fr = lane & 15, fq = lane >> 4;
    unsigned voffA[2], voffB[2];
#pragma unroll
    for (int i = 0; i < 2; ++i) { int R, C; stage_rc(tid * 16 + i * 8192, R, C); const int Rb = Epi::PERM ? ((R & ~31) + perm32(R & 31)) : R;
        voffA[i] = (unsigned)(R * g.lda + C) * 2u; voffB[i] = (unsigned)(Rb * g.ldb + C) * 2u; }
    const size_t kstep = (size_t)(BK * 2);
    const size_t hstepA = (size_t)HALF * g.lda * 2, hstepB = (size_t)HALF * g.ldb * 2;
    const size_t tstepA = 2 * hstepA, tstepB = 2 * hstepB;
    const unsigned ldsw = (unsigned)wid * 1024u;
    const int aoff = lds_byte(wr * 64 + fr, fq * 8), boff = lds_byte(wc * 32 + fr, fq * 8);
#define PG8_SA(b, h) (((b) * 2 + (h)) * HTB)
#define PG8_SB(b, h) ((4 + (b) * 2 + (h)) * HTB)
#define PG8_STAGE(bufoff, gbase, voff) do { _Pragma("unroll") for (int _i = 0; _i < 2; ++_i) \
        __builtin_amdgcn_global_load_lds((const unsigned*)((const char*)(gbase) + (voff)[_i]), (LAS unsigned*)(lds + (bufoff) + ldsw + _i * 8192), 16, 0, 0); } while (0)
#define PG8_LDA(dst, b, h) do { _Pragma("unroll") for (int m = 0; m < 4; ++m) _Pragma("unroll") for (int k = 0; k < 2; ++k) dst[m][k] = *(const LAS bf16x8*)(lds + PG8_SA(b, h) + aoff + m * 2048 + k * 1024); } while (0)
#define PG8_LDB(dst, b, h) do { _Pragma("unroll") for (int n = 0; n < 2; ++n) _Pragma("unroll") for (int k = 0; k < 2; ++k) dst[n][k] = *(const LAS bf16x8*)(lds + PG8_SB(b, h) + boff + n * 2048 + k * 1024); } while (0)
#define PG8_MMA(ai, bj, At, Bt) do { __builtin_amdgcn_s_setprio(1); _Pragma("unroll") for (int m = 0; m < 4; ++m) _Pragma("unroll") for (int n = 0; n < 2; ++n) _Pragma("unroll") for (int k = 0; k < 2; ++k) \
        acc[ai][bj][m][n] = __builtin_amdgcn_mfma_f32_16x16x32_bf16(Bt[n][k], At[m][k], acc[ai][bj][m][n], 0, 0, 0); __builtin_amdgcn_s_setprio(0); } while (0)
#define PG8_WAIT_V(n) asm volatile("s_waitcnt vmcnt(" #n ")" ::: "memory")
#define PG8_WAIT_L(n) asm volatile("s_waitcnt lgkmcnt(" #n ")" ::: "memory")
#define PG8_BAR __builtin_amdgcn_s_barrier()
#define PG8_SCHED __builtin_amdgcn_sched_barrier(0)
    Unit cur, nxt; int ui = 0;
    if (!S.next(0, cur)) return;
    f32x4 acc[2][2][4][2];
#pragma unroll
    for (int a = 0; a < 2; ++a)
#pragma unroll
        for (int b = 0; b < 2; ++b)
#pragma unroll
            for (int m = 0; m < 4; ++m)
#pragma unroll
                for (int n = 0; n < 2; ++n) acc[a][b][m][n] = (f32x4){0.f, 0.f, 0.f, 0.f};
    if constexpr (Epi::ACCINIT) { E.acc_init(acc, cur, wr, wc, fr, fq); cur.tag |= 256; }
    if constexpr (Epi::PREWAIT) E.pre_wait(wave0_);
    bf16x8 At[4][2], B0[2][2], B1[2][2];
    const char* cA = (const char*)g.A + (size_t)cur.pm * tstepA + (size_t)cur.koff * 2; const char* cB = (const char*)g.Bt + (size_t)cur.pn * tstepB + (size_t)cur.koff * 2;
    PG8_STAGE(PG8_SB(0, 0), cB, voffB); PG8_STAGE(PG8_SB(0, 1), cB + hstepB, voffB); PG8_STAGE(PG8_SA(0, 0), cA, voffA); PG8_STAGE(PG8_SA(0, 1), cA + hstepA, voffA);
    if (wr == 1) PG8_BAR;
    PG8_WAIT_V(2); PG8_BAR;
    PG8_STAGE(PG8_SB(1, 0), cB + kstep, voffB); PG8_STAGE(PG8_SA(1, 0), cA + kstep, voffA); PG8_STAGE(PG8_SB(1, 1), cB + hstepB + kstep, voffB);
    PG8_WAIT_V(6); PG8_BAR;
    for (;;) {
        const bool has_next = S.next(ui + 1, nxt);
        const char* nA = has_next ? (const char*)g.A + (size_t)nxt.pm * tstepA + (size_t)nxt.koff * 2 : cA; const char* nB = has_next ? (const char*)g.Bt + (size_t)nxt.pn * tstepB + (size_t)nxt.koff * 2 : cB;
        const int nt = cur.nt;
        for (int t = 0; t < nt; t += 2) {
            const bool last = (t == nt - 2);
            const char* a1 = cA + (size_t)(t + 1) * kstep;
            const char* a2 = last ? nA : cA + (size_t)(t + 2) * kstep; const char* b2 = last ? nB : cB + (size_t)(t + 2) * kstep;
            const char* a3 = a2 + kstep; const char* b3 = b2 + kstep;
            PG8_LDB(B0, 0, 0); PG8_LDB(B1, 0, 1); PG8_SCHED; PG8_LDA(At, 0, 0); PG8_STAGE(PG8_SA(1, 1), a1 + hstepA, voffA);
            PG8_WAIT_V(8); PG8_WAIT_L(0); PG8_BAR; PG8_MMA(0, 0, At, B0); PG8_MMA(0, 1, At, B1); PG8_BAR; PG8_SCHED;
            PG8_LDA(At, 0, 1); PG8_STAGE(PG8_SB(0, 0), b2, voffB); PG8_STAGE(PG8_SB(0, 1), b2 + hstepB, voffB); PG8_STAGE(PG8_SA(0, 0), a2, voffA);
            PG8_WAIT_V(8); PG8_WAIT_L(0); PG8_BAR; PG8_MMA(1, 0, At, B0); PG8_MMA(1, 1, At, B1); PG8_BAR; PG8_SCHED;
            PG8_LDB(B0, 1, 0); PG8_LDB(B1, 1, 1); PG8_SCHED; PG8_LDA(At, 1, 0); PG8_STAGE(PG8_SA(0, 1), a2 + hstepA, voffA);
            PG8_WAIT_V(8); PG8_WAIT_L(0); PG8_BAR; PG8_MMA(0, 0, At, B0); PG8_MMA(0, 1, At, B1); PG8_BAR; PG8_SCHED;
            PG8_LDA(At, 1, 1); PG8_STAGE(PG8_SB(1, 0), b3, voffB); PG8_STAGE(PG8_SB(1, 1), b3 + hstepB, voffB); PG8_STAGE(PG8_SA(1, 0), a3, voffA);
            PG8_WAIT_V(8); PG8_WAIT_L(0); PG8_BAR; PG8_MMA(1, 0, At, B0); PG8_MMA(1, 1, At, B1); PG8_BAR; PG8_SCHED;
        }
        if (wr == 0) PG8_BAR;
        if constexpr (Epi::LAZYBAR) { if (ui == 0) E.lazy_wait(wave0_); }
        E(acc, cur, wr, wc, fr, fq, wid, lane);
        if (Epi::DUP) E(acc, cur, wr, wc, fr, fq, wid, lane);
        if (!has_next) break;
        if (nxt.first) {
#pragma unroll
            for (int a = 0; a < 2; ++a)
#pragma unroll
                for (int b = 0; b < 2; ++b)
#pragma unroll
                    for (int m = 0; m < 4; ++m)
#pragma unroll
                        for (int n = 0; n < 2; ++n) acc[a][b][m][n] = (f32x4){0.f, 0.f, 0.f, 0.f};
        }
        cur = nxt; cA = nA; cB = nB; ++ui;
        if (wr == 1) PG8_BAR;
    }
    PG8_WAIT_V(0);
    PG8_BAR;
#undef PG8_SA
#undef PG8_SB
#undef PG8_STAGE
#undef PG8_LDA
#undef PG8_LDB
#undef PG8_MMA
#undef PG8_WAIT_V
#undef PG8_WAIT_L
#undef PG8_BAR
#undef PG8_SCHED
}
}

typedef f32x4 AccT[2][2][4][2];

struct EpiQKV {
    static constexpr bool PERM = true, DUP = (DUP_EPI == 1), LAZYBAR = false, ACCINIT = false, PREWAIT = false;
    unsigned char* ws; const float* gains[6]; int which;
    LAS unsigned char* lds;
    __device__ __forceinline__ void operator()(AccT& acc, const pg8::Unit& u, int wr, int wc, int fr, int fq, int wid, int lane) const {
        int mode, ldc, col; bf16_t* O; const float* gain = nullptr; float sc = 1.f; const int pn = u.pn;
        if (which == 0) {
            if (pn < 6)       { mode = 1; O = (bf16_t*)(ws + WS_QA); ldc = AW; col = pn * 256;        gain = gains[0]; sc = SCQ128; }
            else if (pn < 12) { mode = 1; O = (bf16_t*)(ws + WS_KA); ldc = AW; col = (pn - 6) * 256;  gain = gains[1]; }
            else if (pn < 18) { mode = 0; O = (bf16_t*)(ws + WS_VA); ldc = AW; col = (pn - 12) * 256; }
            else if (pn < 22) { mode = 1; O = (bf16_t*)(ws + WS_QB); ldc = BW; col = (pn - 18) * 256; gain = gains[2]; sc = SCQ128; }
            else if (pn < 26) { mode = 1; O = (bf16_t*)(ws + WS_KB); ldc = BW; col = (pn - 22) * 256; gain = gains[3]; }
            else if (pn < 30) { mode = 0; O = (bf16_t*)(ws + WS_VB); ldc = BW; col = (pn - 26) * 256; }
            else              { mode = 2; O = (bf16_t*)(ws + WS_QM); ldc = MW; col = (pn - 30) * 256; gain = gains[4]; sc = SCQ256; }
        } else {
            if (pn < 4)       { mode = 2; O = (bf16_t*)(ws + WS_KM); ldc = MW; col = pn * 256;        gain = gains[5]; }
            else              { mode = 0; O = (bf16_t*)(ws + WS_VM); ldc = MW; col = (pn - 4) * 256; }
        }
        float rs[2][4][2];
        if (mode != 0) {
            LAS float* P = (LAS float*)(lds + PSUM_OFF);
#pragma unroll
            for (int ai = 0; ai < 2; ++ai)
#pragma unroll
                for (int m = 0; m < 4; ++m)
#pragma unroll
                    for (int bj = 0; bj < 2; ++bj) {
                        const f32x4 a = acc[ai][bj][m][0], b = acc[ai][bj][m][1];
                        float s = (a[0] * a[0] + a[1] * a[1]) + (a[2] * a[2] + a[3] * a[3]) + (b[0] * b[0] + b[1] * b[1]) + (b[2] * b[2] + b[3] * b[3]);
                        s = xor16_add(s); s = xor32_add(s);
                        if (fq == 0) P[((ai * 128 + wr * 64 + m * 16 + fr) * 2 + bj) * 4 + wc] = s;
                    }
            asm volatile("s_waitcnt lgkmcnt(0)" ::: "memory"); __builtin_amdgcn_s_barrier(); asm volatile("" ::: "memory");
#pragma unroll
            for (int ai = 0; ai < 2; ++ai)
#pragma unroll
                for (int m = 0; m < 4; ++m) {
                    const LAS f32x4* pr = (const LAS f32x4*)(P + (ai * 128 + wr * 64 + m * 16 + fr) * 8);
                    const f32x4 s0 = pr[0], s1 = pr[1];
                    const float t0 = (s0[0] + s0[1]) + (s0[2] + s0[3]), t1 = (s1[0] + s1[1]) + (s1[2] + s1[3]);
                    if (mode == 1) { rs[ai][m][0] = sc * __builtin_amdgcn_rsqf(t0 * (1.f / 128.f) + EPS); rs[ai][m][1] = sc * __builtin_amdgcn_rsqf(t1 * (1.f / 128.f) + EPS); }
                    else { const float r = sc * __builtin_amdgcn_rsqf((t0 + t1) * (1.f / 256.f) + EPS); rs[ai][m][0] = r; rs[ai][m][1] = r; }
                }
        }
        const int row0 = u.pm * 256 + wr * 64 + fr, col0 = col + wc * 32 + 8 * fq;
        f32x4 gv[2][2];
#pragma unroll
        for (int bj = 0; bj < 2; ++bj)
#pragma unroll
            for (int n = 0; n < 2; ++n) {
                if (mode == 0) gv[bj][n] = (f32x4){1.f, 1.f, 1.f, 1.f};
                else { const int gc = (mode == 1 ? 0 : bj * 128) + wc * 32 + 8 * fq + 4 * n; gv[bj][n] = *(const f32x4*)(gain + gc); }
            }
#pragma unroll
        for (int ai = 0; ai < 2; ++ai)
#pragma unroll
            for (int m = 0; m < 4; ++m) { bf16_t* rowp = O + (size_t)(row0 + ai * 128 + m * 16) * ldc + col0;
#pragma unroll
                for (int bj = 0; bj < 2; ++bj) {
                    f32x4 v0 = acc[ai][bj][m][0] * gv[bj][0], v1 = acc[ai][bj][m][1] * gv[bj][1];
                    if (mode != 0) { const float r = rs[ai][m][bj]; v0 = v0 * r; v1 = v1 * r; }
                    u32x4 w; w.x = cvt_pk_bf16(v0[0], v0[1]); w.y = cvt_pk_bf16(v0[2], v0[3]); w.z = cvt_pk_bf16(v1[0], v1[1]); w.w = cvt_pk_bf16(v1[2], v1[3]);
                    *(u32x4*)(rowp + bj * 128) = w; } }
    }
};

struct EpiZG {
    static constexpr bool PERM = true, DUP = false, LAZYBAR = true, ACCINIT = false, PREWAIT = false;
    unsigned char* ws; const bf16_t* oa0; const bf16_t* oa1; const float* bgate;
    XcdBarrier wb; bool lazy;
    __device__ __forceinline__ void lazy_wait(const int wave0_) const { if (lazy) xcd_barrier_wait(wb, wave0_); }
    __device__ __forceinline__ void operator()(AccT& acc, const pg8::Unit& u, int wr, int wc, int fr, int fq, int wid, int lane) const {
        const int pn = u.pn; const int row0 = u.pm * 256 + wr * 64 + fr, cw = wc * 32 + 8 * fq;
        bf16_t* Y = (bf16_t*)(ws + WS_Y);
        if (pn < 6) {
            const bf16_t* oa2 = (const bf16_t*)(ws + WS_OA2); const float* lse = (const float*)(ws + WS_LSE);
#pragma unroll
            for (int ab = 0; ab < 4; ++ab) { const int ai = ab >> 1, m0 = (ab & 1) * 2;
                float L[2][2][3]; u32x4 P[2][2][3];
#pragma unroll
                for (int mm = 0; mm < 2; ++mm) { const int row = row0 + ai * 128 + (m0 + mm) * 16;
#pragma unroll
                    for (int bj = 0; bj < 2; ++bj) { const int head = 2 * pn + bj, c = pn * 256 + bj * 128 + cw;
                        L[mm][bj][0] = lse[(size_t)row * 12 + head]; L[mm][bj][1] = lse[((size_t)TOK + row) * 12 + head]; L[mm][bj][2] = lse[((size_t)2 * TOK + row) * 12 + head];
                        P[mm][bj][0] = *(const u32x4*)(oa0 + (size_t)row * AW + c); P[mm][bj][1] = *(const u32x4*)(oa1 + (size_t)row * AW + c); P[mm][bj][2] = *(const u32x4*)(oa2 + (size_t)row * AW + c); } }
                asm volatile("" ::: "memory");
#pragma unroll
                for (int mm = 0; mm < 2; ++mm) { const int m = m0 + mm, row = row0 + ai * 128 + m * 16;
#pragma unroll
                    for (int bj = 0; bj < 2; ++bj) { const int c = pn * 256 + bj * 128 + cw;
                        const float l0 = L[mm][bj][0], l1 = L[mm][bj][1], l2 = L[mm][bj][2];
                        const float mx = fmaxf(l0, fmaxf(l1, l2));
                        float w0 = __builtin_amdgcn_exp2f(l0 - mx), w1 = __builtin_amdgcn_exp2f(l1 - mx), w2 = __builtin_amdgcn_exp2f(l2 - mx);
                        const float inv = __builtin_amdgcn_rcpf(w0 + w1 + w2); w0 *= inv; w1 *= inv; w2 *= inv;
                        const u32x4 p0 = P[mm][bj][0], p1 = P[mm][bj][1], p2 = P[mm][bj][2];
                        const f32x4 z0 = acc[ai][bj][m][0], z1 = acc[ai][bj][m][1]; float y[8];
#pragma unroll
                        for (int j = 0; j < 4; ++j) { const unsigned a = p0[j], b = p1[j], d = p2[j];
                            const float olo = w0 * bf_lo(a) + w1 * bf_lo(b) + w2 * bf_lo(d), ohi = w0 * bf_hi(a) + w1 * bf_hi(b) + w2 * bf_hi(d);
                            const float zl = j < 2 ? z0[2 * j] : z1[2 * j - 4], zh = j < 2 ? z0[2 * j + 1] : z1[2 * j - 3];
                            y[2 * j] = olo * zl * fast_sigmoid(zl); y[2 * j + 1] = ohi * zh * fast_sigmoid(zh); }
                        u32x4 w; w.x = cvt_pk_bf16(y[0], y[1]); w.y = cvt_pk_bf16(y[2], y[3]); w.z = cvt_pk_bf16(y[4], y[5]); w.w = cvt_pk_bf16(y[6], y[7]);
                        *(u32x4*)(Y + (size_t)row * KP + c) = w; } }
                asm volatile("" ::: "memory"); }
        } else if (pn < 14) {
            const int cb = (pn < 10 ? AW + (pn - 6) * 256 : AW + BW + (pn - 10) * 256) + cw;
#pragma unroll
            for (int ai = 0; ai < 2; ++ai) { u32x4 P[4][2];
#pragma unroll
                for (int m = 0; m < 4; ++m) { const bf16_t* rowp = Y + (size_t)(row0 + ai * 128 + m * 16) * KP + cb;
#pragma unroll
                    for (int bj = 0; bj < 2; ++bj) P[m][bj] = *(const u32x4*)(rowp + bj * 128); }
                asm volatile("" ::: "memory");
#pragma unroll
                for (int m = 0; m < 4; ++m) { bf16_t* rowp = Y + (size_t)(row0 + ai * 128 + m * 16) * KP + cb;
#pragma unroll
                    for (int bj = 0; bj < 2; ++bj) { const u32x4 p = P[m][bj];
                        const f32x4 z0 = acc[ai][bj][m][0], z1 = acc[ai][bj][m][1]; float y[8];
#pragma unroll
                        for (int j = 0; j < 4; ++j) { const float zl = j < 2 ? z0[2 * j] : z1[2 * j - 4], zh = j < 2 ? z0[2 * j + 1] : z1[2 * j - 3];
                            y[2 * j] = bf_lo(p[j]) * zl * fast_sigmoid(zl); y[2 * j + 1] = bf_hi(p[j]) * zh * fast_sigmoid(zh); }
                        u32x4 w; w.x = cvt_pk_bf16(y[0], y[1]); w.y = cvt_pk_bf16(y[2], y[3]); w.z = cvt_pk_bf16(y[4], y[5]); w.w = cvt_pk_bf16(y[6], y[7]);
                        *(u32x4*)(rowp + bj * 128) = w; } }
                asm volatile("" ::: "memory"); }
        } else {
            const int idx = pn - 14, br = idx >> 3, cg = (idx & 7) * 256 + cw;
            bf16_t* G = (bf16_t*)(ws + WS_G) + (size_t)br * TOK * DM; const float* bg = bgate + br * DM + cg;
            f32x4 bv[2][2];
#pragma unroll
            for (int bj = 0; bj < 2; ++bj)
#pragma unroll
                for (int n = 0; n < 2; ++n) bv[bj][n] = *(const f32x4*)(bg + bj * 128 + 4 * n);
#pragma unroll
            for (int ai = 0; ai < 2; ++ai)
#pragma unroll
                for (int m = 0; m < 4; ++m) { bf16_t* rowp = G + (size_t)(row0 + ai * 128 + m * 16) * DM + cg;
#pragma unroll
                    for (int bj = 0; bj < 2; ++bj) { const f32x4 v0 = acc[ai][bj][m][0] + bv[bj][0], v1 = acc[ai][bj][m][1] + bv[bj][1];
                        u32x4 w; w.x = cvt_pk_bf16(fast_sigmoid(v0[0]), fast_sigmoid(v0[1])); w.y = cvt_pk_bf16(fast_sigmoid(v0[2]), fast_sigmoid(v0[3]));
                        w.z = cvt_pk_bf16(fast_sigmoid(v1[0]), fast_sigmoid(v1[1])); w.w = cvt_pk_bf16(fast_sigmoid(v1[2]), fast_sigmoid(v1[3]));
                        *(u32x4*)(rowp + bj * 128) = w; } }
        }
    }
};

struct EpiMerge {
    static constexpr bool PERM = true, DUP = false, LAZYBAR = false, ACCINIT = false, PREWAIT = false;
    unsigned char* ws;
    __device__ __forceinline__ void operator()(AccT& acc, const pg8::Unit& u, int wr, int wc, int fr, int fq, int wid, int lane) const {
        const int br = u.tag & 3, brn = (u.tag >> 2) & 3; const bool last = (u.tag >> 4) != 0;
        const int row0 = u.pm * 256 + wr * 64 + fr, c0 = u.pn * 256 + wc * 32 + 8 * fq;
        const bf16_t* Ga = (const bf16_t*)(ws + WS_G) + (size_t)br * TOK * DM;
        const bf16_t* Gb = last ? Ga : (const bf16_t*)(ws + WS_G) + (size_t)brn * TOK * DM;
        bf16_t* Mg = (bf16_t*)(ws + WS_MRG);
#pragma unroll
        for (int ab = 0; ab < 2; ++ab) { const int ai = ab, m0 = 0; u32x4 ga[4][2], gb[4][2];
#pragma unroll
            for (int mm = 0; mm < 4; ++mm) { const size_t off = (size_t)(row0 + ai * 128 + (m0 + mm) * 16) * DM + c0;
#pragma unroll
                for (int bj = 0; bj < 2; ++bj) { ga[mm][bj] = *(const u32x4*)(Ga + off + bj * 128); gb[mm][bj] = *(const u32x4*)(Gb + off + bj * 128); } }
            asm volatile("" ::: "memory");
#pragma unroll
            for (int mm = 0; mm < 4; ++mm) { const int m = m0 + mm; const size_t off = (size_t)(row0 + ai * 128 + m * 16) * DM + c0;
#pragma unroll
                for (int bj = 0; bj < 2; ++bj) { float f[8];
#pragma unroll
                    for (int j = 0; j < 4; ++j) { const float il = last ? 1.f : __builtin_amdgcn_rcpf(bf_lo(gb[mm][bj][j])), ih = last ? 1.f : __builtin_amdgcn_rcpf(bf_hi(gb[mm][bj][j]));
                        f[2 * j] = bf_lo(ga[mm][bj][j]) * il; f[2 * j + 1] = bf_hi(ga[mm][bj][j]) * ih; }
                    f32x4 v0 = acc[ai][bj][m][0], v1 = acc[ai][bj][m][1];
                    v0 = v0 * (f32x4){f[0], f[1], f[2], f[3]}; v1 = v1 * (f32x4){f[4], f[5], f[6], f[7]};
                    acc[ai][bj][m][0] = v0; acc[ai][bj][m][1] = v1;
                    if (last) { u32x4 w; w.x = cvt_pk_bf16(v0[0], v0[1]); w.y = cvt_pk_bf16(v0[2], v0[3]); w.z = cvt_pk_bf16(v1[0], v1[1]); w.w = cvt_pk_bf16(v1[2], v1[3]);
                        *(u32x4*)(Mg + off + bj * 128) = w; } } }
            asm volatile("" ::: "memory"); }
    }
};

struct EpiOut {
    static constexpr bool PERM = false, DUP = (DUP_EPI == 5), LAZYBAR = false, ACCINIT = true, PREWAIT = true;
    const float* x; float* out;
    XcdBarrier wb; bool lazy;
    __device__ __forceinline__ void pre_wait(const int wave0_) const { if (lazy) xcd_barrier_wait(wb, wave0_); }
    __device__ __forceinline__ void acc_init(AccT& acc, const pg8::Unit& u, int wr, int wc, int fr, int fq) const {
        const int row0 = u.pm * 256 + wr * 64 + fr, col0 = u.pn * 256 + wc * 32 + 4 * fq;
#pragma unroll
        for (int ai = 0; ai < 2; ++ai)
#pragma unroll
            for (int m = 0; m < 4; ++m) { const size_t off = (size_t)(row0 + ai * 128 + m * 16) * DM + col0;
#pragma unroll
                for (int bj = 0; bj < 2; ++bj)
#pragma unroll
                    for (int n = 0; n < 2; ++n) acc[ai][bj][m][n] = *(const f32x4*)(x + off + bj * 128 + n * 16); }
    }
    __device__ __forceinline__ void operator()(AccT& acc, const pg8::Unit& u, int wr, int wc, int fr, int fq, int wid, int lane) const {
        const int row0 = u.pm * 256 + wr * 64 + fr, col0 = u.pn * 256 + wc * 32 + 4 * fq;
        if (u.tag & 256) {
#pragma unroll
            for (int ai = 0; ai < 2; ++ai)
#pragma unroll
                for (int m = 0; m < 4; ++m) { const size_t off = (size_t)(row0 + ai * 128 + m * 16) * DM + col0;
#pragma unroll
                    for (int bj = 0; bj < 2; ++bj)
#pragma unroll
                        for (int n = 0; n < 2; ++n) *(f32x4*)(out + off + bj * 128 + n * 16) = acc[ai][bj][m][n]; }
            return;
        }
#pragma unroll
        for (int ab = 0; ab < 2; ++ab) { const int ai = ab, m0 = 0; f32x4 xv[4][2][2];
#pragma unroll
            for (int mm = 0; mm < 4; ++mm) { const size_t off = (size_t)(row0 + ai * 128 + (m0 + mm) * 16) * DM + col0;
#pragma unroll
                for (int bj = 0; bj < 2; ++bj)
#pragma unroll
                    for (int n = 0; n < 2; ++n) xv[mm][bj][n] = *(const f32x4*)(x + off + bj * 128 + n * 16); }
            asm volatile("" ::: "memory");
#pragma unroll
            for (int mm = 0; mm < 4; ++mm) { const size_t off = (size_t)(row0 + ai * 128 + (m0 + mm) * 16) * DM + col0;
#pragma unroll
                for (int bj = 0; bj < 2; ++bj)
#pragma unroll
                    for (int n = 0; n < 2; ++n) *(f32x4*)(out + off + bj * 128 + n * 16) = xv[mm][bj][n] + acc[ai][bj][m0 + mm][n]; }
            asm volatile("" ::: "memory"); }
    }
};

namespace att {
#define KSWZ(row, colB) ((row) * 256 + ((colB) ^ (((row) & 7) << 4)))
#define SBAR() __builtin_amdgcn_sched_barrier(0)
constexpr int SHM_V = 16384, SHM_K = 16384;
constexpr int V_OFF = 0, K_OFF = 49152, WS_OFF = 114688, TAB_OFF = 116736, CSL_OFF = 118784;
constexpr float THR2 = 8.f;
__device__ __forceinline__ int crow(int r, int hi) { return (r & 3) + 8 * (r >> 2) + 4 * hi; }
__device__ __forceinline__ int v_st(int k, int c) { const int kk = (k & ~0xC) | ((k & 4) << 1) | ((k & 8) >> 1); return ((kk >> 3) * 4 + (c >> 5)) * 512 + ((kk & 7) * 32 + (c & 31)) * 2; }
__device__ __forceinline__ int swap23(int k) { return (k & ~0xC) | ((k & 4) << 1) | ((k & 8) >> 1); }
#define GLDS(src, dst) asm volatile("s_mov_b32 m0, %1\n\tglobal_load_lds_dwordx4 %0, off" :: "v"(src), "s"((unsigned)(uintptr_t)(dst)) : "memory", "m0")
__device__ __forceinline__ int v_rd_base(int lane) { return ((lane & 3) << 3) | (((lane >> 2) & 3) << 6) | (((lane >> 4) & 1) << 5) | (((lane >> 5) & 1) << 8); }
constexpr int v_rd_off(int d0, int ks, int half) { return d0 * 512 + ks * 4096 + half * 2048; }

template <bool ACCUM>
__device__ __forceinline__ void qkt(f32x16& p0, f32x16& p1, const LAS char* Kimg, int r32, int hi, const bf16x8* qr) {
    if (!ACCUM) { p0 = f32x16{}; p1 = f32x16{}; }
    const LAS char* kb[4];
#pragma unroll
    for (int dd = 0; dd < 4; ++dd) kb[dd] = Kimg + KSWZ(r32, (dd * 16 + hi * 8) * 2);
    __builtin_amdgcn_s_setprio(1);
    bf16x8 f0[8], f1[8];
#pragma unroll
    for (int d0 = 0; d0 < 8; ++d0) { const LAS char* a = kb[d0 & 3] + (d0 >> 2) * 128; f0[d0] = *(const LAS bf16x8*)(a); f1[d0] = *(const LAS bf16x8*)(a + 32 * 256); }
#pragma unroll
    for (int d0 = 0; d0 < 8; ++d0) { p0 = __builtin_amdgcn_mfma_f32_32x32x16_bf16(f0[d0], qr[d0], p0, 0, 0, 0); p1 = __builtin_amdgcn_mfma_f32_32x32x16_bf16(f1[d0], qr[d0], p1, 0, 0, 0); }
    __builtin_amdgcn_sched_group_barrier(0x100, 4, 0);
#pragma unroll
    for (int d0 = 0; d0 < 6; ++d0) { __builtin_amdgcn_sched_group_barrier(0x008, 2, 0); __builtin_amdgcn_sched_group_barrier(0x100, 2, 0); }
    __builtin_amdgcn_sched_group_barrier(0x008, 4, 0);
    __builtin_amdgcn_s_setprio(0);
}
typedef short v4i16_t __attribute__((ext_vector_type(4)));
__device__ __forceinline__ s16x4 vtr(int addr) { return __builtin_bit_cast(s16x4, __builtin_amdgcn_ds_read_tr16_b64_v4i16((LAS v4i16_t*)(uintptr_t)(unsigned)addr)); }
__device__ __forceinline__ void pv_tile(f32x16* o, int vb, bf16x8 pa0, bf16x8 pa1, bf16x8 pa2, bf16x8 pa3) {
#define PV_D0(d0) do { constexpr int b_ = v_rd_off(d0, 0, 0); \
        const s16x4 l0 = vtr(vb + b_), h0 = vtr(vb + b_ + 2048), l1 = vtr(vb + b_ + 4096), h1 = vtr(vb + b_ + 6144), l2 = vtr(vb + b_ + 8192), h2 = vtr(vb + b_ + 10240), l3 = vtr(vb + b_ + 12288), h3 = vtr(vb + b_ + 14336); \
        o[d0] = __builtin_amdgcn_mfma_f32_32x32x16_bf16((bf16x8){l0[0], l0[1], l0[2], l0[3], h0[0], h0[1], h0[2], h0[3]}, pa0, o[d0], 0, 0, 0);   \
        o[d0] = __builtin_amdgcn_mfma_f32_32x32x16_bf16((bf16x8){l1[0], l1[1], l1[2], l1[3], h1[0], h1[1], h1[2], h1[3]}, pa1, o[d0], 0, 0, 0);   \
        o[d0] = __builtin_amdgcn_mfma_f32_32x32x16_bf16((bf16x8){l2[0], l2[1], l2[2], l2[3], h2[0], h2[1], h2[2], h2[3]}, pa2, o[d0], 0, 0, 0);   \
        o[d0] = __builtin_amdgcn_mfma_f32_32x32x16_bf16((bf16x8){l3[0], l3[1], l3[2], l3[3], h3[0], h3[1], h3[2], h3[3]}, pa3, o[d0], 0, 0, 0); } while (0)
    __builtin_amdgcn_s_setprio(1);
    PV_D0(0); PV_D0(1); PV_D0(2); PV_D0(3);
    __builtin_amdgcn_s_setprio(0);
#undef PV_D0
}
__device__ __forceinline__ void store_o_rows(bf16_t* rowp, const f32x16* o, const float rl) {
#pragma unroll
    for (int d0 = 0; d0 < 4; ++d0)
#pragma unroll
        for (int j = 0; j < 2; ++j) { const int a = 8 * j, b = 8 * j + 4;
            const unsigned A0 = cvt_pk_bf16(o[d0][a] * rl, o[d0][a + 1] * rl), A1 = cvt_pk_bf16(o[d0][a + 2] * rl, o[d0][a + 3] * rl);
            const unsigned B0 = cvt_pk_bf16(o[d0][b] * rl, o[d0][b + 1] * rl), B1 = cvt_pk_bf16(o[d0][b + 2] * rl, o[d0][b + 3] * rl);
            auto r0 = __builtin_amdgcn_permlane32_swap(A0, B0, false, false); auto r1 = __builtin_amdgcn_permlane32_swap(A1, B1, false, false);
            const u32x4 w = {r0[0], r1[0], r0[1], r1[1]};
            *(u32x4*)(rowp + d0 * 32 + j * 16) = w; }
}
__device__ __forceinline__ void softmax_tile(f32x16& p0, f32x16& p1, float& m_reg, float& l_reg, float& alpha, bf16x8& pa0, bf16x8& pa1, bf16x8& pa2, bf16x8& pa3) {
    float pmax = p0[0];
#pragma unroll
    for (int r = 1; r < 16; ++r) pmax = fmaxf(pmax, p0[r]);
#pragma unroll
    for (int r = 0; r < 16; ++r) pmax = fmaxf(pmax, p1[r]);
    { auto rr = __builtin_amdgcn_permlane32_swap(__float_as_uint(pmax), __float_as_uint(pmax), false, false);
      pmax = fmaxf(__uint_as_float(rr[0]), __uint_as_float(rr[1])); }
    float mn;
    if (__builtin_expect(__all(pmax - m_reg <= THR2), 1)) { mn = m_reg; alpha = 1.f; }
    else { mn = fmaxf(m_reg, pmax); alpha = __builtin_amdgcn_exp2f(m_reg - mn); m_reg = mn; }
    const f32x2 mn2 = {mn, mn}; f32x2 ps2a = {0.f, 0.f}, ps2b = {0.f, 0.f};
#pragma unroll
    for (int r = 0; r < 8; ++r) { f32x2 v = {p0[2 * r], p0[2 * r + 1]}; v = v - mn2; v[0] = __builtin_amdgcn_exp2f(v[0]); v[1] = __builtin_amdgcn_exp2f(v[1]); p0[2 * r] = v[0]; p0[2 * r + 1] = v[1]; ps2a += v; }
#pragma unroll
    for (int r = 0; r < 8; ++r) { f32x2 v = {p1[2 * r], p1[2 * r + 1]}; v = v - mn2; v[0] = __builtin_amdgcn_exp2f(v[0]); v[1] = __builtin_amdgcn_exp2f(v[1]); p1[2 * r] = v[0]; p1[2 * r + 1] = v[1]; ps2b += v; }
    ps2a += ps2b; float ps = ps2a[0] + ps2a[1];
    { auto rr = __builtin_amdgcn_permlane32_swap(__float_as_uint(ps), __float_as_uint(ps), false, false);
      ps = __uint_as_float(rr[0]) + __uint_as_float(rr[1]); }
    l_reg = l_reg * alpha + ps;
#define PK4(P, B_, OUT) do { unsigned a0 = cvt_pk_bf16(P[B_+0], P[B_+1]), a1 = cvt_pk_bf16(P[B_+2], P[B_+3]);                          \
        unsigned b0 = cvt_pk_bf16(P[B_+4], P[B_+5]), b1 = cvt_pk_bf16(P[B_+6], P[B_+7]);                                             \
        auto r0 = __builtin_amdgcn_permlane32_swap(a0, b0, false, false); auto r1 = __builtin_amdgcn_permlane32_swap(a1, b1, false, false); \
        u32x4 w = {r0[0], r1[0], r0[1], r1[1]}; OUT = *reinterpret_cast<bf16x8*>(&w); } while (0)
    PK4(p0, 0, pa0); PK4(p0, 8, pa1); PK4(p1, 0, pa2); PK4(p1, 8, pa3);
#undef PK4
}

struct AU {
    const bf16_t* Q; int ldq;
    const bf16_t* K; const bf16_t* V; int ldk;
    bf16_t* O; int ldo;
    float* lse;
    const float* cs;
    const float* relb;
    int hh;
    int v0;
    int Lm, Ls, dil;
    int kb0, NT;
};

__device__ __forceinline__ void pv_softmax(f32x16* o, const int vb, const bf16x8 q0, const bf16x8 q1, const bf16x8 q2, const bf16x8 q3,
                                           f32x16& p0, f32x16& p1, float& m_reg, float& l_reg, float& alpha, bf16x8& pa0, bf16x8& pa1, bf16x8& pa2, bf16x8& pa3) {
#define PVQ_D0(d0) do { constexpr int b_ = v_rd_off(d0, 0, 0); \
        const s16x4 l0 = vtr(vb + b_), h0 = vtr(vb + b_ + 2048), l1 = vtr(vb + b_ + 4096), h1 = vtr(vb + b_ + 6144), l2 = vtr(vb + b_ + 8192), h2 = vtr(vb + b_ + 10240), l3 = vtr(vb + b_ + 12288), h3 = vtr(vb + b_ + 14336); \
        o[d0] = __builtin_amdgcn_mfma_f32_32x32x16_bf16((bf16x8){l0[0], l0[1], l0[2], l0[3], h0[0], h0[1], h0[2], h0[3]}, q0, o[d0], 0, 0, 0);   \
        o[d0] = __builtin_amdgcn_mfma_f32_32x32x16_bf16((bf16x8){l1[0], l1[1], l1[2], l1[3], h1[0], h1[1], h1[2], h1[3]}, q1, o[d0], 0, 0, 0);   \
        o[d0] = __builtin_amdgcn_mfma_f32_32x32x16_bf16((bf16x8){l2[0], l2[1], l2[2], l2[3], h2[0], h2[1], h2[2], h2[3]}, q2, o[d0], 0, 0, 0);   \
        o[d0] = __builtin_amdgcn_mfma_f32_32x32x16_bf16((bf16x8){l3[0], l3[1], l3[2], l3[3], h3[0], h3[1], h3[2], h3[3]}, q3, o[d0], 0, 0, 0); } while (0)
    PVQ_D0(0); PVQ_D0(1); PVQ_D0(2); PVQ_D0(3);
#undef PVQ_D0
    float pmax = p0[0];
#pragma unroll
    for (int r = 1; r < 16; ++r) pmax = fmaxf(pmax, p0[r]);
#pragma unroll
    for (int r = 0; r < 16; ++r) pmax = fmaxf(pmax, p1[r]);
    { auto rr = __builtin_amdgcn_permlane32_swap(__float_as_uint(pmax), __float_as_uint(pmax), false, false);
      pmax = fmaxf(__uint_as_float(rr[0]), __uint_as_float(rr[1])); }
    const bool ok = __all(pmax - m_reg <= THR2);
    const float mn = ok ? m_reg : fmaxf(m_reg, pmax);
    alpha = __builtin_amdgcn_exp2f(m_reg - mn); m_reg = mn;
    const f32x2 mn2 = {mn, mn}; f32x2 ps2a = {0.f, 0.f}, ps2b = {0.f, 0.f};
#pragma unroll
    for (int r = 0; r < 8; ++r) { f32x2 v = {p0[2 * r], p0[2 * r + 1]}; v = v - mn2; v[0] = __builtin_amdgcn_exp2f(v[0]); v[1] = __builtin_amdgcn_exp2f(v[1]); p0[2 * r] = v[0]; p0[2 * r + 1] = v[1]; ps2a += v; }
#pragma unroll
    for (int r = 0; r < 8; ++r) { f32x2 v = {p1[2 * r], p1[2 * r + 1]}; v = v - mn2; v[0] = __builtin_amdgcn_exp2f(v[0]); v[1] = __builtin_amdgcn_exp2f(v[1]); p1[2 * r] = v[0]; p1[2 * r + 1] = v[1]; ps2b += v; }
    ps2a += ps2b; float ps = ps2a[0] + ps2a[1];
    { auto rr = __builtin_amdgcn_permlane32_swap(__float_as_uint(ps), __float_as_uint(ps), false, false);
      ps = __uint_as_float(rr[0]) + __uint_as_float(rr[1]); }
    l_reg = l_reg * alpha + ps;
#define PK4(P, B_, OUT) do { unsigned a0 = cvt_pk_bf16(P[B_+0], P[B_+1]), a1 = cvt_pk_bf16(P[B_+2], P[B_+3]);                          \
        unsigned b0 = cvt_pk_bf16(P[B_+4], P[B_+5]), b1 = cvt_pk_bf16(P[B_+6], P[B_+7]);                                             \
        auto r0 = __builtin_amdgcn_permlane32_swap(a0, b0, false, false); auto r1 = __builtin_amdgcn_permlane32_swap(a1, b1, false, false); \
        u32x4 w = {r0[0], r1[0], r0[1], r1[1]}; OUT = *reinterpret_cast<bf16x8*>(&w); } while (0)
    PK4(p0, 0, pa0); PK4(p0, 8, pa1); PK4(p1, 0, pa2); PK4(p1, 8, pa3);
#undef PK4
    __builtin_amdgcn_sched_group_barrier(0x100, 8, 0);
#pragma unroll
    for (int i = 0; i < 16; ++i) { __builtin_amdgcn_sched_group_barrier(0x008, 1, 0); __builtin_amdgcn_sched_group_barrier(0x002, 6, 0); __builtin_amdgcn_sched_group_barrier(0x400, 2, 0);
        __builtin_amdgcn_sched_group_barrier(0x100, 2, 0); }
}
template <int MODE>
__device__ __forceinline__ void attn_unit(LAS char* lds, const AU& u, const int wave0_) {
    constexpr int NKH = MODE == 2 ? 2 : 1;
    const int tid = opaque_tid(), wid = __builtin_amdgcn_readfirstlane(tid >> 6), lane = tid & 63, r32 = lane & 31, hi = lane >> 5;
    LAS char* V_lds = lds + V_OFF; LAS char* K_lds = lds + K_OFF;
    LAS float* tab = (LAS float*)(lds + TAB_OFF); LAS float* csl = (LAS float*)(lds + CSL_OFF);
    const int Lm = u.Lm, Ls = u.Ls, dil = u.dil;
#define TOKV(v) ((((v) & Lm) * dil) + ((v) >> Ls))
    const int vw = u.v0 + wid * 32, vq = vw + r32, qm = vq - 4 * hi;
    bf16x8 qr[8 * NKH];
    { const bf16_t* qp = u.Q + (size_t)TOKV(vq) * u.ldq + hi * 8;
#pragma unroll
      for (int d0 = 0; d0 < 8 * NKH; ++d0) qr[d0] = *(const bf16x8*)(qp + d0 * 16); }
    if (MODE == 0) {
        const int delta = tid - 160; float val = -__builtin_inff();
        if (delta >= 0 && delta <= 128) { const int dist = delta * dil; int bk = dist;
            if (dist >= 16) { bk = 16 + (int)(log2f((float)dist * 0.0625f) * (16.0f / 7.0f)); bk = bk > 31 ? 31 : bk; }
            val = u.relb[bk * 12] * LOG2E; }
        tab[tid] = val;
    }
    float m_reg = -1e30f, l_reg = 0.f; f32x16 o[4] = {};
    const int l4 = lane >> 4, kr0 = 8 * wid + l4, kc0 = ((lane & 15) ^ l4) * 8, kc1 = ((lane & 15) ^ (4 + l4)) * 8;
    const int vrow = swap23(8 * wid + ((lane & 31) >> 2)), vc0 = (lane >> 5) * 32 + (lane & 3) * 8;
    const int vb0 = (int)(uintptr_t)V_lds + v_rd_base(lane);
    float st_c = 0.f;
#define SLOAD(kbv, kbf, vbf) do { int a0_ = (kbv) + kr0, a1_ = a0_ + 4, av_ = (kbv) + vrow; a0_ = a0_ < 0 ? 0 : a0_; a1_ = a1_ < 0 ? 0 : a1_; av_ = av_ < 0 ? 0 : av_; \
        const bf16_t* k0_ = u.K + (size_t)TOKV(a0_) * u.ldk + kc0; const bf16_t* k1_ = u.K + (size_t)TOKV(a1_) * u.ldk + kc1; const bf16_t* v0_ = u.V + (size_t)TOKV(av_) * u.ldk + vc0; \
        LAS char* kd_ = K_lds + (kbf) * (NKH * SHM_K) + wid * 2048; LAS char* vd_ = V_lds + (vbf) * SHM_V + wid * 2048; \
        GLDS(k0_, kd_); GLDS(k1_, kd_ + 1024); if (NKH == 2) { GLDS(k0_ + 128, kd_ + SHM_K); GLDS(k1_ + 128, kd_ + SHM_K + 1024); } \
        GLDS(v0_, vd_); GLDS(v0_ + 64, vd_ + 1024); \
        if (MODE == 1) { if (tid < 64) st_c = u.cs[(kbv) + tid]; } } while (0)
#define SWRITE(kbf) do { if (MODE == 1) { if (tid < 64) csl[(kbf) * 64 + tid] = -st_c; } } while (0)
#define RESC(a) do { if (__any((a) < 1.f)) { _Pragma("unroll") for (int d_ = 0; d_ < 4; ++d_) _Pragma("unroll") for (int r = 0; r < 16; ++r) o[d_][r] *= (a); } } while (0)
    const bool need_lim = MODE == 0 && (vw & Lm) < 128; const int lim = vq & Lm;
    f32x16 p0, p1; bf16x8 pa0, pa1, pa2, pa3; float alpha;
    bf16x8 q0, q1, q2, q3;
    SLOAD(u.kb0, 0, 0); VM_WAIT(); SWRITE(0);
#pragma unroll
    for (int d0 = 0; d0 < 8 * NKH; ++d0) asm volatile("" :: "v"(qr[d0]));
    __syncthreads();
    bool act_prev = false; int vcur = 0, vprev = 0;
    for (int t = 0; t < u.NT; ++t) {
        int kbo_ = u.kb0 + 64 * t; asm volatile("" : "+s"(kbo_)); const int kb_ = kbo_;
        const int kbf = t & 1, vnext = vcur == 2 ? 0 : vcur + 1; const bool HN = t + 1 < u.NT;
        if (HN) SLOAD(kb_ + 64, kbf ^ 1, vnext);
        bool act_ = true;
        if (MODE == 0) act_ = (kb_ <= vw + 31) && (kb_ + 63 >= vw - 128);
        if (MODE == 1) act_ = (kb_ <= vw + 31);
        if (act_) {
            SBAR();
            if (MODE == 1) { const LAS f32x4* cp_ = (const LAS f32x4*)(csl + kbf * 64 + 4 * hi);
#pragma unroll
                for (int g_ = 0; g_ < 4; ++g_) { const f32x4 c0_ = cp_[2 * g_], c1_ = cp_[2 * g_ + 8];
#pragma unroll
                    for (int i_ = 0; i_ < 4; ++i_) { p0[4 * g_ + i_] = c0_[i_]; p1[4 * g_ + i_] = c1_[i_]; } }
                qkt<true>(p0, p1, K_lds + kbf * (NKH * SHM_K), r32, hi, qr); }
            else qkt<false>(p0, p1, K_lds + kbf * (NKH * SHM_K), r32, hi, qr);
            if (NKH == 2) qkt<true>(p0, p1, K_lds + kbf * (NKH * SHM_K) + SHM_K, r32, hi, qr + 8);
            const int dq_ = qm - kb_;
            if (MODE == 0) { const LAS float* tb_ = tab + (dq_ + 101);
#pragma unroll
                for (int r = 0; r < 16; ++r) { const int c_ = (r & 3) + 8 * (r >> 2); p0[r] += tb_[59 - c_]; p1[r] += tb_[27 - c_]; }
                if (need_lim) {
#pragma unroll
                    for (int r = 0; r < 16; ++r) { const int c_ = (r & 3) + 8 * (r >> 2);
                        if (dq_ - c_ > lim) p0[r] = -__builtin_inff(); if (dq_ - c_ - 32 > lim) p1[r] = -__builtin_inff(); } } }
            if (MODE == 1) {
                if (kb_ + 63 > vw) {
#pragma unroll
                    for (int r = 0; r < 16; ++r) { const int c_ = (r & 3) + 8 * (r >> 2);
                        if (dq_ - c_ < 0) p0[r] = -__builtin_inff(); if (dq_ - c_ - 32 < 0) p1[r] = -__builtin_inff(); } } }
            SBAR();
            if (act_prev) pv_softmax(o, vb0 + vprev * SHM_V, q0, q1, q2, q3, p0, p1, m_reg, l_reg, alpha, pa0, pa1, pa2, pa3);
            else softmax_tile(p0, p1, m_reg, l_reg, alpha, pa0, pa1, pa2, pa3);
            SBAR(); RESC(alpha); SBAR();
            q0 = pa0; q1 = pa1; q2 = pa2; q3 = pa3;
        } else if (act_prev) { SBAR(); pv_tile(o, vb0 + vprev * SHM_V, q0, q1, q2, q3); SBAR(); }
        if (HN) { VM_WAIT(); SWRITE(kbf ^ 1); }
        __syncthreads();
        act_prev = act_; vprev = vcur; vcur = vnext;
    }
    if (act_prev) { SBAR(); pv_tile(o, vb0 + vprev * SHM_V, q0, q1, q2, q3); }
    if (MODE == 0) { if (hi == 0) u.lse[(size_t)TOKV(vq) * 12] = m_reg + log2f(l_reg); }
    store_o_rows(u.O + (size_t)TOKV(vq) * u.ldo + 8 * hi, o, __builtin_amdgcn_rcpf(l_reg));
    __syncthreads();
#undef TOKV
#undef SLOAD
#undef SWRITE
#undef RESC
}
constexpr int A2_GRP = 65536, A2_WS = 132096, A2_TAB = 134144;
template <class Gen>
__device__ __forceinline__ void attn_a2_stream(LAS char* lds, const int NU, const Gen& gen, const float* relb_g, const int wave0_) {
    const int tid = opaque_tid(), wid = __builtin_amdgcn_readfirstlane(tid >> 6), lane = tid & 63, r32 = lane & 31, hi = lane >> 5;
    const int grp = wid >> 2;
    LAS char* V_lds = lds + grp * A2_GRP; LAS char* K_lds = V_lds + 32768;
    const int wg = wid & 3, l4 = lane >> 4, kr0 = 16 * wg + l4, kc0 = ((lane & 15) ^ l4) * 8, kc1 = ((lane & 15) ^ (4 + l4)) * 8;
    const int vr0 = swap23(16 * wg + ((lane & 31) >> 2)), vr1 = swap23(16 * wg + 8 + ((lane & 31) >> 2)), vc0 = (lane >> 5) * 32 + (lane & 3) * 8;
    const int vb0 = (int)(uintptr_t)V_lds + v_rd_base(lane);
#define TOKU(U, v) ((((v) & (U).Lm) * (U).dil) + ((v) >> (U).Ls))
#define SLOADU(U, kbv, bf) do { LAS char* kd_ = K_lds + (bf) * SHM_K + wg * 4096; LAS char* vd_ = V_lds + (bf) * SHM_V + wg * 4096; \
        _Pragma("unroll") for (int i_ = 0; i_ < 4; ++i_) { int a_ = (kbv) + kr0 + 4 * i_; a_ = a_ < 0 ? 0 : a_; GLDS((U).K + (size_t)TOKU(U, a_) * (U).ldk + ((i_ & 1) ? kc1 : kc0), kd_ + i_ * 1024); } \
        _Pragma("unroll") for (int h_ = 0; h_ < 2; ++h_) { int a_ = (kbv) + (h_ ? vr1 : vr0); a_ = a_ < 0 ? 0 : a_; const bf16_t* p_ = (U).V + (size_t)TOKU(U, a_) * (U).ldk + vc0; \
            GLDS(p_, vd_ + h_ * 2048); GLDS(p_ + 64, vd_ + h_ * 2048 + 1024); } } while (0)
#define LOADQU(U) do { const bf16_t* qp_ = (U).Q + (size_t)TOKU(U, (U).v0 + wid * 32 + r32) * (U).ldq + hi * 8; \
        _Pragma("unroll") for (int d0 = 0; d0 < 8; ++d0) qr[d0] = *(const bf16x8*)(qp_ + d0 * 16); } while (0)
#define TABU(U, tb) do { const int delta = tid - 160; float val = -__builtin_inff();          \
        if (delta >= 0 && delta <= 128) { const int dist = delta * (U).dil; int bk = dist; \
            if (dist >= 16) { bk = 16 + (int)(log2f((float)dist * 0.0625f) * (16.0f / 7.0f)); bk = bk > 31 ? 31 : bk; } \
            val = relb_l[bk * 12 + (U).hh] * LOG2E; } \
        ((LAS float*)(lds + A2_TAB))[(tb) * 512 + tid] = val; } while (0)
#define RESC(a) do { if (__any((a) < 1.f)) { _Pragma("unroll") for (int d_ = 0; d_ < 4; ++d_) _Pragma("unroll") for (int r = 0; r < 16; ++r) o[d_][r] *= (a); } } while (0)
    AU u; gen(0, u);
    LAS float* relb_l = (LAS float*)(lds + A2_TAB) + 1024;
    if (tid < 384) relb_l[tid] = relb_g[tid];
    __syncthreads();
    bf16x8 qr[8];
    LOADQU(u); TABU(u, 0); SLOADU(u, u.kb0 + 128 * grp + ((grp != 0 && u.NT == 4) ? 128 : 0), 0);
    for (int iu = 0; iu < NU; ++iu) {
        const bool hasn = iu + 1 < NU; AU un = u; if (hasn) gen(iu + 1, un);
        const LAS float* tab = (const LAS float*)(lds + A2_TAB) + (iu & 1) * 512;
        const int Lm = u.Lm;
        const int vw = u.v0 + wid * 32, vq = vw + r32, qm = vq - 4 * hi;
        const int cstart = vw - (vw & Lm);
        const bool need_lim = (vw & Lm) < 128; const int lim = vq & Lm;
        const int kbg = u.kb0 + 128 * grp;
        const int ntm = u.NT - 1, rot = (grp != 0 && u.NT == 4) ? 2 : 0;
        float m_reg = -1e30f, l_reg = 0.f; f32x16 o[4] = {};
        f32x16 p0, p1; bf16x8 pa0, pa1, pa2, pa3; float alpha;
        VM_WAIT();
#pragma unroll
        for (int d0 = 0; d0 < 8; ++d0) asm volatile("" :: "v"(qr[d0]));
        __syncthreads();
#define TILE2(t, BF, LAST) do { int kbo_ = kbg + 64 * (((t) + rot) & ntm); asm volatile("" : "+s"(kbo_)); const int kb_ = kbo_; \
        const bool shr_ = rot != 0 && (t) >= 2;                       \
        const LAS char* kimg_ = (shr_ ? lds + 32768 : K_lds) + (BF) * SHM_K; const int vimg_ = (shr_ ? vb0 - A2_GRP : vb0) + (BF) * SHM_V; \
        if (!(LAST)) { if (!(rot != 0 && (t) + 1 >= 2)) SLOADU(u, kbg + 64 * (((t) + 1 + rot) & ntm), (BF) ^ 1); } \
        else if (hasn) SLOADU(un, un.kb0 + 128 * grp + ((grp != 0 && un.NT == 4) ? 128 : 0), 0); \
        const bool act_ = (kb_ <= vw + 31) && (kb_ + 63 >= vw - 128) && (kb_ + 63 >= cstart); \
        if (act_) { \
            const int dq_ = qm - kb_; SBAR(); \
            { const LAS float* tb_ = tab + (dq_ + 101);                \
              _Pragma("unroll") for (int r = 0; r < 16; ++r) { const int c_ = (r & 3) + 8 * (r >> 2); p0[r] = tb_[59 - c_]; p1[r] = tb_[27 - c_]; } \
              qkt<true>(p0, p1, kimg_, r32, hi, qr); \
              if (need_lim) { _Pragma("unroll") for (int r = 0; r < 16; ++r) { const int c_ = (r & 3) + 8 * (r >> 2); \
                  if (dq_ - c_ > lim) p0[r] = -__builtin_inff(); if (dq_ - c_ - 32 > lim) p1[r] = -__builtin_inff(); } } } } \
        if ((LAST) && hasn) { SBAR(); LOADQU(un); TABU(un, (iu + 1) & 1); SBAR(); } \
        if (act_) { \
            SBAR(); softmax_tile(p0, p1, m_reg, l_reg, alpha, pa0, pa1, pa2, pa3); \
            RESC(alpha); SBAR(); \
            pv_tile(o, vimg_, pa0, pa1, pa2, pa3); } \
        if (!(LAST)) { VM_WAIT(); __syncthreads(); } } while (0)
        int t = 0;
        for (; t + 2 < u.NT; t += 2) { TILE2(t, 0, false); TILE2(t + 1, 1, false); }
        TILE2(t, 0, false); TILE2(t + 1, 1, true);
#undef TILE2
        if (hi == 0) u.lse[(size_t)TOKU(u, vq) * 12] = m_reg + log2f(l_reg);
        store_o_rows(u.O + (size_t)TOKU(u, vq) * u.ldo + 8 * hi, o, __builtin_amdgcn_rcpf(l_reg));
        u = un;
    }
    __syncthreads();
#undef TOKU
#undef SLOADU
#undef LOADQU
#undef TABU
#undef RESC
}
}

__device__ __forceinline__ unsigned f2bf(float f) { unsigned u = __builtin_bit_cast(unsigned, f); return (u + 0x7fffu + ((u >> 16) & 1u)) >> 16; }
__device__ __forceinline__ unsigned pk2(float lo, float hi) { return f2bf(lo) | (f2bf(hi) << 16); }
__device__ __forceinline__ float wave_sum(float v) {
    v += dpp_f<0xB1>(v); v += dpp_f<0x4E>(v);
    v += dpp_f<0x141>(v); v += dpp_f<0x140>(v);
    v = xor16_add(v); v = xor32_add(v);
    return v;
}
struct TrItem { const float* wp; size_t rs; bf16_t* dp; int ldt; };
__device__ __forceinline__ void tr_load(const TrItem& t, f32x4 (&v)[8]) {
#pragma unroll
    for (int i = 0; i < 8; ++i) v[i] = *(const f32x4*)(t.wp + (size_t)(8 * i) * t.rs);
}
__device__ __forceinline__ void tr_store(const TrItem& t, const f32x4 (&v)[8], LAS float* scr, int lane) {
    const int r = lane >> 3, c4 = lane & 7;
#pragma unroll
    for (int i = 0; i < 8; ++i) { LAS float* d = scr + (8 * i + r) * 33 + 4 * c4; d[0] = v[i][0]; d[1] = v[i][1]; d[2] = v[i][2]; d[3] = v[i][3]; }
    LDS_WAIT(); asm volatile("" ::: "memory");
    const int c = lane & 7;
#pragma unroll
    for (int j = 0; j < 4; ++j) { const int n = (lane >> 3) + 8 * j; const LAS float* s = scr + (8 * c) * 33 + n;
        u32x4 o; o.x = pk2(s[0 * 33], s[1 * 33]); o.y = pk2(s[2 * 33], s[3 * 33]); o.z = pk2(s[4 * 33], s[5 * 33]); o.w = pk2(s[6 * 33], s[7 * 33]);
        *(u32x4*)(t.dp + (size_t)(8 * j) * t.ldt) = o; }
    LDS_WAIT(); asm volatile("" ::: "memory");
}
struct Args { const float* in[19]; float* out; unsigned char* ws; int ph_lo, ph_hi; };
typedef __attribute__((address_space(4))) const Args* KArgP;
__device__ __forceinline__ KArgP fresh_args() { KArgP p = (KArgP)__builtin_amdgcn_kernarg_segment_ptr(); asm volatile("" : "+s"(p)); return p; }

__device__ __forceinline__ TrItem tr_decode(KArgP args, unsigned char* ws, int lane, int it) {
    const float* w_in = args->in[4];
    int r = it; const float* src; int ldw, ldt, nkb; bf16_t* dst;
    if (r < 4608) { src = w_in + 0; ldw = INC; dst = (bf16_t*)(ws + WS_WT1); ldt = DM; nkb = 32; }
    else if ((r -= 4608) < 1536) { src = w_in + 4608; ldw = INC; dst = (bf16_t*)(ws + WS_WT2); ldt = DM; nkb = 32; }
    else if ((r -= 1536) < 3072) { src = w_in + 6144; ldw = INC; dst = (bf16_t*)(ws + WS_WT1) + (size_t)4608 * DM; ldt = DM; nkb = 32; }
    else if ((r -= 3072) < 1024) { src = w_in + 9216; ldw = INC; dst = (bf16_t*)(ws + WS_WT2) + (size_t)1536 * DM; ldt = DM; nkb = 32; }
    else if ((r -= 1024) < 1024) { src = w_in + 10248; ldw = INC; dst = (bf16_t*)(ws + WS_WT1) + (size_t)7680 * DM; ldt = DM; nkb = 32; }
    else if ((r -= 1024) < 1024) { src = w_in + 11272; ldw = INC; dst = (bf16_t*)(ws + WS_WT2) + (size_t)2560 * DM; ldt = DM; nkb = 32; }
    else if ((r -= 1024) < 6144) { src = w_in + 12296; ldw = INC; dst = (bf16_t*)(ws + WS_WT2) + (size_t)3584 * DM; ldt = DM; nkb = 32; }
    else if ((r -= 6144) < 2048) { src = args->in[14]; ldw = 2048; dst = (bf16_t*)(ws + WS_WTKV); ldt = DM; nkb = 32; }
    else if ((r -= 2048) < 1536) { src = args->in[15]; ldw = DM; dst = (bf16_t*)(ws + WS_WTP); ldt = KP; nkb = 24; }
    else if ((r -= 1536) < 1024) { src = args->in[16]; ldw = DM; dst = (bf16_t*)(ws + WS_WTP) + 1536; ldt = KP; nkb = 16; }
    else if ((r -= 1024) < 1024) { src = args->in[17]; ldw = DM; dst = (bf16_t*)(ws + WS_WTP) + 2560; ldt = KP; nkb = 16; }
    else { r -= 1024; src = args->in[18]; ldw = DM; dst = (bf16_t*)(ws + WS_WTO); ldt = DM; nkb = 32; }
    const int nb = r / nkb, kb = r - nb * nkb, k0 = 64 * kb, n0 = 32 * nb;
    TrItem t; t.wp = src + (size_t)(k0 + (lane >> 3)) * ldw + n0 + 4 * (lane & 7); t.rs = (size_t)ldw;
    t.dp = dst + (size_t)(n0 + (lane >> 3)) * ldt + k0 + 8 * (lane & 7); t.ldt = ldt; return t;
}
#define TR_LD(V, T, idx) do { if ((idx) < tot_) { T = tr_decode(args, ws, lane, MAP_((idx))); tr_load(T, V); } } while (0)
#define TR_STREAM(first, total, stride, MAPF) do { const int tot_ = (total), st_ = (stride); int j_ = (first); \
        f32x4 va_[8], vb_[8], vc_[8], vd_[8]; TrItem ta_, tb_, tc_, td_; ta_.wp = nullptr; tb_ = ta_; tc_ = ta_; td_ = ta_; \
        auto MAP_ = [](int q_) { return MAPF(q_); }; \
        TR_LD(va_, ta_, j_); TR_LD(vb_, tb_, j_ + st_); TR_LD(vc_, tc_, j_ + 2 * st_); \
        while (j_ < tot_) { \
            TR_LD(vd_, td_, j_ + 3 * st_); tr_store(ta_, va_, scr, lane); j_ += st_; if (j_ >= tot_) break; \
            TR_LD(va_, ta_, j_ + 3 * st_); tr_store(tb_, vb_, scr, lane); j_ += st_; if (j_ >= tot_) break; \
            TR_LD(vb_, tb_, j_ + 3 * st_); tr_store(tc_, vc_, scr, lane); j_ += st_; if (j_ >= tot_) break; \
            TR_LD(vc_, tc_, j_ + 3 * st_); tr_store(td_, vd_, scr, lane); j_ += st_; } } while (0)
__device__ __forceinline__ int map_p0(int r) { if (r < 4608) return r; if ((r -= 4608) < 3072) return 6144 + r; if ((r -= 3072) < 1024) return 10240 + r; return 18432 + (r - 1024); }
__device__ __forceinline__ int map_p1(int r) { if (r < 1536) return 4608 + r; if ((r -= 1536) < 1024) return 9216 + r; if ((r -= 1024) < 1024) return 11264 + r; return 12288 + (r - 1024); }
__device__ __forceinline__ int map_p3(int r) { return 20480 + r; }
constexpr int P1_SIDE = 5632;
__device__ __forceinline__ int map_p1b(int r) { return map_p1(P1_SIDE + r); }
__global__ void __launch_bounds__(512, 2) fwd_kernel(Args args_) {
    extern __shared__ __attribute__((aligned(16))) unsigned char lds_raw[];
    LAS unsigned char* lds = (LAS unsigned char*)lds_raw;
    volatile LAS unsigned* MISC = (volatile LAS unsigned*)(lds + MISC_OFF);
    const int wave0_ = __builtin_amdgcn_readfirstlane((int)threadIdx.x >> 6);
    const int G = gridDim.x; const int bx = blockIdx.x; const int vcu = (G % 8 == 0) ? (bx % 8) * (G / 8) + bx / 8 : bx;
    gu32* ctl = (gu32*)(fresh_args()->ws + WS_CTL);
    for (int i = threadIdx.x; i < (LDS_BYTES - LDSCTL_OFF) / 4; i += 512) ((LAS unsigned*)(lds + LDSCTL_OFF))[i] = 0u;
    __syncthreads();
    XcdBarrier bar; bar.bar = (unsigned*)(ctl + 4096); bar.x = 0; bar.st = nullptr;
    const int lo = fresh_args()->ph_lo, hi_ = fresh_args()->ph_hi;
    const bool one_launch = (hi_ - lo) > 1;
    if (one_launch) bar = xcd_barrier_post((unsigned*)(ctl + 4096), MISC + 8, wave0_);
#ifndef ATT_DUP
#define ATT_DUP 0
#endif
#ifndef ATT_MASK
#define ATT_MASK 7
#endif
#ifndef PH_MASK
#define PH_MASK 63
#endif
#define IN(k) (((PH_MASK >> (k)) & 1) && lo <= (k) && (k) < hi_)
#define BOTH(k) (IN(k) && IN((k) + 1))
#define GRID_BAR() xcd_barrier(bar, wave0_)

    if (IN(0)) {
        const KArgP args = fresh_args(); unsigned char* ws = args->ws; const float* x = args->in[0];
        const int tid = opaque_tid(), lane = tid & 63, wave = __builtin_amdgcn_readfirstlane(tid >> 6);
        LAS float* scr = (LAS float*)(lds + wave * 16384);
        const int gw = vcu * 8 + wave, NGW = G * 8;
        const float* w_in = args->in[4];
        TR_STREAM(gw, 10752, NGW, map_p0);
        __syncthreads();
        LAS float* wfT = (LAS float*)lds;
        { f32x4 wa[4], wb[4];
#pragma unroll
          for (int j = 0; j < 4; ++j) { const float* p = w_in + (size_t)(tid + 512 * j) * INC + 10240; wa[j] = *(const f32x4*)p; wb[j] = *(const f32x4*)(p + 4); }
#pragma unroll
          for (int j = 0; j < 4; ++j) { const int k = tid + 512 * j;
#pragma unroll
              for (int e = 0; e < 4; ++e) { wfT[e * DM + k] = wa[j][e]; wfT[(4 + e) * DM + k] = wb[j][e]; } } }
        __syncthreads();
        const float* ng = args->in[2]; const float* bfg = args->in[5];
        { const int lane_h = opaque_tid() & 63;
#define lane lane_h
        bf16_t* H = (bf16_t*)(ws + WS_H); float* F = (float*)(ws + WS_F);
#pragma unroll 1
        for (int m = gw; m < TOK; m += NGW) {
            const f32x4* xr = (const f32x4*)(x + (size_t)m * DM) + lane;
            f32x4 v[8]; float s = 0.f;
#pragma unroll
            for (int j = 0; j < 8; ++j) { v[j] = xr[64 * j]; s += (v[j][0] * v[j][0] + v[j][1] * v[j][1]) + (v[j][2] * v[j][2] + v[j][3] * v[j][3]); }
            const float rstd = 1.0f / sqrtf(wave_sum(s) * (1.f / DM) + EPS);
            u32x2* o8 = (u32x2*)(H + (size_t)m * DM) + lane;
#pragma unroll
            for (int j = 0; j < 8; ++j) { const f32x4 gj = *((const f32x4*)ng + lane + 64 * j); v[j] = (v[j] * rstd) * gj;
                u32x2 w; w.x = pk2(v[j][0], v[j][1]); w.y = pk2(v[j][2], v[j][3]); o8[64 * j] = w; }
            float fb[8];
#pragma unroll
            for (int hh = 0; hh < 8; ++hh) fb[hh] = 0.f;
#pragma unroll
            for (int j = 0; j < 8; ++j) {
#pragma unroll
                for (int hh = 0; hh < 8; ++hh) { const f32x4 w4 = *((const LAS f32x4*)(wfT + hh * DM) + lane + 64 * j); fb[hh] += (v[j][0] * w4[0] + v[j][1] * w4[1]) + (v[j][2] * w4[2] + v[j][3] * w4[3]); }
                asm volatile("" ::: "memory"); }
#pragma unroll
            for (int hh = 0; hh < 8; ++hh) { fb[hh] = wave_sum(fb[hh]); __builtin_amdgcn_sched_barrier(0); }
            if (lane < 8) { float f = fb[0];
#pragma unroll
                for (int hh = 1; hh < 8; ++hh) f = lane == hh ? fb[hh] : f;
                const float xx = f + bfg[lane]; F[(size_t)m * 8 + lane] = fminf(xx, 0.f) - log1pf(expf(-fabsf(xx))); }
        }
#undef lane
        }
        const float* mem = args->in[1]; const float* mg = args->in[3]; bf16_t* MH = (bf16_t*)(ws + WS_MH);
        { const int lane_m = opaque_tid() & 63;
#define lane lane_m
#pragma unroll 1
        for (int m = gw; m < NB * MEML; m += NGW) {
            const f32x4* xr = (const f32x4*)(mem + (size_t)m * DM) + lane;
            f32x4 v[8]; float s = 0.f;
#pragma unroll
            for (int j = 0; j < 8; ++j) { v[j] = xr[64 * j]; s += (v[j][0] * v[j][0] + v[j][1] * v[j][1]) + (v[j][2] * v[j][2] + v[j][3] * v[j][3]); }
            const float rstd = 1.0f / sqrtf(wave_sum(s) * (1.f / DM) + EPS);
            u32x2* o8 = (u32x2*)(MH + (size_t)m * DM) + lane;
#pragma unroll
            for (int j = 0; j < 8; ++j) { const f32x4 gj = *((const f32x4*)mg + lane + 64 * j); v[j] = (v[j] * rstd) * gj;
                u32x2 w; w.x = pk2(v[j][0], v[j][1]); w.y = pk2(v[j][2], v[j][3]); o8[64 * j] = w; }
        }
#undef lane
        }
        if (BOTH(0)) xcd_barrier_arrive(bar, wave0_); else __syncthreads();
        { const KArgP args = fresh_args(); unsigned char* ws = args->ws;
          const int tid = opaque_tid(), lane = tid & 63, wave = __builtin_amdgcn_readfirstlane(tid >> 6);
          LAS float* scr = (LAS float*)(lds + wave * 16384);
          TR_STREAM(vcu * 8 + wave, 9728 - P1_SIDE, G * 8, map_p1b); }
        if (BOTH(0)) xcd_barrier_wait(bar, wave0_); else __syncthreads();
    }

    if (IN(1)) {
        const KArgP args = fresh_args(); unsigned char* ws = args->ws;
        if (bx >= 192 && bx < 256) {                 const int tid = opaque_tid(), lane = tid & 63, wave = __builtin_amdgcn_readfirstlane(tid >> 6);
            const int j = bx - 192, b = j >> 3, hh = j & 7;
            const float* F = (const float*)(ws + WS_F) + ((size_t)b * SEQ) * 8 + hh; float* CS = (float*)(ws + WS_CS) + (size_t)j * SEQ;
            LAS float* wt = (LAS float*)lds;
            float a0 = F[(size_t)(4 * tid + 0) * 8], a1 = F[(size_t)(4 * tid + 1) * 8], a2 = F[(size_t)(4 * tid + 2) * 8], a3 = F[(size_t)(4 * tid + 3) * 8];
            a1 += a0; a2 += a1; a3 += a2;
            float sc = a3;
#pragma unroll
            for (int o = 1; o < 64; o <<= 1) { const float t = __shfl_up(sc, o); if (lane >= o) sc += t; }
            if (lane == 63) wt[wave] = sc;
            __syncthreads();
            float base = 0.f;
            for (int w = 0; w < wave; ++w) base += wt[w];
            const float ex = base + sc - a3;
            CS[4 * tid + 0] = (ex + a0) * LOG2E; CS[4 * tid + 1] = (ex + a1) * LOG2E; CS[4 * tid + 2] = (ex + a2) * LOG2E; CS[4 * tid + 3] = (ex + a3) * LOG2E;
            __syncthreads();
            { LAS float* scr = (LAS float*)(lds + wave * 16384);
              TR_STREAM((bx - 192) * 8 + wave, P1_SIDE, 512, map_p1); }
            __syncthreads();
        }
        EpiQKV E; E.ws = ws; E.gains[0] = args->in[8]; E.gains[1] = args->in[9]; E.gains[2] = args->in[10]; E.gains[3] = args->in[11]; E.gains[4] = args->in[12]; E.gains[5] = args->in[13]; E.lds = lds;
        { E.which = 0; pg8::Gemm g{(const bf16_t*)(ws + WS_H), (const bf16_t*)(ws + WS_WT1), DM, DM}; pg8::StaticOrder S; S.init(TOK, N1, DM, G, bx);
          pg8::gemm_phase<EpiQKV, pg8::StaticOrder>(lds, g, S, E, wave0_); }
        { E.which = 1; pg8::Gemm g{(const bf16_t*)(ws + WS_MH), (const bf16_t*)(ws + WS_WTKV), DM, DM}; pg8::StaticOrder S; S.init(NB * MEML, 2048, DM, G, (bx + 128) % G);
          pg8::gemm_phase<EpiQKV, pg8::StaticOrder>(lds, g, S, E, wave0_); }
        if (BOTH(1)) xcd_barrier_arrive(bar, wave0_); else __syncthreads();
        { const KArgP args = fresh_args(); unsigned char* ws = args->ws;
          const int tid = opaque_tid(), lane = tid & 63, wave = __builtin_amdgcn_readfirstlane(tid >> 6);
          LAS float* scr = (LAS float*)(lds + wave * 16384);
          TR_STREAM(vcu * 8 + wave, 5632, G * 8, map_p3); }
        if (BOTH(1)) xcd_barrier_wait(bar, wave0_); else __syncthreads();
    }

    if (IN(2)) {
        const KArgP args = fresh_args(); unsigned char* ws = args->ws;
        LAS char* al = (LAS char*)lds;
        const float* CS = (const float*)(ws + WS_CS);
        for (int v = vcu; v < 256; v += G) {
            { const int bh = v >> 2, s = v & 3, b = bh >> 3, h = bh & 7;
              for (int pass = 0; pass < 2; ++pass) { const int qb = pass ? 7 - s : s;
                  att::AU u; u.Q = (const bf16_t*)(ws + WS_QB) + (size_t)b * SEQ * BW + h * 128; u.ldq = BW;
                  u.K = (const bf16_t*)(ws + WS_KB) + (size_t)b * SEQ * BW + h * 128; u.V = (const bf16_t*)(ws + WS_VB) + (size_t)b * SEQ * BW + h * 128; u.ldk = BW;
                  u.O = (bf16_t*)(ws + WS_Y) + (size_t)b * SEQ * KP + AW + h * 128; u.ldo = KP; u.lse = nullptr; u.cs = CS + (size_t)(b * 8 + h) * SEQ; u.relb = nullptr;
                  u.v0 = qb * 256; u.Lm = 0x3fffffff; u.Ls = 30; u.dil = 1; u.kb0 = 0; u.NT = 4 * (qb + 1);
                  if (ATT_MASK & 1) att::attn_unit<1>(al, u, wave0_);
                  if (ATT_DUP & 1) att::attn_unit<1>(al, u, wave0_); } }
            { const int b = v >> 5, h = (v >> 3) & 3, qb = v & 7;
              for (int e = 0; e < 2; ++e) {
                  att::AU u; u.Q = (const bf16_t*)(ws + WS_QM) + (size_t)b * SEQ * MW + h * 256; u.ldq = MW;
                  u.K = (const bf16_t*)(ws + WS_KM) + (size_t)b * MEML * MW + h * 256; u.V = (const bf16_t*)(ws + WS_VM) + (size_t)b * MEML * MW + h * 256 + e * 128; u.ldk = MW;
                  u.O = (bf16_t*)(ws + WS_Y) + (size_t)b * SEQ * KP + AW + BW + h * 256 + e * 128; u.ldo = KP; u.lse = nullptr; u.cs = nullptr; u.relb = nullptr;
                  u.v0 = qb * 256; u.Lm = 0x3fffffff; u.Ls = 30; u.dil = 1; u.kb0 = 0; u.NT = 4;
                  if (ATT_MASK & 2) att::attn_unit<2>(al, u, wave0_);
                  if (ATT_DUP & 2) att::attn_unit<2>(al, u, wave0_); } }
            { float* const outp = args->out; const float* const relbp = args->in[7];
              auto genA = [=](int i, att::AU& u) {
                const int b = v >> 5, c_ = v & 31, w_ = (i < 7 ? 32 * i + c_ : 224 + (c_ - 16) * 4 + (i - 7)), h = w_ / 24, rem_ = w_ - 24 * h, pat = rem_ >> 3, vb = rem_ & 7;
                u.Q = (const bf16_t*)(ws + WS_QA) + (size_t)b * SEQ * AW + h * 128; u.ldq = AW;
                u.K = (const bf16_t*)(ws + WS_KA) + (size_t)b * SEQ * AW + h * 128; u.V = (const bf16_t*)(ws + WS_VA) + (size_t)b * SEQ * AW + h * 128; u.ldk = AW;
                bf16_t* ob = pat == 0 ? (bf16_t*)outp : (pat == 1 ? (bf16_t*)outp + (size_t)TOK * AW : (bf16_t*)(ws + WS_OA2));
                u.O = ob + (size_t)b * SEQ * AW + h * 128; u.ldo = AW;
                u.lse = (float*)(ws + WS_LSE) + ((size_t)pat * TOK + (size_t)b * SEQ) * 12 + h; u.cs = nullptr; u.relb = relbp + h; u.hh = h;
                u.v0 = vb * 256; u.Ls = pat == 0 ? 11 : (pat == 1 ? 9 : 7); u.Lm = (1 << u.Ls) - 1; u.dil = pat == 0 ? 1 : (pat == 1 ? 4 : 16);
                if (pat == 2) { u.kb0 = u.v0; u.NT = 2; } else { u.kb0 = u.v0 - 128; u.NT = 4; }
              };
              const int nuA = (v & 31) >= 16 ? 11 : 7;
              if (ATT_MASK & 4) att::attn_a2_stream(al, nuA, genA, relbp, wave0_);
              if (ATT_DUP & 4) att::attn_a2_stream(al, nuA, genA, relbp, wave0_); }
        }
        if (BOTH(2)) xcd_barrier_arrive(bar, wave0_);
    }

    if (IN(3)) {
        const KArgP args = fresh_args(); unsigned char* ws = args->ws;
        EpiZG E; E.ws = ws; E.oa0 = (const bf16_t*)args->out; E.oa1 = (const bf16_t*)args->out + (size_t)TOK * AW; E.bgate = args->in[6]; E.wb = bar; E.lazy = BOTH(2);
        pg8::Gemm g{(const bf16_t*)(ws + WS_H), (const bf16_t*)(ws + WS_WT2), DM, DM}; pg8::StaticOrder S; S.init(TOK, N2, DM, G, bx, P3_ROT * (bx & 7));
        pg8::gemm_phase<EpiZG, pg8::StaticOrder>(lds, g, S, E, wave0_);
        if (BOTH(3)) GRID_BAR();
    }

    if (IN(4)) {
        const KArgP args = fresh_args(); unsigned char* ws = args->ws;
        EpiMerge E; E.ws = ws;
        pg8::Gemm g{(const bf16_t*)(ws + WS_Y), (const bf16_t*)(ws + WS_WTP), KP, KP}; pg8::Sub3Order S; S.init(TOK, DM, G, bx, bx & 7);
        pg8::gemm_phase<EpiMerge, pg8::Sub3Order>(lds, g, S, E, wave0_);
        if (BOTH(4)) xcd_barrier_arrive(bar, wave0_);
    }

    if (IN(5)) {
        const KArgP args = fresh_args(); unsigned char* ws = args->ws; const float* x = args->in[0];
        EpiOut E; E.x = x; E.out = args->out; E.wb = bar; E.lazy = BOTH(4);
        pg8::Gemm g{(const bf16_t*)(ws + WS_MRG), (const bf16_t*)(ws + WS_WTO), DM, DM}; pg8::StaticOrder S; S.init(TOK, DM, DM, G, bx);
        pg8::gemm_phase<EpiOut, pg8::StaticOrder>(lds, g, S, E, wave0_);
    }
#undef IN
#undef BOTH
#undef GRID_BAR
}

extern "C" void kernel_launch(void* const* d_in, const int* in_sizes, int n_in, void* d_out, int out_size, void* d_ws, size_t ws_size, hipStream_t stream) {
    static int grid = 0;
    if (grid == 0) {
        if (n_in != 19 || in_sizes[0] != TOK * DM || out_size != TOK * DM || ws_size < WS_END) {
            fprintf(stderr, "kernel_launch: shape/workspace mismatch (n_in %d, in0 %d, out %d, ws %zu, need %zu)\n", n_in, n_in > 0 ? in_sizes[0] : -1, out_size, ws_size, (size_t)WS_END); grid = -1; return; }
        int dev = 0, cus = 0;
        if (hipGetDevice(&dev) != hipSuccess || hipDeviceGetAttribute(&cus, hipDeviceAttributeMultiprocessorCount, dev) != hipSuccess) { grid = -1; return; }
        if (hipFuncSetAttribute((const void*)fwd_kernel, hipFuncAttributeMaxDynamicSharedMemorySize, LDS_BYTES) != hipSuccess) { fprintf(stderr, "kernel_launch: hipFuncSetAttribute failed\n"); grid = -1; return; }
        (void)hipGetLastError();
        grid = cus;
    }
    if (grid < 0) return;
    (void)hipMemsetAsync((char*)d_ws + WS_CTL, 0, CTL_ZERO_BYTES, stream);
    Args a{};
    for (int i = 0; i < 19; ++i) a.in[i] = (const float*)d_in[i];
    a.out = (float*)d_out; a.ws = (unsigned char*)d_ws;
#if MK_N_LAUNCHES == 1
    a.ph_lo = 0; a.ph_hi = 6;
    hipLaunchKernelGGL(fwd_kernel, dim3(grid), dim3(512), LDS_BYTES, stream, a);
#else
    for (int p = 0; p < 6; ++p) { a.ph_lo = p; a.ph_hi = p + 1; hipLaunchKernelGGL(fwd_kernel, dim3(grid), dim3(512), LDS_BYTES, stream, a);
#if defined(DUP_PHASE)
        if (p == DUP_PHASE) hipLaunchKernelGGL(fwd_kernel, dim3(grid), dim3(512), LDS_BYTES, stream, a);
#endif
    }
#endif
    const hipError_t le = hipPeekAtLastError();
    if (le != hipSuccess) fprintf(stderr, "kernel_launch: launch failed: %s\n", hipGetErrorName(le));
}
```

```cpp
#pragma clang diagnostic ignored "-Winline-asm"
#include <hip/hip_runtime.h>
#include <hip/hip_bf16.h>
#include <cstdio>
#include <cstdint>

#ifndef P3_ROT
#define P3_ROT 1
#endif
#ifndef DUP_EPI
#define DUP_EPI 0
#endif
#ifndef MK_N_LAUNCHES
#define MK_N_LAUNCHES 1
#endif

#define LAS __attribute__((address_space(3)))
#define GAS __attribute__((address_space(1)))
typedef unsigned short bf16_t;
typedef short bf16x8 __attribute__((ext_vector_type(8)));
typedef short s16x4 __attribute__((ext_vector_type(4)));
typedef float f32x4 __attribute__((ext_vector_type(4)));
typedef float f32x2 __attribute__((ext_vector_type(2)));
typedef float f32x16 __attribute__((ext_vector_type(16)));
typedef unsigned u32x4 __attribute__((ext_vector_type(4)));
typedef unsigned u32x2 __attribute__((ext_vector_type(2)));

constexpr int NB = 8, SEQ = 2048, DM = 2048, TOK = NB * SEQ;
constexpr int AW = 1536, BW = 1024, MW = 1024, MEML = 256, INC = 18440;
constexpr int N1 = 8704, N2 = 9728, KP = 3584;
constexpr float EPS = 1e-6f, LOG2E = 1.4426950408889634f;
constexpr float SCQ128 = 0.08838834764831845f * LOG2E, SCQ256 = 0.0625f * LOG2E;

constexpr size_t MiB = 1u << 20;
constexpr size_t WS_CTL = 0, CTL_ZERO_BYTES = 1 * MiB;
constexpr size_t WS_F = 1 * MiB;
constexpr size_t WS_CS = WS_F + 512 * 1024;
constexpr size_t WS_LSE = 2 * MiB;
constexpr size_t WS_KM = 5 * MiB, WS_VM = 9 * MiB;
constexpr size_t WS_WTP = 13 * MiB;
constexpr size_t WS_WTO = 27 * MiB;
constexpr size_t WS_WT2 = 35 * MiB;
constexpr size_t WS_WT1 = 73 * MiB;
constexpr size_t WS_WTKV = 107 * MiB;
constexpr size_t WS_MH = 115 * MiB;
constexpr size_t WS_OA2 = 73 * MiB;
constexpr size_t WS_H = 123 * MiB;
constexpr size_t WS_MRG = 123 * MiB;
constexpr size_t WS_QA = 187 * MiB, WS_KA = 235 * MiB, WS_VA = 283 * MiB;
constexpr size_t WS_KB = 331 * MiB, WS_VB = 363 * MiB;
constexpr size_t WS_G = 187 * MiB;
constexpr size_t WS_QB = 395 * MiB, WS_QM = 427 * MiB;
constexpr size_t WS_Y = 459 * MiB;
constexpr size_t WS_END = 571 * MiB;

constexpr int RING_BYTES = 131072;
constexpr int LDSCTL_OFF = RING_BYTES, MISC_OFF = LDSCTL_OFF + 320;
constexpr int PSUM_OFF = RING_BYTES + 1024;
constexpr int LDS_BYTES = 147456;

#define LDS_WAIT() asm volatile("s_waitcnt lgkmcnt(0)" ::: "memory")
#define VM_WAIT() asm volatile("s_waitcnt vmcnt(0)" ::: "memory")
#define RLX_AGENT __ATOMIC_RELAXED, __HIP_MEMORY_SCOPE_AGENT
typedef GAS unsigned gu32;

#define opaque_tid() opaque_tid_(wave0_)
__device__ __forceinline__ int opaque_tid_(int wave0) { int l; asm volatile("v_mbcnt_lo_u32_b32 %0, -1, 0\n\tv_mbcnt_hi_u32_b32 %0, -1, %0" : "=v"(l)); return wave0 * 64 + l; }
typedef __bf16 bf16x2_t __attribute__((ext_vector_type(2)));
__device__ __forceinline__ unsigned cvt_pk_bf16(float lo, float hi) { f32x2 v = {lo, hi}; bf16x2_t b = __builtin_convertvector(v, bf16x2_t); return __builtin_bit_cast(unsigned, b); }
template <int CTRL> __device__ __forceinline__ float dpp_f(float v) { return __int_as_float(__builtin_amdgcn_update_dpp(0, __float_as_int(v), CTRL, 0xF, 0xF, true)); }
__device__ __forceinline__ float xor16_add(float v) { auto r = __builtin_amdgcn_permlane16_swap(__float_as_uint(v), __float_as_uint(v), false, false); return __uint_as_float(r[0]) + __uint_as_float(r[1]); }
__device__ __forceinline__ float xor32_add(float v) { auto r = __builtin_amdgcn_permlane32_swap(__float_as_uint(v), __float_as_uint(v), false, false); return __uint_as_float(r[0]) + __uint_as_float(r[1]); }
__device__ __forceinline__ float bf_lo(unsigned w) { return __uint_as_float(w << 16); }
__device__ __forceinline__ float bf_hi(unsigned w) { return __uint_as_float(w & 0xffff0000u); }
__device__ __forceinline__ float fast_sigmoid(float x) { return __builtin_amdgcn_rcpf(1.0f + __builtin_amdgcn_exp2f(-x * LOG2E)); }

#define XB_TMO      128
#define XB_XCNT(j)  (256  + 64 * (j))
#define XB_XSUB(j)  (1280 + 64 * (j))
#define XB_XGEN(j)  (2304 + 64 * (j))
#define XB_TOP      3328
#define XB_TOPGEN   3392
#define XCD_BAR_WORDS 3456
#define XB_SPIN_CAP (1u << 18)
__device__ __forceinline__ unsigned xb_ld(unsigned* p)              { return __hip_atomic_load(p, __ATOMIC_RELAXED, __HIP_MEMORY_SCOPE_AGENT); }
__device__ __forceinline__ unsigned xb_add(unsigned* p, unsigned v) { return __hip_atomic_fetch_add(p, v, __ATOMIC_RELAXED, __HIP_MEMORY_SCOPE_AGENT); }
__device__ __forceinline__ unsigned xb_xcc_id() { return (unsigned)__builtin_amdgcn_s_getreg((3 << 11) | 20) & 0xFu; }
#define XB_SPIN(cond, bar) do { unsigned _sp = 0; while (cond) { __builtin_amdgcn_s_sleep(1); \
    if ((++_sp & 255u) == 0u) { if (xb_ld(&(bar)[XB_TMO])) break; if (_sp > XB_SPIN_CAP) { atomicAdd(&(bar)[XB_TMO], 1u); break; } } } } while (0)
struct XcdBarrier { unsigned* bar; unsigned x; volatile LAS unsigned* st; };
__device__ __forceinline__ XcdBarrier xcd_barrier_post(unsigned* bar, volatile LAS unsigned* st, const int wave0_) {
    XcdBarrier b; b.bar = bar; b.x = xb_xcc_id(); b.st = st;
    if (opaque_tid() == 0) (void)xb_add(&bar[XB_XCNT(b.x)], 1u);
    return b;
}
__device__ __forceinline__ void xcd_barrier_complete(unsigned* bar, unsigned x, unsigned& nloc, unsigned& nx) {
    const unsigned G = gridDim.x * gridDim.y * gridDim.z;
    unsigned sum, cnt, mine, sp = 0u;
    for (;;) {
        sum = 0u; cnt = 0u; mine = 0u;
#pragma unroll
        for (unsigned j = 0; j < 16; ++j) { const unsigned c = xb_ld(&bar[XB_XCNT(j)]); sum += c; cnt += (c > 0u) ? 1u : 0u; mine = (j == x) ? c : mine; }
        if (sum == G) break;
        __builtin_amdgcn_s_sleep(1);
        if ((++sp & 255u) == 0u) { if (xb_ld(&bar[XB_TMO])) break; if (sp > XB_SPIN_CAP) { atomicAdd(&bar[XB_TMO], 1u); break; } }
    }
    nloc = mine > 0u ? mine : 1u; nx = cnt > 0u ? cnt : 1u;
}
__device__ __forceinline__ void xcd_barrier(const XcdBarrier& b, const int wave0_) {
    asm volatile("s_waitcnt vmcnt(0)" ::: "memory");
    __syncthreads();
    if (opaque_tid() == 0) {
        unsigned* bar = b.bar;
        __builtin_amdgcn_s_waitcnt(0);
        unsigned nloc = b.st[0], nx = b.st[1];
        if (nloc == 0u) { xcd_barrier_complete(bar, b.x, nloc, nx); b.st[0] = nloc; b.st[1] = nx; }
        const unsigned old = xb_add(&bar[XB_XSUB(b.x)], 1u);
        const unsigned gen = old / nloc;
        if (old + 1u == (gen + 1u) * nloc) {
            __builtin_amdgcn_fence(__ATOMIC_RELEASE, "agent");
            asm volatile("s_waitcnt vmcnt(0)" ::: "memory");
            const unsigned og = xb_add(&bar[XB_TOP], 1u);
            const unsigned tg = og / nx;
            if (og + 1u == (tg + 1u) * nx) xb_add(&bar[XB_TOPGEN], 1u);
            else XB_SPIN(xb_ld(&bar[XB_TOPGEN]) == tg, bar);
            __builtin_amdgcn_fence(__ATOMIC_ACQUIRE, "agent");
            xb_add(&bar[XB_XGEN(b.x)], 1u);
            asm volatile("s_waitcnt vmcnt(0)" ::: "memory");
        } else {
            XB_SPIN(xb_ld(&bar[XB_XGEN(b.x)]) == gen, bar);
            __builtin_amdgcn_fence(__ATOMIC_ACQUIRE, "agent");
            asm volatile("s_waitcnt vmcnt(0)" ::: "memory");
        }
    }
    __syncthreads();
}

__device__ __forceinline__ void xcd_barrier_arrive(const XcdBarrier& b, const int wave0_) {
    asm volatile("s_waitcnt vmcnt(0)" ::: "memory");
    __syncthreads();
    if (opaque_tid() == 0) {
        unsigned* bar = b.bar;
        __builtin_amdgcn_s_waitcnt(0);
        unsigned nloc = b.st[0], nx = b.st[1];
        if (nloc == 0u) { xcd_barrier_complete(bar, b.x, nloc, nx); b.st[0] = nloc; b.st[1] = nx; }
        const unsigned old = xb_add(&bar[XB_XSUB(b.x)], 1u);
        const unsigned gen = old / nloc;
        unsigned role = 0u, tg = 0u;
        if (old + 1u == (gen + 1u) * nloc) {
            __builtin_amdgcn_fence(__ATOMIC_RELEASE, "agent");
            asm volatile("s_waitcnt vmcnt(0)" ::: "memory");
            const unsigned og = xb_add(&bar[XB_TOP], 1u);
            tg = og / nx;
            if (og + 1u == (tg + 1u) * nx) { xb_add(&bar[XB_TOPGEN], 1u); xb_add(&bar[XB_XGEN(b.x)], 1u); role = 2u; } else role = 1u;
        }
        b.st[2] = gen; b.st[3] = tg; b.st[4] = role;
    }
}
__device__ __forceinline__ void xcd_barrier_wait(const XcdBarrier& b, const int wave0_) {
    if (opaque_tid() == 0) {
        unsigned* bar = b.bar; const unsigned gen = b.st[2], tg = b.st[3], role = b.st[4];
        if (role == 1u) { XB_SPIN(xb_ld(&bar[XB_TOPGEN]) == tg, bar); __builtin_amdgcn_fence(__ATOMIC_ACQUIRE, "agent"); xb_add(&bar[XB_XGEN(b.x)], 1u); }
        else if (role == 0u) { XB_SPIN(xb_ld(&bar[XB_XGEN(b.x)]) == gen, bar); __builtin_amdgcn_fence(__ATOMIC_ACQUIRE, "agent"); }
        else __builtin_amdgcn_fence(__ATOMIC_ACQUIRE, "agent");
    }
    __syncthreads();
}

namespace pg8 {
constexpr int BM = 256, BK = 64, HALF = 128, HTB = HALF * BK * 2, STAGE_BYTES = 8 * HTB, NXCD = 8, WGM = 8;
__host__ __device__ __forceinline__ int lds_byte(int r, int c) { const int st = (r >> 4) * 2 + (c >> 5), rr = r & 15, cc = c & 31, ob = rr * 64 + cc * 2; return st * 1024 + (ob ^ (((ob >> 9) & 1) << 5)); }
__host__ __device__ __forceinline__ void stage_rc(int b, int& R, int& C) { const int st = b / 1024, sb = b % 1024, swz = sb ^ (((sb >> 9) & 1) << 5); R = (st >> 1) * 16 + swz / 64; C = (st & 1) * 32 + (swz % 64) / 2; }
__host__ __device__ __forceinline__ int perm32(int rho) { const int n = rho >> 4, i = rho & 15; return 8 * (i >> 2) + 4 * n + (i & 3); }

struct Unit { int pm, pn, koff, nt, first, tag; };
struct Gemm { const bf16_t* A; const bf16_t* Bt; int lda, ldb; };

__device__ __forceinline__ void tile_of(int L, int nM, int nN, int& pm, int& pn) {
    const int nwg = nM * nN; int wgid = L;
    { const int q = nwg / NXCD, r = nwg % NXCD, xcd = wgid % NXCD, off = wgid / NXCD; wgid = (xcd < r ? xcd * (q + 1) : r * (q + 1) + (xcd - r) * q) + off; }
    const int nig = WGM * nN, gid = wgid / nig, fm = gid * WGM, gsz = (nM - fm) < WGM ? (nM - fm) : WGM;
    pm = fm + ((wgid % nig) % gsz); pn = (wgid % nig) / gsz;
}
struct StaticOrder {
    int nM, nN, nwg, G, c, nt, nu, rot;
    __device__ __forceinline__ void init(int M, int N, int K, int G_, int c_, int rot_ = 0) { nM = M / BM; nN = N / BM; nwg = nM * nN; G = G_; c = c_; nt = K / BK;
        nu = c < nwg ? (nwg - 1 - c) / G + 1 : 0; rot = nu > 0 ? rot_ % nu : 0; }
    __device__ __forceinline__ bool next(int i, Unit& u) const {
        if (i >= nu) return false; int ir = i + rot; if (ir >= nu) ir -= nu;
        const long L = (long)ir * G + c;
        tile_of((int)L, nM, nN, u.pm, u.pn); u.koff = 0; u.nt = nt; u.first = 1; u.tag = 0; return true;
    }
};
struct Sub3Order {
    int nM, nN, nwg, G, c, perm;
    __device__ __forceinline__ void init(int M, int N, int G_, int c_, int perm_) { nM = M / BM; nN = N / BM; nwg = nM * nN; G = G_; c = c_; perm = perm_ % 3; }
    __device__ __forceinline__ bool next(int i, Unit& u) const {
        const int ti = i / 3, s = i - 3 * ti; const long L = (long)ti * G + c; if (L >= nwg) return false;
        tile_of((int)L, nM, nN, u.pm, u.pn);
        int br = s + perm; if (br >= 3) br -= 3; int brn = br + 1; if (brn >= 3) brn -= 3;
        u.koff = br == 0 ? 0 : (br == 1 ? 1536 : 2560); u.nt = br == 0 ? 24 : 16; u.first = s == 0; u.tag = br | (brn << 2) | ((s == 2) << 4); return true;
    }
};

template <class Epi, class Sched>
__device__ __forceinline__ void gemm_phase(LAS unsigned char* lds, const Gemm g, const Sched& S, const Epi& E, const int wave0_) {
    const int tid = opaque_tid(), wid = __builtin_amdgcn_readfirstlane(tid >> 6), lane = tid & 63, wr = wid >> 2, wc = wid & 3, fr = lane & 15, fq = lane >> 4;
    unsigned voffA[2], voffB[2];
#pragma unroll
    for (int i = 0; i < 2; ++i) { int R, C; stage_rc(tid * 16 + i * 8192, R, C); const int Rb = Epi::PERM ? ((R & ~31) + perm32(R & 31)) : R;
        voffA[i] = (unsigned)(R * g.lda + C) * 2u; voffB[i] = (unsigned)(Rb * g.ldb + C) * 2u; }
    const size_t kstep = (size_t)(BK * 2);
    const size_t hstepA = (size_t)HALF * g.lda * 2, hstepB = (size_t)HALF * g.ldb * 2;
    const size_t tstepA = 2 * hstepA, tstepB = 2 * hstepB;
    const unsigned ldsw = (unsigned)wid * 1024u;
    const int aoff = lds_byte(wr * 64 + fr, fq * 8), boff = lds_byte(wc * 32 + fr, fq * 8);
#define PG8_SA(b, h) (((b) * 2 + (h)) * HTB)
#define PG8_SB(b, h) ((4 + (b) * 2 + (h)) * HTB)
#define PG8_STAGE(bufoff, gbase, voff) do { _Pragma("unroll") for (int _i = 0; _i < 2; ++_i) \
        __builtin_amdgcn_global_load_lds((const unsigned*)((const char*)(gbase) + (voff)[_i]), (LAS unsigned*)(lds + (bufoff) + ldsw + _i * 8192), 16, 0, 0); } while (0)
#define PG8_LDA(dst, b, h) do { _Pragma("unroll") for (int m = 0; m < 4; ++m) _Pragma("unroll") for (int k = 0; k < 2; ++k) dst[m][k] = *(const LAS bf16x8*)(lds + PG8_SA(b, h) + aoff + m * 2048 + k * 1024); } while (0)
#define PG8_LDB(dst, b, h) do { _Pragma("unroll") for (int n = 0; n < 2; ++n) _Pragma("unroll") for (int k = 0; k < 2; ++k) dst[n][k] = *(const LAS bf16x8*)(lds + PG8_SB(b, h) + boff + n * 2048 + k * 1024); } while (0)
#define PG8_MMA(ai, bj, At, Bt) do { __builtin_amdgcn_s_setprio(1); _Pragma("unroll") for (int m = 0; m < 4; ++m) _Pragma("unroll") for (int n = 0; n < 2; ++n) _Pragma("unroll") for (int k = 0; k < 2; ++k) \
        acc[ai][bj][m][n] = __builtin_amdgcn_mfma_f32_16x16x32_bf16(Bt[n][k], At[m][k], acc[ai][bj][m][n], 0, 0, 0); __builtin_amdgcn_s_setprio(0); } while (0)
#define PG8_WAIT_V(n) asm volatile("s_waitcnt vmcnt(" #n ")" ::: "memory")
#define PG8_WAIT_L(n) asm volatile("s_waitcnt lgkmcnt(" #n ")" ::: "memory")
#define PG8_BAR __builtin_amdgcn_s_barrier()
#define PG8_SCHED __builtin_amdgcn_sched_barrier(0)
    Unit cur, nxt; int ui = 0;
    if (!S.next(0, cur)) return;
    f32x4 acc[2][2][4][2];
#pragma unroll
    for (int a = 0; a < 2; ++a)
#pragma unroll
        for (int b = 0; b < 2; ++b)
#pragma unroll
            for (int m = 0; m < 4; ++m)
#pragma unroll
                for (int n = 0; n < 2; ++n) acc[a][b][m][n] = (f32x4){0.f, 0.f, 0.f, 0.f};
    if constexpr (Epi::ACCINIT) { E.acc_init(acc, cur, wr, wc, fr, fq); cur.tag |= 256; }
    if constexpr (Epi::PREWAIT) E.pre_wait(wave0_);
    bf16x8 At[4][2], B0[2][2], B1[2][2];
    const char* cA = (const char*)g.A + (size_t)cur.pm * tstepA + (size_t)cur.koff * 2; const char* cB = (const char*)g.Bt + (size_t)cur.pn * tstepB + (size_t)cur.koff * 2;
    PG8_STAGE(PG8_SB(0, 0), cB, voffB); PG8_STAGE(PG8_SB(0, 1), cB + hstepB, voffB); PG8_STAGE(PG8_SA(0, 0), cA, voffA); PG8_STAGE(PG8_SA(0, 1), cA + hstepA, voffA);
    if (wr == 1) PG8_BAR;
    PG8_WAIT_V(2); PG8_BAR;
    PG8_STAGE(PG8_SB(1, 0), cB + kstep, voffB); PG8_STAGE(PG8_SA(1, 0), cA + kstep, voffA); PG8_STAGE(PG8_SB(1, 1), cB + hstepB + kstep, voffB);
    PG8_WAIT_V(6); PG8_BAR;
    for (;;) {
        const bool has_next = S.next(ui + 1, nxt);
        const char* nA = has_next ? (const char*)g.A + (size_t)nxt.pm * tstepA + (size_t)nxt.koff * 2 : cA; const char* nB = has_next ? (const char*)g.Bt + (size_t)nxt.pn * tstepB + (size_t)nxt.koff * 2 : cB;
        const int nt = cur.nt;
        for (int t = 0; t < nt; t += 2) {
            const bool last = (t == nt - 2);
            const char* a1 = cA + (size_t)(t + 1) * kstep;
            const char* a2 = last ? nA : cA + (size_t)(t + 2) * kstep; const char* b2 = last ? nB : cB + (size_t)(t + 2) * kstep;
            const char* a3 = a2 + kstep; const char* b3 = b2 + kstep;
            PG8_LDB(B0, 0, 0); PG8_LDB(B1, 0, 1); PG8_SCHED; PG8_LDA(At, 0, 0); PG8_STAGE(PG8_SA(1, 1), a1 + hstepA, voffA);
            PG8_WAIT_V(8); PG8_WAIT_L(0); PG8_BAR; PG8_MMA(0, 0, At, B0); PG8_MMA(0, 1, At, B1); PG8_BAR; PG8_SCHED;
            PG8_LDA(At, 0, 1); PG8_STAGE(PG8_SB(0, 0), b2, voffB); PG8_STAGE(PG8_SB(0, 1), b2 + hstepB, voffB); PG8_STAGE(PG8_SA(0, 0), a2, voffA);
            PG8_WAIT_V(8); PG8_WAIT_L(0); PG8_BAR; PG8_MMA(1, 0, At, B0); PG8_MMA(1, 1, At, B1); PG8_BAR; PG8_SCHED;
            PG8_LDB(B0, 1, 0); PG8_LDB(B1, 1, 1); PG8_SCHED; PG8_LDA(At, 1, 0); PG8_STAGE(PG8_SA(0, 1), a2 + hstepA, voffA);
            PG8_WAIT_V(8); PG8_WAIT_L(0); PG8_BAR; PG8_MMA(0, 0, At, B0); PG8_MMA(0, 1, At, B1); PG8_BAR; PG8_SCHED;
            PG8_LDA(At, 1, 1); PG8_STAGE(PG8_SB(1, 0), b3, voffB); PG8_STAGE(PG8_SB(1, 1), b3 + hstepB, voffB); PG8_STAGE(PG8_SA(1, 0), a3, voffA);
            PG8_WAIT_V(8); PG8_WAIT_L(0); PG8_BAR; PG8_MMA(1, 0, At, B0); PG8_MMA(1, 1, At, B1); PG8_BAR; PG8_SCHED;
        }
        if (wr == 0) PG8_BAR;
        if constexpr (Epi::LAZYBAR) { if (ui == 0) E.lazy_wait(wave0_); }
        E(acc, cur, wr, wc, fr, fq, wid, lane);
        if (Epi::DUP) E(acc, cur, wr, wc, fr, fq, wid, lane);
        if (!has_next) break;
        if (nxt.first) {
#pragma unroll
            for (int a = 0; a < 2; ++a)
#pragma unroll
                for (int b = 0; b < 2; ++b)
#pragma unroll
                    for (int m = 0; m < 4; ++m)
#pragma unroll
                        for (int n = 0; n < 2; ++n) acc[a][b][m][n] = (f32x4){0.f, 0.f, 0.f, 0.f};
        }
        cur = nxt; cA = nA; cB = nB; ++ui;
        if (wr == 1) PG8_BAR;
    }
    PG8_WAIT_V(0);
    PG8_BAR;
#undef PG8_SA
#undef PG8_SB
#undef PG8_STAGE
#undef PG8_LDA
#undef PG8_LDB
#undef PG8_MMA
#undef PG8_WAIT_V
#undef PG8_WAIT_L
#undef PG8_BAR
#undef PG8_SCHED
}
}

typedef f32x4 AccT[2][2][4][2];

struct EpiQKV {
    static constexpr bool PERM = true, DUP = (DUP_EPI == 1), LAZYBAR = false, ACCINIT = false, PREWAIT = false;
    unsigned char* ws; const float* gains[6]; int which;
    LAS unsigned char* lds;
    __device__ __forceinline__ void operator()(AccT& acc, const pg8::Unit& u, int wr, int wc, int fr, int fq, int wid, int lane) const {
        int mode, ldc, col; bf16_t* O; const float* gain = nullptr; float sc = 1.f; const int pn = u.pn;
        if (which == 0) {
            if (pn < 6)       { mode = 1; O = (bf16_t*)(ws + WS_QA); ldc = AW; col = pn * 256;        gain = gains[0]; sc = SCQ128; }
            else if (pn < 12) { mode = 1; O = (bf16_t*)(ws + WS_KA); ldc = AW; col = (pn - 6) * 256;  gain = gains[1]; }
            else if (pn < 18) { mode = 0; O = (bf16_t*)(ws + WS_VA); ldc = AW; col = (pn - 12) * 256; }
            else if (pn < 22) { mode = 1; O = (bf16_t*)(ws + WS_QB); ldc = BW; col = (pn - 18) * 256; gain = gains[2]; sc = SCQ128; }
            else if (pn < 26) { mode = 1; O = (bf16_t*)(ws + WS_KB); ldc = BW; col = (pn - 22) * 256; gain = gains[3]; }
            else if (pn < 30) { mode = 0; O = (bf16_t*)(ws + WS_VB); ldc = BW; col = (pn - 26) * 256; }
            else              { mode = 2; O = (bf16_t*)(ws + WS_QM); ldc = MW; col = (pn - 30) * 256; gain = gains[4]; sc = SCQ256; }
        } else {
            if (pn < 4)       { mode = 2; O = (bf16_t*)(ws + WS_KM); ldc = MW; col = pn * 256;        gain = gains[5]; }
            else              { mode = 0; O = (bf16_t*)(ws + WS_VM); ldc = MW; col = (pn - 4) * 256; }
        }
        float rs[2][4][2];
        if (mode != 0) {
            LAS float* P = (LAS float*)(lds + PSUM_OFF);
#pragma unroll
            for (int ai = 0; ai < 2; ++ai)
#pragma unroll
                for (int m = 0; m < 4; ++m)
#pragma unroll
                    for (int bj = 0; bj < 2; ++bj) {
                        const f32x4 a = acc[ai][bj][m][0], b = acc[ai][bj][m][1];
                        float s = (a[0] * a[0] + a[1] * a[1]) + (a[2] * a[2] + a[3] * a[3]) + (b[0] * b[0] + b[1] * b[1]) + (b[2] * b[2] + b[3] * b[3]);
                        s = xor16_add(s); s = xor32_add(s);
                        if (fq == 0) P[((ai * 128 + wr * 64 + m * 16 + fr) * 2 + bj) * 4 + wc] = s;
                    }
            asm volatile("s_waitcnt lgkmcnt(0)" ::: "memory"); __builtin_amdgcn_s_barrier(); asm volatile("" ::: "memory");
#pragma unroll
            for (int ai = 0; ai < 2; ++ai)
#pragma unroll
                for (int m = 0; m < 4; ++m) {
                    const LAS f32x4* pr = (const LAS f32x4*)(P + (ai * 128 + wr * 64 + m * 16 + fr) * 8);
                    const f32x4 s0 = pr[0], s1 = pr[1];
                    const float t0 = (s0[0] + s0[1]) + (s0[2] + s0[3]), t1 = (s1[0] + s1[1]) + (s1[2] + s1[3]);
                    if (mode == 1) { rs[ai][m][0] = sc * __builtin_amdgcn_rsqf(t0 * (1.f / 128.f) + EPS); rs[ai][m][1] = sc * __builtin_amdgcn_rsqf(t1 * (1.f / 128.f) + EPS); }
                    else { const float r = sc * __builtin_amdgcn_rsqf((t0 + t1) * (1.f / 256.f) + EPS); rs[ai][m][0] = r; rs[ai][m][1] = r; }
                }
        }
        const int row0 = u.pm * 256 + wr * 64 + fr, col0 = col + wc * 32 + 8 * fq;
        f32x4 gv[2][2];
#pragma unroll
        for (int bj = 0; bj < 2; ++bj)
#pragma unroll
            for (int n = 0; n < 2; ++n) {
                if (mode == 0) gv[bj][n] = (f32x4){1.f, 1.f, 1.f, 1.f};
                else { const int gc = (mode == 1 ? 0 : bj * 128) + wc * 32 + 8 * fq + 4 * n; gv[bj][n] = *(const f32x4*)(gain + gc); }
            }
#pragma unroll
        for (int ai = 0; ai < 2; ++ai)
#pragma unroll
            for (int m = 0; m < 4; ++m) { bf16_t* rowp = O + (size_t)(row0 + ai * 128 + m * 16) * ldc + col0;
#pragma unroll
                for (int bj = 0; bj < 2; ++bj) {
                    f32x4 v0 = acc[ai][bj][m][0] * gv[bj][0], v1 = acc[ai][bj][m][1] * gv[bj][1];
                    if (mode != 0) { const float r = rs[ai][m][bj]; v0 = v0 * r; v1 = v1 * r; }
                    u32x4 w; w.x = cvt_pk_bf16(v0[0], v0[1]); w.y = cvt_pk_bf16(v0[2], v0[3]); w.z = cvt_pk_bf16(v1[0], v1[1]); w.w = cvt_pk_bf16(v1[2], v1[3]);
                    *(u32x4*)(rowp + bj * 128) = w; } }
    }
};

struct EpiZG {
    static constexpr bool PERM = true, DUP = false, LAZYBAR = true, ACCINIT = false, PREWAIT = false;
    unsigned char* ws; const bf16_t* oa0; const bf16_t* oa1; const float* bgate;
    XcdBarrier wb; bool lazy;
    __device__ __forceinline__ void lazy_wait(const int wave0_) const { if (lazy) xcd_barrier_wait(wb, wave0_); }
    __device__ __forceinline__ void operator()(AccT& acc, const pg8::Unit& u, int wr, int wc, int fr, int fq, int wid, int lane) const {
        const int pn = u.pn; const int row0 = u.pm * 256 + wr * 64 + fr, cw = wc * 32 + 8 * fq;
        bf16_t* Y = (bf16_t*)(ws + WS_Y);
        if (pn < 6) {
            const bf16_t* oa2 = (const bf16_t*)(ws + WS_OA2); const float* lse = (const float*)(ws + WS_LSE);
#pragma unroll
            for (int ab = 0; ab < 4; ++ab) { const int ai = ab >> 1, m0 = (ab & 1) * 2;
                float L[2][2][3]; u32x4 P[2][2][3];
#pragma unroll
                for (int mm = 0; mm < 2; ++mm) { const int row = row0 + ai * 128 + (m0 + mm) * 16;
#pragma unroll
                    for (int bj = 0; bj < 2; ++bj) { const int head = 2 * pn + bj, c = pn * 256 + bj * 128 + cw;
                        L[mm][bj][0] = lse[(size_t)row * 12 + head]; L[mm][bj][1] = lse[((size_t)TOK + row) * 12 + head]; L[mm][bj][2] = lse[((size_t)2 * TOK + row) * 12 + head];
                        P[mm][bj][0] = *(const u32x4*)(oa0 + (size_t)row * AW + c); P[mm][bj][1] = *(const u32x4*)(oa1 + (size_t)row * AW + c); P[mm][bj][2] = *(const u32x4*)(oa2 + (size_t)row * AW + c); } }
                asm volatile("" ::: "memory");
#pragma unroll
                for (int mm = 0; mm < 2; ++mm) { const int m = m0 + mm, row = row0 + ai * 128 + m * 16;
#pragma unroll
                    for (int bj = 0; bj < 2; ++bj) { const int c = pn * 256 + bj * 128 + cw;
                        const float l0 = L[mm][bj][0], l1 = L[mm][bj][1], l2 = L[mm][bj][2];
                        const float mx = fmaxf(l0, fmaxf(l1, l2));
                        float w0 = __builtin_amdgcn_exp2f(l0 - mx), w1 = __builtin_amdgcn_exp2f(l1 - mx), w2 = __builtin_amdgcn_exp2f(l2 - mx);
                        const float inv = __builtin_amdgcn_rcpf(w0 + w1 + w2); w0 *= inv; w1 *= inv; w2 *= inv;
                        const u32x4 p0 = P[mm][bj][0], p1 = P[mm][bj][1], p2 = P[mm][bj][2];
                        const f32x4 z0 = acc[ai][bj][m][0], z1 = acc[ai][bj][m][1]; float y[8];
#pragma unroll
                        for (int j = 0; j < 4; ++j) { const unsigned a = p0[j], b = p1[j], d = p2[j];
                            const float olo = w0 * bf_lo(a) + w1 * bf_lo(b) + w2 * bf_lo(d), ohi = w0 * bf_hi(a) + w1 * bf_hi(b) + w2 * bf_hi(d);
                            const float zl = j < 2 ? z0[2 * j] : z1[2 * j - 4], zh = j < 2 ? z0[2 * j + 1] : z1[2 * j - 3];
                            y[2 * j] = olo * zl * fast_sigmoid(zl); y[2 * j + 1] = ohi * zh * fast_sigmoid(zh); }
                        u32x4 w; w.x = cvt_pk_bf16(y[0], y[1]); w.y = cvt_pk_bf16(y[2], y[3]); w.z = cvt_pk_bf16(y[4], y[5]); w.w = cvt_pk_bf16(y[6], y[7]);
                        *(u32x4*)(Y + (size_t)row * KP + c) = w; } }
                asm volatile("" ::: "memory"); }
        } else if (pn < 14) {
            const int cb = (pn < 10 ? AW + (pn - 6) * 256 : AW + BW + (pn - 10) * 256) + cw;
#pragma unroll
            for (int ai = 0; ai < 2; ++ai) { u32x4 P[4][2];
#pragma unroll
                for (int m = 0; m < 4; ++m) { const bf16_t* rowp = Y + (size_t)(row0 + ai * 128 + m * 16) * KP + cb;
#pragma unroll
                    for (int bj = 0; bj < 2; ++bj) P[m][bj] = *(const u32x4*)(rowp + bj * 128); }
                asm volatile("" ::: "memory");
#pragma unroll
                for (int m = 0; m < 4; ++m) { bf16_t* rowp = Y + (size_t)(row0 + ai * 128 + m * 16) * KP + cb;
#pragma unroll
                    for (int bj = 0; bj < 2; ++bj) { const u32x4 p = P[m][bj];
                        const f32x4 z0 = acc[ai][bj][m][0], z1 = acc[ai][bj][m][1]; float y[8];
#pragma unroll
                        for (int j = 0; j < 4; ++j) { const float zl = j < 2 ? z0[2 * j] : z1[2 * j - 4], zh = j < 2 ? z0[2 * j + 1] : z1[2 * j - 3];
                            y[2 * j] = bf_lo(p[j]) * zl * fast_sigmoid(zl); y[2 * j + 1] = bf_hi(p[j]) * zh * fast_sigmoid(zh); }
                        u32x4 w; w.x = cvt_pk_bf16(y[0], y[1]); w.y = cvt_pk_bf16(y[2], y[3]); w.z = cvt_pk_bf16(y[4], y[5]); w.w = cvt_pk_bf16(y[6], y[7]);
                        *(u32x4*)(rowp + bj * 128) = w; } }
                asm volatile("" ::: "memory"); }
        } else {
            const int idx = pn - 14, br = idx >> 3, cg = (idx & 7) * 256 + cw;
            unsigned char* G8 = (unsigned char*)(ws + WS_G) + (size_t)br * TOK * DM + (idx & 7) * 256 + (wc * 4 + fq) * 16; const float* bg = bgate + br * DM + cg;
            f32x4 bv[2][2];
#pragma unroll
            for (int bj = 0; bj < 2; ++bj)
#pragma unroll
                for (int n = 0; n < 2; ++n) bv[bj][n] = *(const f32x4*)(bg + bj * 128 + 4 * n);
#define GQ8(x) fmaxf(255.f * fast_sigmoid(x), 1.f)
#define PK8(v) __builtin_amdgcn_cvt_pk_u8_f32(GQ8(v[3]), 3, __builtin_amdgcn_cvt_pk_u8_f32(GQ8(v[2]), 2, __builtin_amdgcn_cvt_pk_u8_f32(GQ8(v[1]), 1, __builtin_amdgcn_cvt_pk_u8_f32(GQ8(v[0]), 0, 0u))))
#pragma unroll
            for (int ai = 0; ai < 2; ++ai)
#pragma unroll
                for (int m = 0; m < 4; ++m) { u32x4 w;
                    { const f32x4 v0 = acc[ai][0][m][0] + bv[0][0], v1 = acc[ai][0][m][1] + bv[0][1]; w.x = PK8(v0); w.y = PK8(v1); }
                    { const f32x4 v0 = acc[ai][1][m][0] + bv[1][0], v1 = acc[ai][1][m][1] + bv[1][1]; w.z = PK8(v0); w.w = PK8(v1); }
                    *(u32x4*)(G8 + (size_t)(row0 + ai * 128 + m * 16) * DM) = w; }
#undef PK8
#undef GQ8
        }
    }
};

struct EpiMerge {
    static constexpr bool PERM = true, DUP = false, LAZYBAR = false, ACCINIT = false, PREWAIT = false;
    unsigned char* ws;
    __device__ __forceinline__ void operator()(AccT& acc, const pg8::Unit& u, int wr, int wc, int fr, int fq, int wid, int lane) const {
        const int br = u.tag & 3, brn = (u.tag >> 2) & 3; const bool last = (u.tag >> 4) != 0;
        const int row0 = u.pm * 256 + wr * 64 + fr, c0 = u.pn * 256 + wc * 32 + 8 * fq;
        const unsigned char* Ga = (const unsigned char*)(ws + WS_G) + (size_t)br * TOK * DM + u.pn * 256 + (wc * 4 + fq) * 16;
        const unsigned char* Gb = last ? Ga : (const unsigned char*)(ws + WS_G) + (size_t)brn * TOK * DM + u.pn * 256 + (wc * 4 + fq) * 16;
        bf16_t* Mg = (bf16_t*)(ws + WS_MRG);
#define UB(w, k) ((float)(((w) >> (8 * (k))) & 0xffu))
#pragma unroll
        for (int ai = 0; ai < 2; ++ai) { u32x4 ga[4], gb[4];
#pragma unroll
            for (int m = 0; m < 4; ++m) { const size_t ro = (size_t)(row0 + ai * 128 + m * 16) * DM; ga[m] = *(const u32x4*)(Ga + ro); gb[m] = *(const u32x4*)(Gb + ro); }
            asm volatile("" ::: "memory");
#pragma unroll
            for (int m = 0; m < 4; ++m) { const size_t off = (size_t)(row0 + ai * 128 + m * 16) * DM + c0;
#pragma unroll
                for (int bj = 0; bj < 2; ++bj) { float f[8];
#pragma unroll
                    for (int j = 0; j < 8; ++j) { const unsigned wa = ga[m][2 * bj + (j >> 2)], wb = gb[m][2 * bj + (j >> 2)];
                        f[j] = UB(wa, j & 3) * (last ? (1.f / 255.f) : __builtin_amdgcn_rcpf(UB(wb, j & 3))); }
                    f32x4 v0 = acc[ai][bj][m][0], v1 = acc[ai][bj][m][1];
                    v0 = v0 * (f32x4){f[0], f[1], f[2], f[3]}; v1 = v1 * (f32x4){f[4], f[5], f[6], f[7]};
                    acc[ai][bj][m][0] = v0; acc[ai][bj][m][1] = v1;
                    if (last) { u32x4 w; w.x = cvt_pk_bf16(v0[0], v0[1]); w.y = cvt_pk_bf16(v0[2], v0[3]); w.z = cvt_pk_bf16(v1[0], v1[1]); w.w = cvt_pk_bf16(v1[2], v1[3]);
                        *(u32x4*)(Mg + off + bj * 128) = w; } } }
            asm volatile("" ::: "memory"); }
#undef UB
    }
};

struct EpiOut {
    static constexpr bool PERM = false, DUP = (DUP_EPI == 5), LAZYBAR = false, ACCINIT = true, PREWAIT = true;
    const float* x; float* out;
    XcdBarrier wb; bool lazy;
    __device__ __forceinline__ void pre_wait(const int wave0_) const { if (lazy) xcd_barrier_wait(wb, wave0_); }
    __device__ __forceinline__ void acc_init(AccT& acc, const pg8::Unit& u, int wr, int wc, int fr, int fq) const {
        const int row0 = u.pm * 256 + wr * 64 + fr, col0 = u.pn * 256 + wc * 32 + 4 * fq;
#pragma unroll
        for (int ai = 0; ai < 2; ++ai)
#pragma unroll
            for (int m = 0; m < 4; ++m) { const size_t off = (size_t)(row0 + ai * 128 + m * 16) * DM + col0;
#pragma unroll
                for (int bj = 0; bj < 2; ++bj)
#pragma unroll
                    for (int n = 0; n < 2; ++n) acc[ai][bj][m][n] = *(const f32x4*)(x + off + bj * 128 + n * 16); }
    }
    __device__ __forceinline__ void operator()(AccT& acc, const pg8::Unit& u, int wr, int wc, int fr, int fq, int wid, int lane) const {
        const int row0 = u.pm * 256 + wr * 64 + fr, col0 = u.pn * 256 + wc * 32 + 4 * fq;
        if (u.tag & 256) {
#pragma unroll
            for (int ai = 0; ai < 2; ++ai)
#pragma unroll
                for (int m = 0; m < 4; ++m) { const size_t off = (size_t)(row0 + ai * 128 + m * 16) * DM + col0;
#pragma unroll
                    for (int bj = 0; bj < 2; ++bj)
#pragma unroll
                        for (int n = 0; n < 2; ++n) *(f32x4*)(out + off + bj * 128 + n * 16) = acc[ai][bj][m][n]; }
            return;
        }
#pragma unroll
        for (int ab = 0; ab < 2; ++ab) { const int ai = ab, m0 = 0; f32x4 xv[4][2][2];
#pragma unroll
            for (int mm = 0; mm < 4; ++mm) { const size_t off = (size_t)(row0 + ai * 128 + (m0 + mm) * 16) * DM + col0;
#pragma unroll
                for (int bj = 0; bj < 2; ++bj)
#pragma unroll
                    for (int n = 0; n < 2; ++n) xv[mm][bj][n] = *(const f32x4*)(x + off + bj * 128 + n * 16); }
            asm volatile("" ::: "memory");
#pragma unroll
            for (int mm = 0; mm < 4; ++mm) { const size_t off = (size_t)(row0 + ai * 128 + (m0 + mm) * 16) * DM + col0;
#pragma unroll
                for (int bj = 0; bj < 2; ++bj)
#pragma unroll
                    for (int n = 0; n < 2; ++n) *(f32x4*)(out + off + bj * 128 + n * 16) = xv[mm][bj][n] + acc[ai][bj][m0 + mm][n]; }
            asm volatile("" ::: "memory"); }
    }
};

namespace att {
#define KSWZ(row, colB) ((row) * 256 + ((colB) ^ (((row) & 7) << 4)))
#define SBAR() __builtin_amdgcn_sched_barrier(0)
constexpr int SHM_V = 16384, SHM_K = 16384;
constexpr int V_OFF = 0, K_OFF = 49152, WS_OFF = 114688, TAB_OFF = 116736, CSL_OFF = 118784;
constexpr float THR2 = 8.f;
__device__ __forceinline__ int crow(int r, int hi) { return (r & 3) + 8 * (r >> 2) + 4 * hi; }
__device__ __forceinline__ int v_st(int k, int c) { const int kk = (k & ~0xC) | ((k & 4) << 1) | ((k & 8) >> 1); return ((kk >> 3) * 4 + (c >> 5)) * 512 + ((kk & 7) * 32 + (c & 31)) * 2; }
__device__ __forceinline__ int swap23(int k) { return (k & ~0xC) | ((k & 4) << 1) | ((k & 8) >> 1); }
#define GLDS(src, dst) asm volatile("s_mov_b32 m0, %1\n\tglobal_load_lds_dwordx4 %0, off" :: "v"(src), "s"((unsigned)(uintptr_t)(dst)) : "memory", "m0")
__device__ __forceinline__ int v_rd_base(int lane) { return ((lane & 3) << 3) | (((lane >> 2) & 3) << 6) | (((lane >> 4) & 1) << 5) | (((lane >> 5) & 1) << 8); }
constexpr int v_rd_off(int d0, int ks, int half) { return d0 * 512 + ks * 4096 + half * 2048; }

template <bool ACCUM>
__device__ __forceinline__ void qkt(f32x16& p0, f32x16& p1, const LAS char* Kimg, int r32, int hi, const bf16x8* qr) {
    if (!ACCUM) { p0 = f32x16{}; p1 = f32x16{}; }
    const LAS char* kb[4];
#pragma unroll
    for (int dd = 0; dd < 4; ++dd) kb[dd] = Kimg + KSWZ(r32, (dd * 16 + hi * 8) * 2);
    __builtin_amdgcn_s_setprio(1);
    bf16x8 f0[8], f1[8];
#pragma unroll
    for (int d0 = 0; d0 < 8; ++d0) { const LAS char* a = kb[d0 & 3] + (d0 >> 2) * 128; f0[d0] = *(const LAS bf16x8*)(a); f1[d0] = *(const LAS bf16x8*)(a + 32 * 256); }
#pragma unroll
    for (int d0 = 0; d0 < 8; ++d0) { p0 = __builtin_amdgcn_mfma_f32_32x32x16_bf16(f0[d0], qr[d0], p0, 0, 0, 0); p1 = __builtin_amdgcn_mfma_f32_32x32x16_bf16(f1[d0], qr[d0], p1, 0, 0, 0); }
    __builtin_amdgcn_sched_group_barrier(0x100, 4, 0);
#pragma unroll
    for (int d0 = 0; d0 < 6; ++d0) { __builtin_amdgcn_sched_group_barrier(0x008, 2, 0); __builtin_amdgcn_sched_group_barrier(0x100, 2, 0); }
    __builtin_amdgcn_sched_group_barrier(0x008, 4, 0);
    __builtin_amdgcn_s_setprio(0);
}
typedef short v4i16_t __attribute__((ext_vector_type(4)));
__device__ __forceinline__ s16x4 vtr(int addr) { return __builtin_bit_cast(s16x4, __builtin_amdgcn_ds_read_tr16_b64_v4i16((LAS v4i16_t*)(uintptr_t)(unsigned)addr)); }
__device__ __forceinline__ void pv_tile(f32x16* o, int vb, bf16x8 pa0, bf16x8 pa1, bf16x8 pa2, bf16x8 pa3) {
#define PV_D0(d0) do { constexpr int b_ = v_rd_off(d0, 0, 0); \
        const s16x4 l0 = vtr(vb + b_), h0 = vtr(vb + b_ + 2048), l1 = vtr(vb + b_ + 4096), h1 = vtr(vb + b_ + 6144), l2 = vtr(vb + b_ + 8192), h2 = vtr(vb + b_ + 10240), l3 = vtr(vb + b_ + 12288), h3 = vtr(vb + b_ + 14336); \
        o[d0] = __builtin_amdgcn_mfma_f32_32x32x16_bf16((bf16x8){l0[0], l0[1], l0[2], l0[3], h0[0], h0[1], h0[2], h0[3]}, pa0, o[d0], 0, 0, 0);   \
        o[d0] = __builtin_amdgcn_mfma_f32_32x32x16_bf16((bf16x8){l1[0], l1[1], l1[2], l1[3], h1[0], h1[1], h1[2], h1[3]}, pa1, o[d0], 0, 0, 0);   \
        o[d0] = __builtin_amdgcn_mfma_f32_32x32x16_bf16((bf16x8){l2[0], l2[1], l2[2], l2[3], h2[0], h2[1], h2[2], h2[3]}, pa2, o[d0], 0, 0, 0);   \
        o[d0] = __builtin_amdgcn_mfma_f32_32x32x16_bf16((bf16x8){l3[0], l3[1], l3[2], l3[3], h3[0], h3[1], h3[2], h3[3]}, pa3, o[d0], 0, 0, 0); } while (0)
    __builtin_amdgcn_s_setprio(1);
    PV_D0(0); PV_D0(1); PV_D0(2); PV_D0(3);
    __builtin_amdgcn_s_setprio(0);
#undef PV_D0
}
__device__ __forceinline__ void store_o_rows(bf16_t* rowp, const f32x16* o, const float rl) {
#pragma unroll
    for (int d0 = 0; d0 < 4; ++d0)
#pragma unroll
        for (int j = 0; j < 2; ++j) { const int a = 8 * j, b = 8 * j + 4;
            const unsigned A0 = cvt_pk_bf16(o[d0][a] * rl, o[d0][a + 1] * rl), A1 = cvt_pk_bf16(o[d0][a + 2] * rl, o[d0][a + 3] * rl);
            const unsigned B0 = cvt_pk_bf16(o[d0][b] * rl, o[d0][b + 1] * rl), B1 = cvt_pk_bf16(o[d0][b + 2] * rl, o[d0][b + 3] * rl);
            auto r0 = __builtin_amdgcn_permlane32_swap(A0, B0, false, false); auto r1 = __builtin_amdgcn_permlane32_swap(A1, B1, false, false);
            const u32x4 w = {r0[0], r1[0], r0[1], r1[1]};
            *(u32x4*)(rowp + d0 * 32 + j * 16) = w; }
}
__device__ __forceinline__ void softmax_tile(f32x16& p0, f32x16& p1, float& m_reg, float& l_reg, float& alpha, bf16x8& pa0, bf16x8& pa1, bf16x8& pa2, bf16x8& pa3) {
    float pmax = p0[0];
#pragma unroll
    for (int r = 1; r < 16; ++r) pmax = fmaxf(pmax, p0[r]);
#pragma unroll
    for (int r = 0; r < 16; ++r) pmax = fmaxf(pmax, p1[r]);
    { auto rr = __builtin_amdgcn_permlane32_swap(__float_as_uint(pmax), __float_as_uint(pmax), false, false);
      pmax = fmaxf(__uint_as_float(rr[0]), __uint_as_float(rr[1])); }
    float mn;
    if (__builtin_expect(__all(pmax - m_reg <= THR2), 1)) { mn = m_reg; alpha = 1.f; }
    else { mn = fmaxf(m_reg, pmax); alpha = __builtin_amdgcn_exp2f(m_reg - mn); m_reg = mn; }
    const f32x2 mn2 = {mn, mn}; f32x2 ps2a = {0.f, 0.f}, ps2b = {0.f, 0.f};
#pragma unroll
    for (int r = 0; r < 8; ++r) { f32x2 v = {p0[2 * r], p0[2 * r + 1]}; v = v - mn2; v[0] = __builtin_amdgcn_exp2f(v[0]); v[1] = __builtin_amdgcn_exp2f(v[1]); p0[2 * r] = v[0]; p0[2 * r + 1] = v[1]; ps2a += v; }
#pragma unroll
    for (int r = 0; r < 8; ++r) { f32x2 v = {p1[2 * r], p1[2 * r + 1]}; v = v - mn2; v[0] = __builtin_amdgcn_exp2f(v[0]); v[1] = __builtin_amdgcn_exp2f(v[1]); p1[2 * r] = v[0]; p1[2 * r + 1] = v[1]; ps2b += v; }
    ps2a += ps2b; float ps = ps2a[0] + ps2a[1];
    { auto rr = __builtin_amdgcn_permlane32_swap(__float_as_uint(ps), __float_as_uint(ps), false, false);
      ps = __uint_as_float(rr[0]) + __uint_as_float(rr[1]); }
    l_reg = l_reg * alpha + ps;
#define PK4(P, B_, OUT) do { unsigned a0 = cvt_pk_bf16(P[B_+0], P[B_+1]), a1 = cvt_pk_bf16(P[B_+2], P[B_+3]);                          \
        unsigned b0 = cvt_pk_bf16(P[B_+4], P[B_+5]), b1 = cvt_pk_bf16(P[B_+6], P[B_+7]);                                             \
        auto r0 = __builtin_amdgcn_permlane32_swap(a0, b0, false, false); auto r1 = __builtin_amdgcn_permlane32_swap(a1, b1, false, false); \
        u32x4 w = {r0[0], r1[0], r0[1], r1[1]}; OUT = *reinterpret_cast<bf16x8*>(&w); } while (0)
    PK4(p0, 0, pa0); PK4(p0, 8, pa1); PK4(p1, 0, pa2); PK4(p1, 8, pa3);
#undef PK4
}

struct AU {
    const bf16_t* Q; int ldq;
    const bf16_t* K; const bf16_t* V; int ldk;
    bf16_t* O; int ldo;
    float* lse;
    const float* cs;
    const float* relb;
    int hh;
    int v0;
    int Lm, Ls, dil;
    int kb0, NT;
};

__device__ __forceinline__ void pv_softmax(f32x16* o, const int vb, const bf16x8 q0, const bf16x8 q1, const bf16x8 q2, const bf16x8 q3,
                                           f32x16& p0, f32x16& p1, float& m_reg, float& l_reg, float& alpha, bf16x8& pa0, bf16x8& pa1, bf16x8& pa2, bf16x8& pa3) {
#define PVQ_D0(d0) do { constexpr int b_ = v_rd_off(d0, 0, 0); \
        const s16x4 l0 = vtr(vb + b_), h0 = vtr(vb + b_ + 2048), l1 = vtr(vb + b_ + 4096), h1 = vtr(vb + b_ + 6144), l2 = vtr(vb + b_ + 8192), h2 = vtr(vb + b_ + 10240), l3 = vtr(vb + b_ + 12288), h3 = vtr(vb + b_ + 14336); \
        o[d0] = __builtin_amdgcn_mfma_f32_32x32x16_bf16((bf16x8){l0[0], l0[1], l0[2], l0[3], h0[0], h0[1], h0[2], h0[3]}, q0, o[d0], 0, 0, 0);   \
        o[d0] = __builtin_amdgcn_mfma_f32_32x32x16_bf16((bf16x8){l1[0], l1[1], l1[2], l1[3], h1[0], h1[1], h1[2], h1[3]}, q1, o[d0], 0, 0, 0);   \
        o[d0] = __builtin_amdgcn_mfma_f32_32x32x16_bf16((bf16x8){l2[0], l2[1], l2[2], l2[3], h2[0], h2[1], h2[2], h2[3]}, q2, o[d0], 0, 0, 0);   \
        o[d0] = __builtin_amdgcn_mfma_f32_32x32x16_bf16((bf16x8){l3[0], l3[1], l3[2], l3[3], h3[0], h3[1], h3[2], h3[3]}, q3, o[d0], 0, 0, 0); } while (0)
    PVQ_D0(0); PVQ_D0(1); PVQ_D0(2); PVQ_D0(3);
#undef PVQ_D0
    float pmax = p0[0];
#pragma unroll
    for (int r = 1; r < 16; ++r) pmax = fmaxf(pmax, p0[r]);
#pragma unroll
    for (int r = 0; r < 16; ++r) pmax = fmaxf(pmax, p1[r]);
    { auto rr = __builtin_amdgcn_permlane32_swap(__float_as_uint(pmax), __float_as_uint(pmax), false, false);
      pmax = fmaxf(__uint_as_float(rr[0]), __uint_as_float(rr[1])); }
    const bool ok = __all(pmax - m_reg <= THR2);
    const float mn = ok ? m_reg : fmaxf(m_reg, pmax);
    alpha = __builtin_amdgcn_exp2f(m_reg - mn); m_reg = mn;
    const f32x2 mn2 = {mn, mn}; f32x2 ps2a = {0.f, 0.f}, ps2b = {0.f, 0.f};
#pragma unroll
    for (int r = 0; r < 8; ++r) { f32x2 v = {p0[2 * r], p0[2 * r + 1]}; v = v - mn2; v[0] = __builtin_amdgcn_exp2f(v[0]); v[1] = __builtin_amdgcn_exp2f(v[1]); p0[2 * r] = v[0]; p0[2 * r + 1] = v[1]; ps2a += v; }
#pragma unroll
    for (int r = 0; r < 8; ++r) { f32x2 v = {p1[2 * r], p1[2 * r + 1]}; v = v - mn2; v[0] = __builtin_amdgcn_exp2f(v[0]); v[1] = __builtin_amdgcn_exp2f(v[1]); p1[2 * r] = v[0]; p1[2 * r + 1] = v[1]; ps2b += v; }
    ps2a += ps2b; float ps = ps2a[0] + ps2a[1];
    { auto rr = __builtin_amdgcn_permlane32_swap(__float_as_uint(ps), __float_as_uint(ps), false, false);
      ps = __uint_as_float(rr[0]) + __uint_as_float(rr[1]); }
    l_reg = l_reg * alpha + ps;
#define PK4(P, B_, OUT) do { unsigned a0 = cvt_pk_bf16(P[B_+0], P[B_+1]), a1 = cvt_pk_bf16(P[B_+2], P[B_+3]);                          \
        unsigned b0 = cvt_pk_bf16(P[B_+4], P[B_+5]), b1 = cvt_pk_bf16(P[B_+6], P[B_+7]);                                             \
        auto r0 = __builtin_amdgcn_permlane32_swap(a0, b0, false, false); auto r1 = __builtin_amdgcn_permlane32_swap(a1, b1, false, false); \
        u32x4 w = {r0[0], r1[0], r0[1], r1[1]}; OUT = *reinterpret_cast<bf16x8*>(&w); } while (0)
    PK4(p0, 0, pa0); PK4(p0, 8, pa1); PK4(p1, 0, pa2); PK4(p1, 8, pa3);
#undef PK4
    __builtin_amdgcn_sched_group_barrier(0x100, 8, 0);
#pragma unroll
    for (int i = 0; i < 16; ++i) { __builtin_amdgcn_sched_group_barrier(0x008, 1, 0); __builtin_amdgcn_sched_group_barrier(0x002, 6, 0); __builtin_amdgcn_sched_group_barrier(0x400, 2, 0);
        __builtin_amdgcn_sched_group_barrier(0x100, 2, 0); }
}
template <int MODE>
__device__ __forceinline__ void attn_unit(LAS char* lds, const AU& u, const int wave0_) {
    constexpr int NKH = MODE == 2 ? 2 : 1;
    const int tid = opaque_tid(), wid = __builtin_amdgcn_readfirstlane(tid >> 6), lane = tid & 63, r32 = lane & 31, hi = lane >> 5;
    LAS char* V_lds = lds + V_OFF; LAS char* K_lds = lds + K_OFF;
    LAS float* tab = (LAS float*)(lds + TAB_OFF); LAS float* csl = (LAS float*)(lds + CSL_OFF);
    const int Lm = u.Lm, Ls = u.Ls, dil = u.dil;
#define TOKV(v) ((((v) & Lm) * dil) + ((v) >> Ls))
    const int vw = u.v0 + wid * 32, vq = vw + r32, qm = vq - 4 * hi;
    bf16x8 qr[8 * NKH];
    { const bf16_t* qp = u.Q + (size_t)TOKV(vq) * u.ldq + hi * 8;
#pragma unroll
      for (int d0 = 0; d0 < 8 * NKH; ++d0) qr[d0] = *(const bf16x8*)(qp + d0 * 16); }
    if (MODE == 0) {
        const int delta = tid - 160; float val = -__builtin_inff();
        if (delta >= 0 && delta <= 128) { const int dist = delta * dil; int bk = dist;
            if (dist >= 16) { bk = 16 + (int)(log2f((float)dist * 0.0625f) * (16.0f / 7.0f)); bk = bk > 31 ? 31 : bk; }
            val = u.relb[bk * 12] * LOG2E; }
        tab[tid] = val;
    }
    float m_reg = -1e30f, l_reg = 0.f; f32x16 o[4] = {};
    const int l4 = lane >> 4, kr0 = 8 * wid + l4, kc0 = ((lane & 15) ^ l4) * 8, kc1 = ((lane & 15) ^ (4 + l4)) * 8;
    const int vrow = swap23(8 * wid + ((lane & 31) >> 2)), vc0 = (lane >> 5) * 32 + (lane & 3) * 8;
    const int vb0 = (int)(uintptr_t)V_lds + v_rd_base(lane);
    float st_c = 0.f;
#define SLOAD(kbv, kbf, vbf) do { int a0_ = (kbv) + kr0, a1_ = a0_ + 4, av_ = (kbv) + vrow; a0_ = a0_ < 0 ? 0 : a0_; a1_ = a1_ < 0 ? 0 : a1_; av_ = av_ < 0 ? 0 : av_; \
        const bf16_t* k0_ = u.K + (size_t)TOKV(a0_) * u.ldk + kc0; const bf16_t* k1_ = u.K + (size_t)TOKV(a1_) * u.ldk + kc1; const bf16_t* v0_ = u.V + (size_t)TOKV(av_) * u.ldk + vc0; \
        LAS char* kd_ = K_lds + (kbf) * (NKH * SHM_K) + wid * 2048; LAS char* vd_ = V_lds + (vbf) * SHM_V + wid * 2048; \
        GLDS(k0_, kd_); GLDS(k1_, kd_ + 1024); if (NKH == 2) { GLDS(k0_ + 128, kd_ + SHM_K); GLDS(k1_ + 128, kd_ + SHM_K + 1024); } \
        GLDS(v0_, vd_); GLDS(v0_ + 64, vd_ + 1024); \
        if (MODE == 1) { if (tid < 64) st_c = u.cs[(kbv) + tid]; } } while (0)
#define SWRITE(kbf) do { if (MODE == 1) { if (tid < 64) csl[(kbf) * 64 + tid] = -st_c; } } while (0)
#define RESC(a) do { if (__any((a) < 1.f)) { _Pragma("unroll") for (int d_ = 0; d_ < 4; ++d_) _Pragma("unroll") for (int r = 0; r < 16; ++r) o[d_][r] *= (a); } } while (0)
    const bool need_lim = MODE == 0 && (vw & Lm) < 128; const int lim = vq & Lm;
    f32x16 p0, p1; bf16x8 pa0, pa1, pa2, pa3; float alpha;
    bf16x8 q0, q1, q2, q3;
    SLOAD(u.kb0, 0, 0); VM_WAIT(); SWRITE(0);
#pragma unroll
    for (int d0 = 0; d0 < 8 * NKH; ++d0) asm volatile("" :: "v"(qr[d0]));
    __syncthreads();
    bool act_prev = false; int vcur = 0, vprev = 0;
    for (int t = 0; t < u.NT; ++t) {
        int kbo_ = u.kb0 + 64 * t; asm volatile("" : "+s"(kbo_)); const int kb_ = kbo_;
        const int kbf = t & 1, vnext = vcur == 2 ? 0 : vcur + 1; const bool HN = t + 1 < u.NT;
        if (HN) SLOAD(kb_ + 64, kbf ^ 1, vnext);
        bool act_ = true;
        if (MODE == 0) act_ = (kb_ <= vw + 31) && (kb_ + 63 >= vw - 128);
        if (MODE == 1) act_ = (kb_ <= vw + 31);
        if (act_) {
            SBAR();
            if (MODE == 1) { const LAS f32x4* cp_ = (const LAS f32x4*)(csl + kbf * 64 + 4 * hi);
#pragma unroll
                for (int g_ = 0; g_ < 4; ++g_) { const f32x4 c0_ = cp_[2 * g_], c1_ = cp_[2 * g_ + 8];
#pragma unroll
                    for (int i_ = 0; i_ < 4; ++i_) { p0[4 * g_ + i_] = c0_[i_]; p1[4 * g_ + i_] = c1_[i_]; } }
                qkt<true>(p0, p1, K_lds + kbf * (NKH * SHM_K), r32, hi, qr); }
            else qkt<false>(p0, p1, K_lds + kbf * (NKH * SHM_K), r32, hi, qr);
            if (NKH == 2) qkt<true>(p0, p1, K_lds + kbf * (NKH * SHM_K) + SHM_K, r32, hi, qr + 8);
            const int dq_ = qm - kb_;
            if (MODE == 0) { const LAS float* tb_ = tab + (dq_ + 101);
#pragma unroll
                for (int r = 0; r < 16; ++r) { const int c_ = (r & 3) + 8 * (r >> 2); p0[r] += tb_[59 - c_]; p1[r] += tb_[27 - c_]; }
                if (need_lim) {
#pragma unroll
                    for (int r = 0; r < 16; ++r) { const int c_ = (r & 3) + 8 * (r >> 2);
                        if (dq_ - c_ > lim) p0[r] = -__builtin_inff(); if (dq_ - c_ - 32 > lim) p1[r] = -__builtin_inff(); } } }
            if (MODE == 1) {
                if (kb_ + 63 > vw) {
#pragma unroll
                    for (int r = 0; r < 16; ++r) { const int c_ = (r & 3) + 8 * (r >> 2);
                        if (dq_ - c_ < 0) p0[r] = -__builtin_inff(); if (dq_ - c_ - 32 < 0) p1[r] = -__builtin_inff(); } } }
            SBAR();
            if (act_prev) pv_softmax(o, vb0 + vprev * SHM_V, q0, q1, q2, q3, p0, p1, m_reg, l_reg, alpha, pa0, pa1, pa2, pa3);
            else softmax_tile(p0, p1, m_reg, l_reg, alpha, pa0, pa1, pa2, pa3);
            SBAR(); RESC(alpha); SBAR();
            q0 = pa0; q1 = pa1; q2 = pa2; q3 = pa3;
        } else if (act_prev) { SBAR(); pv_tile(o, vb0 + vprev * SHM_V, q0, q1, q2, q3); SBAR(); }
        if (HN) { VM_WAIT(); SWRITE(kbf ^ 1); }
        __syncthreads();
        act_prev = act_; vprev = vcur; vcur = vnext;
    }
    if (act_prev) { SBAR(); pv_tile(o, vb0 + vprev * SHM_V, q0, q1, q2, q3); }
    if (MODE == 0) { if (hi == 0) u.lse[(size_t)TOKV(vq) * 12] = m_reg + log2f(l_reg); }
    store_o_rows(u.O + (size_t)TOKV(vq) * u.ldo + 8 * hi, o, __builtin_amdgcn_rcpf(l_reg));
    __syncthreads();
#undef TOKV
#undef SLOAD
#undef SWRITE
#undef RESC
}
constexpr int A2_GRP = 65536, A2_WS = 132096, A2_TAB = 134144;
template <class Gen>
__device__ __forceinline__ void attn_a2_stream(LAS char* lds, const int NU, const Gen& gen, const float* relb_g, const int wave0_) {
    const int tid = opaque_tid(), wid = __builtin_amdgcn_readfirstlane(tid >> 6), lane = tid & 63, r32 = lane & 31, hi = lane >> 5;
    const int grp = wid >> 2;
    LAS char* V_lds = lds + grp * A2_GRP; LAS char* K_lds = V_lds + 32768;
    const int wg = wid & 3, l4 = lane >> 4, kr0 = 16 * wg + l4, kc0 = ((lane & 15) ^ l4) * 8, kc1 = ((lane & 15) ^ (4 + l4)) * 8;
    const int vr0 = swap23(16 * wg + ((lane & 31) >> 2)), vr1 = swap23(16 * wg + 8 + ((lane & 31) >> 2)), vc0 = (lane >> 5) * 32 + (lane & 3) * 8;
    const int vb0 = (int)(uintptr_t)V_lds + v_rd_base(lane);
#define TOKU(U, v) ((((v) & (U).Lm) * (U).dil) + ((v) >> (U).Ls))
#define SLOADU(U, kbv, bf) do { LAS char* kd_ = K_lds + (bf) * SHM_K + wg * 4096; LAS char* vd_ = V_lds + (bf) * SHM_V + wg * 4096; \
        _Pragma("unroll") for (int i_ = 0; i_ < 4; ++i_) { int a_ = (kbv) + kr0 + 4 * i_; a_ = a_ < 0 ? 0 : a_; GLDS((U).K + (size_t)TOKU(U, a_) * (U).ldk + ((i_ & 1) ? kc1 : kc0), kd_ + i_ * 1024); } \
        _Pragma("unroll") for (int h_ = 0; h_ < 2; ++h_) { int a_ = (kbv) + (h_ ? vr1 : vr0); a_ = a_ < 0 ? 0 : a_; const bf16_t* p_ = (U).V + (size_t)TOKU(U, a_) * (U).ldk + vc0; \
            GLDS(p_, vd_ + h_ * 2048); GLDS(p_ + 64, vd_ + h_ * 2048 + 1024); } } while (0)
#define LOADQU(U) do { const bf16_t* qp_ = (U).Q + (size_t)TOKU(U, (U).v0 + wid * 32 + r32) * (U).ldq + hi * 8; \
        _Pragma("unroll") for (int d0 = 0; d0 < 8; ++d0) qr[d0] = *(const bf16x8*)(qp_ + d0 * 16); } while (0)
#define TABU(U, tb) do { const int delta = tid - 160; float val = -__builtin_inff();          \
        if (delta >= 0 && delta <= 128) { const int dist = delta * (U).dil; int bk = dist; \
            if (dist >= 16) { bk = 16 + (int)(log2f((float)dist * 0.0625f) * (16.0f / 7.0f)); bk = bk > 31 ? 31 : bk; } \
            val = relb_l[bk * 12 + (U).hh] * LOG2E; } \
        ((LAS float*)(lds + A2_TAB))[(tb) * 512 + tid] = val; } while (0)
#define RESC(a) do { if (__any((a) < 1.f)) { _Pragma("unroll") for (int d_ = 0; d_ < 4; ++d_) _Pragma("unroll") for (int r = 0; r < 16; ++r) o[d_][r] *= (a); } } while (0)
    AU u; gen(0, u);
    LAS float* relb_l = (LAS float*)(lds + A2_TAB) + 1024;
    if (tid < 384) relb_l[tid] = relb_g[tid];
    __syncthreads();
    bf16x8 qr[8];
    LOADQU(u); TABU(u, 0); SLOADU(u, u.kb0 + 128 * grp + ((grp != 0 && u.NT == 4) ? 128 : 0), 0);
    for (int iu = 0; iu < NU; ++iu) {
        const bool hasn = iu + 1 < NU; AU un = u; if (hasn) gen(iu + 1, un);
        const LAS float* tab = (const LAS float*)(lds + A2_TAB) + (iu & 1) * 512;
        const int Lm = u.Lm;
        const int vw = u.v0 + wid * 32, vq = vw + r32, qm = vq - 4 * hi;
        const int cstart = vw - (vw & Lm);
        const bool need_lim = (vw & Lm) < 128; const int lim = vq & Lm;
        const int kbg = u.kb0 + 128 * grp;
        const int ntm = u.NT - 1, rot = (grp != 0 && u.NT == 4) ? 2 : 0;
        float m_reg = -1e30f, l_reg = 0.f; f32x16 o[4] = {};
        f32x16 p0, p1; bf16x8 pa0, pa1, pa2, pa3; float alpha;
        VM_WAIT();
#pragma unroll
        for (int d0 = 0; d0 < 8; ++d0) asm volatile("" :: "v"(qr[d0]));
        __syncthreads();
#define TILE2(t, BF, LAST) do { int kbo_ = kbg + 64 * (((t) + rot) & ntm); asm volatile("" : "+s"(kbo_)); const int kb_ = kbo_; \
        const bool shr_ = rot != 0 && (t) >= 2;                       \
        const LAS char* kimg_ = (shr_ ? lds + 32768 : K_lds) + (BF) * SHM_K; const int vimg_ = (shr_ ? vb0 - A2_GRP : vb0) + (BF) * SHM_V; \
        if (!(LAST)) { if (!(rot != 0 && (t) + 1 >= 2)) SLOADU(u, kbg + 64 * (((t) + 1 + rot) & ntm), (BF) ^ 1); } \
        else if (hasn) SLOADU(un, un.kb0 + 128 * grp + ((grp != 0 && un.NT == 4) ? 128 : 0), 0); \
        const bool act_ = (kb_ <= vw + 31) && (kb_ + 63 >= vw - 128) && (kb_ + 63 >= cstart); \
        if (act_) { \
            const int dq_ = qm - kb_; SBAR(); \
            { const LAS float* tb_ = tab + (dq_ + 101);                \
              _Pragma("unroll") for (int r = 0; r < 16; ++r) { const int c_ = (r & 3) + 8 * (r >> 2); p0[r] = tb_[59 - c_]; p1[r] = tb_[27 - c_]; } \
              qkt<true>(p0, p1, kimg_, r32, hi, qr); \
              if (need_lim) { _Pragma("unroll") for (int r = 0; r < 16; ++r) { const int c_ = (r & 3) + 8 * (r >> 2); \
                  if (dq_ - c_ > lim) p0[r] = -__builtin_inff(); if (dq_ - c_ - 32 > lim) p1[r] = -__builtin_inff(); } } } } \
        if ((LAST) && hasn) { SBAR(); LOADQU(un); TABU(un, (iu + 1) & 1); SBAR(); } \
        if (act_) { \
            SBAR(); softmax_tile(p0, p1, m_reg, l_reg, alpha, pa0, pa1, pa2, pa3); \
            RESC(alpha); SBAR(); \
            pv_tile(o, vimg_, pa0, pa1, pa2, pa3); } \
        if (!(LAST)) { VM_WAIT(); __syncthreads(); } } while (0)
        int t = 0;
        for (; t + 2 < u.NT; t += 2) { TILE2(t, 0, false); TILE2(t + 1, 1, false); }
        TILE2(t, 0, false); TILE2(t + 1, 1, true);
#undef TILE2
        if (hi == 0) u.lse[(size_t)TOKU(u, vq) * 12] = m_reg + log2f(l_reg);
        store_o_rows(u.O + (size_t)TOKU(u, vq) * u.ldo + 8 * hi, o, __builtin_amdgcn_rcpf(l_reg));
        u = un;
    }
    __syncthreads();
#undef TOKU
#undef SLOADU
#undef LOADQU
#undef TABU
#undef RESC
}
}

__device__ __forceinline__ unsigned f2bf(float f) { unsigned u = __builtin_bit_cast(unsigned, f); return (u + 0x7fffu + ((u >> 16) & 1u)) >> 16; }
__device__ __forceinline__ unsigned pk2(float lo, float hi) { return f2bf(lo) | (f2bf(hi) << 16); }
__device__ __forceinline__ float wave_sum(float v) {
    v += dpp_f<0xB1>(v); v += dpp_f<0x4E>(v);
    v += dpp_f<0x141>(v); v += dpp_f<0x140>(v);
    v = xor16_add(v); v = xor32_add(v);
    return v;
}
struct TrItem { const float* wp; size_t rs; bf16_t* dp; int ldt; };
__device__ __forceinline__ void tr_load(const TrItem& t, f32x4 (&v)[8]) {
#pragma unroll
    for (int i = 0; i < 8; ++i) v[i] = *(const f32x4*)(t.wp + (size_t)(8 * i) * t.rs);
}
__device__ __forceinline__ void tr_store(const TrItem& t, const f32x4 (&v)[8], LAS float* scr, int lane) {
    const int r = lane >> 3, c4 = lane & 7;
#pragma unroll
    for (int i = 0; i < 8; ++i) { LAS float* d = scr + (8 * i + r) * 33 + 4 * c4; d[0] = v[i][0]; d[1] = v[i][1]; d[2] = v[i][2]; d[3] = v[i][3]; }
    LDS_WAIT(); asm volatile("" ::: "memory");
    const int c = lane & 7;
#pragma unroll
    for (int j = 0; j < 4; ++j) { const int n = (lane >> 3) + 8 * j; const LAS float* s = scr + (8 * c) * 33 + n;
        u32x4 o; o.x = pk2(s[0 * 33], s[1 * 33]); o.y = pk2(s[2 * 33], s[3 * 33]); o.z = pk2(s[4 * 33], s[5 * 33]); o.w = pk2(s[6 * 33], s[7 * 33]);
        *(u32x4*)(t.dp + (size_t)(8 * j) * t.ldt) = o; }
    LDS_WAIT(); asm volatile("" ::: "memory");
}
struct Args { const float* in[19]; float* out; unsigned char* ws; int ph_lo, ph_hi; };
typedef __attribute__((address_space(4))) const Args* KArgP;
__device__ __forceinline__ KArgP fresh_args() { KArgP p = (KArgP)__builtin_amdgcn_kernarg_segment_ptr(); asm volatile("" : "+s"(p)); return p; }

__device__ __forceinline__ TrItem tr_decode(KArgP args, unsigned char* ws, int lane, int it) {
    const float* w_in = args->in[4];
    int r = it; const float* src; int ldw, ldt, nkb; bf16_t* dst;
    if (r < 4608) { src = w_in + 0; ldw = INC; dst = (bf16_t*)(ws + WS_WT1); ldt = DM; nkb = 32; }
    else if ((r -= 4608) < 1536) { src = w_in + 4608; ldw = INC; dst = (bf16_t*)(ws + WS_WT2); ldt = DM; nkb = 32; }
    else if ((r -= 1536) < 3072) { src = w_in + 6144; ldw = INC; dst = (bf16_t*)(ws + WS_WT1) + (size_t)4608 * DM; ldt = DM; nkb = 32; }
    else if ((r -= 3072) < 1024) { src = w_in + 9216; ldw = INC; dst = (bf16_t*)(ws + WS_WT2) + (size_t)1536 * DM; ldt = DM; nkb = 32; }
    else if ((r -= 1024) < 1024) { src = w_in + 10248; ldw = INC; dst = (bf16_t*)(ws + WS_WT1) + (size_t)7680 * DM; ldt = DM; nkb = 32; }
    else if ((r -= 1024) < 1024) { src = w_in + 11272; ldw = INC; dst = (bf16_t*)(ws + WS_WT2) + (size_t)2560 * DM; ldt = DM; nkb = 32; }
    else if ((r -= 1024) < 6144) { src = w_in + 12296; ldw = INC; dst = (bf16_t*)(ws + WS_WT2) + (size_t)3584 * DM; ldt = DM; nkb = 32; }
    else if ((r -= 6144) < 2048) { src = args->in[14]; ldw = 2048; dst = (bf16_t*)(ws + WS_WTKV); ldt = DM; nkb = 32; }
    else if ((r -= 2048) < 1536) { src = args->in[15]; ldw = DM; dst = (bf16_t*)(ws + WS_WTP); ldt = KP; nkb = 24; }
    else if ((r -= 1536) < 1024) { src = args->in[16]; ldw = DM; dst = (bf16_t*)(ws + WS_WTP) + 1536; ldt = KP; nkb = 16; }
    else if ((r -= 1024) < 1024) { src = args->in[17]; ldw = DM; dst = (bf16_t*)(ws + WS_WTP) + 2560; ldt = KP; nkb = 16; }
    else { r -= 1024; src = args->in[18]; ldw = DM; dst = (bf16_t*)(ws + WS_WTO); ldt = DM; nkb = 32; }
    const int nb = r / nkb, kb = r - nb * nkb, k0 = 64 * kb, n0 = 32 * nb;
    TrItem t; t.wp = src + (size_t)(k0 + (lane >> 3)) * ldw + n0 + 4 * (lane & 7); t.rs = (size_t)ldw;
    t.dp = dst + (size_t)(n0 + (lane >> 3)) * ldt + k0 + 8 * (lane & 7); t.ldt = ldt; return t;
}
#define TR_LD(V, T, idx) do { if ((idx) < tot_) { T = tr_decode(args, ws, lane, MAP_((idx))); tr_load(T, V); } } while (0)
#define TR_STREAM(first, total, stride, MAPF) do { const int tot_ = (total), st_ = (stride); int j_ = (first); \
        f32x4 va_[8], vb_[8], vc_[8], vd_[8]; TrItem ta_, tb_, tc_, td_; ta_.wp = nullptr; tb_ = ta_; tc_ = ta_; td_ = ta_; \
        auto MAP_ = [](int q_) { return MAPF(q_); }; \
        TR_LD(va_, ta_, j_); TR_LD(vb_, tb_, j_ + st_); TR_LD(vc_, tc_, j_ + 2 * st_); \
        while (j_ < tot_) { \
            TR_LD(vd_, td_, j_ + 3 * st_); tr_store(ta_, va_, scr, lane); j_ += st_; if (j_ >= tot_) break; \
            TR_LD(va_, ta_, j_ + 3 * st_); tr_store(tb_, vb_, scr, lane); j_ += st_; if (j_ >= tot_) break; \
            TR_LD(vb_, tb_, j_ + 3 * st_); tr_store(tc_, vc_, scr, lane); j_ += st_; if (j_ >= tot_) break; \
            TR_LD(vc_, tc_, j_ + 3 * st_); tr_store(td_, vd_, scr, lane); j_ += st_; } } while (0)
__device__ __forceinline__ int map_p0(int r) { if (r < 4608) return r; if ((r -= 4608) < 3072) return 6144 + r; if ((r -= 3072) < 1024) return 10240 + r; return 18432 + (r - 1024); }
__device__ __forceinline__ int map_p1(int r) { if (r < 1536) return 4608 + r; if ((r -= 1536) < 1024) return 9216 + r; if ((r -= 1024) < 1024) return 11264 + r; return 12288 + (r - 1024); }
__device__ __forceinline__ int map_p3(int r) { return 20480 + r; }
constexpr int P1_SIDE = 5632;
__device__ __forceinline__ int map_p1b(int r) { return map_p1(P1_SIDE + r); }
__global__ void __launch_bounds__(512, 2) fwd_kernel(Args args_) {
    extern __shared__ __attribute__((aligned(16))) unsigned char lds_raw[];
    LAS unsigned char* lds = (LAS unsigned char*)lds_raw;
    volatile LAS unsigned* MISC = (volatile LAS unsigned*)(lds + MISC_OFF);
    const int wave0_ = __builtin_amdgcn_readfirstlane((int)threadIdx.x >> 6);
    const int G = gridDim.x; const int bx = blockIdx.x; const int vcu = (G % 8 == 0) ? (bx % 8) * (G / 8) + bx / 8 : bx;
    gu32* ctl = (gu32*)(fresh_args()->ws + WS_CTL);
    for (int i = threadIdx.x; i < (LDS_BYTES - LDSCTL_OFF) / 4; i += 512) ((LAS unsigned*)(lds + LDSCTL_OFF))[i] = 0u;
    __syncthreads();
    XcdBarrier bar; bar.bar = (unsigned*)(ctl + 4096); bar.x = 0; bar.st = nullptr;
    const int lo = fresh_args()->ph_lo, hi_ = fresh_args()->ph_hi;
    const bool one_launch = (hi_ - lo) > 1;
    if (one_launch) bar = xcd_barrier_post((unsigned*)(ctl + 4096), MISC + 8, wave0_);
#ifndef ATT_DUP
#define ATT_DUP 0
#endif
#ifndef ATT_MASK
#define ATT_MASK 7
#endif
#ifndef PH_MASK
#define PH_MASK 63
#endif
#define IN(k) (((PH_MASK >> (k)) & 1) && lo <= (k) && (k) < hi_)
#define BOTH(k) (IN(k) && IN((k) + 1))
#define GRID_BAR() xcd_barrier(bar, wave0_)

    if (IN(0)) {
        const KArgP args = fresh_args(); unsigned char* ws = args->ws; const float* x = args->in[0];
        const int tid = opaque_tid(), lane = tid & 63, wave = __builtin_amdgcn_readfirstlane(tid >> 6);
        LAS float* scr = (LAS float*)(lds + wave * 16384);
        const int gw = vcu * 8 + wave, NGW = G * 8;
        const float* w_in = args->in[4];
        TR_STREAM(gw, 10752, NGW, map_p0);
        __syncthreads();
        LAS float* wfT = (LAS float*)lds;
        { f32x4 wa[4], wb[4];
#pragma unroll
          for (int j = 0; j < 4; ++j) { const float* p = w_in + (size_t)(tid + 512 * j) * INC + 10240; wa[j] = *(const f32x4*)p; wb[j] = *(const f32x4*)(p + 4); }
#pragma unroll
          for (int j = 0; j < 4; ++j) { const int k = tid + 512 * j;
#pragma unroll
              for (int e = 0; e < 4; ++e) { wfT[e * DM + k] = wa[j][e]; wfT[(4 + e) * DM + k] = wb[j][e]; } } }
        __syncthreads();
        const float* ng = args->in[2]; const float* bfg = args->in[5];
        { const int lane_h = opaque_tid() & 63;
#define lane lane_h
        bf16_t* H = (bf16_t*)(ws + WS_H); float* F = (float*)(ws + WS_F);
#pragma unroll 1
        for (int m = gw; m < TOK; m += NGW) {
            const f32x4* xr = (const f32x4*)(x + (size_t)m * DM) + lane;
            f32x4 v[8]; float s = 0.f;
#pragma unroll
            for (int j = 0; j < 8; ++j) { v[j] = xr[64 * j]; s += (v[j][0] * v[j][0] + v[j][1] * v[j][1]) + (v[j][2] * v[j][2] + v[j][3] * v[j][3]); }
            const float rstd = 1.0f / sqrtf(wave_sum(s) * (1.f / DM) + EPS);
            u32x2* o8 = (u32x2*)(H + (size_t)m * DM) + lane;
#pragma unroll
            for (int j = 0; j < 8; ++j) { const f32x4 gj = *((const f32x4*)ng + lane + 64 * j); v[j] = (v[j] * rstd) * gj;
                u32x2 w; w.x = pk2(v[j][0], v[j][1]); w.y = pk2(v[j][2], v[j][3]); o8[64 * j] = w; }
            float fb[8];
#pragma unroll
            for (int hh = 0; hh < 8; ++hh) fb[hh] = 0.f;
#pragma unroll
            for (int j = 0; j < 8; ++j) {
#pragma unroll
                for (int hh = 0; hh < 8; ++hh) { const f32x4 w4 = *((const LAS f32x4*)(wfT + hh * DM) + lane + 64 * j); fb[hh] += (v[j][0] * w4[0] + v[j][1] * w4[1]) + (v[j][2] * w4[2] + v[j][3] * w4[3]); }
                asm volatile("" ::: "memory"); }
#pragma unroll
            for (int hh = 0; hh < 8; ++hh) { fb[hh] = wave_sum(fb[hh]); __builtin_amdgcn_sched_barrier(0); }
            if (lane < 8) { float f = fb[0];
#pragma unroll
                for (int hh = 1; hh < 8; ++hh) f = lane == hh ? fb[hh] : f;
                const float xx = f + bfg[lane]; F[(size_t)m * 8 + lane] = fminf(xx, 0.f) - log1pf(expf(-fabsf(xx))); }
        }
#undef lane
        }
        const float* mem = args->in[1]; const float* mg = args->in[3]; bf16_t* MH = (bf16_t*)(ws + WS_MH);
        { const int lane_m = opaque_tid() & 63;
#define lane lane_m
#pragma unroll 1
        for (int m = gw; m < NB * MEML; m += NGW) {
            const f32x4* xr = (const f32x4*)(mem + (size_t)m * DM) + lane;
            f32x4 v[8]; float s = 0.f;
#pragma unroll
            for (int j = 0; j < 8; ++j) { v[j] = xr[64 * j]; s += (v[j][0] * v[j][0] + v[j][1] * v[j][1]) + (v[j][2] * v[j][2] + v[j][3] * v[j][3]); }
            const float rstd = 1.0f / sqrtf(wave_sum(s) * (1.f / DM) + EPS);
            u32x2* o8 = (u32x2*)(MH + (size_t)m * DM) + lane;
#pragma unroll
            for (int j = 0; j < 8; ++j) { const f32x4 gj = *((const f32x4*)mg + lane + 64 * j); v[j] = (v[j] * rstd) * gj;
                u32x2 w; w.x = pk2(v[j][0], v[j][1]); w.y = pk2(v[j][2], v[j][3]); o8[64 * j] = w; }
        }
#undef lane
        }
        if (BOTH(0)) xcd_barrier_arrive(bar, wave0_); else __syncthreads();
        { const KArgP args = fresh_args(); unsigned char* ws = args->ws;
          const int tid = opaque_tid(), lane = tid & 63, wave = __builtin_amdgcn_readfirstlane(tid >> 6);
          LAS float* scr = (LAS float*)(lds + wave * 16384);
          TR_STREAM(vcu * 8 + wave, 9728 - P1_SIDE, G * 8, map_p1b); }
        if (BOTH(0)) xcd_barrier_wait(bar, wave0_); else __syncthreads();
    }

    if (IN(1)) {
        const KArgP args = fresh_args(); unsigned char* ws = args->ws;
        if (bx >= 192 && bx < 256) {                 const int tid = opaque_tid(), lane = tid & 63, wave = __builtin_amdgcn_readfirstlane(tid >> 6);
            const int j = bx - 192, b = j >> 3, hh = j & 7;
            const float* F = (const float*)(ws + WS_F) + ((size_t)b * SEQ) * 8 + hh; float* CS = (float*)(ws + WS_CS) + (size_t)j * SEQ;
            LAS float* wt = (LAS float*)lds;
            float a0 = F[(size_t)(4 * tid + 0) * 8], a1 = F[(size_t)(4 * tid + 1) * 8], a2 = F[(size_t)(4 * tid + 2) * 8], a3 = F[(size_t)(4 * tid + 3) * 8];
            a1 += a0; a2 += a1; a3 += a2;
            float sc = a3;
#pragma unroll
            for (int o = 1; o < 64; o <<= 1) { const float t = __shfl_up(sc, o); if (lane >= o) sc += t; }
            if (lane == 63) wt[wave] = sc;
            __syncthreads();
            float base = 0.f;
            for (int w = 0; w < wave; ++w) base += wt[w];
            const float ex = base + sc - a3;
            CS[4 * tid + 0] = (ex + a0) * LOG2E; CS[4 * tid + 1] = (ex + a1) * LOG2E; CS[4 * tid + 2] = (ex + a2) * LOG2E; CS[4 * tid + 3] = (ex + a3) * LOG2E;
            __syncthreads();
            { LAS float* scr = (LAS float*)(lds + wave * 16384);
              TR_STREAM((bx - 192) * 8 + wave, P1_SIDE, 512, map_p1); }
            __syncthreads();
        }
        EpiQKV E; E.ws = ws; E.gains[0] = args->in[8]; E.gains[1] = args->in[9]; E.gains[2] = args->in[10]; E.gains[3] = args->in[11]; E.gains[4] = args->in[12]; E.gains[5] = args->in[13]; E.lds = lds;
        { E.which = 0; pg8::Gemm g{(const bf16_t*)(ws + WS_H), (const bf16_t*)(ws + WS_WT1), DM, DM}; pg8::StaticOrder S; S.init(TOK, N1, DM, G, bx);
          pg8::gemm_phase<EpiQKV, pg8::StaticOrder>(lds, g, S, E, wave0_); }
        { E.which = 1; pg8::Gemm g{(const bf16_t*)(ws + WS_MH), (const bf16_t*)(ws + WS_WTKV), DM, DM}; pg8::StaticOrder S; S.init(NB * MEML, 2048, DM, G, (bx + 128) % G);
          pg8::gemm_phase<EpiQKV, pg8::StaticOrder>(lds, g, S, E, wave0_); }
        if (BOTH(1)) GRID_BAR();
    }

    if (IN(2)) {
        const KArgP args = fresh_args(); unsigned char* ws = args->ws;
        LAS char* al = (LAS char*)lds;
        const float* CS = (const float*)(ws + WS_CS);
        for (int v = vcu; v < 256; v += G) {
            { const int bh = v >> 2, s = v & 3, b = bh >> 3, h = bh & 7;
              for (int pass = 0; pass < 2; ++pass) { const int qb = pass ? 7 - s : s;
                  att::AU u; u.Q = (const bf16_t*)(ws + WS_QB) + (size_t)b * SEQ * BW + h * 128; u.ldq = BW;
                  u.K = (const bf16_t*)(ws + WS_KB) + (size_t)b * SEQ * BW + h * 128; u.V = (const bf16_t*)(ws + WS_VB) + (size_t)b * SEQ * BW + h * 128; u.ldk = BW;
                  u.O = (bf16_t*)(ws + WS_Y) + (size_t)b * SEQ * KP + AW + h * 128; u.ldo = KP; u.lse = nullptr; u.cs = CS + (size_t)(b * 8 + h) * SEQ; u.relb = nullptr;
                  u.v0 = qb * 256; u.Lm = 0x3fffffff; u.Ls = 30; u.dil = 1; u.kb0 = 0; u.NT = 4 * (qb + 1);
                  if (ATT_MASK & 1) att::attn_unit<1>(al, u, wave0_);
                  if (ATT_DUP & 1) att::attn_unit<1>(al, u, wave0_); } }
            { const int b = v >> 5, h = (v >> 3) & 3, qb = v & 7;
              for (int e = 0; e < 2; ++e) {
                  att::AU u; u.Q = (const bf16_t*)(ws + WS_QM) + (size_t)b * SEQ * MW + h * 256; u.ldq = MW;
                  u.K = (const bf16_t*)(ws + WS_KM) + (size_t)b * MEML * MW + h * 256; u.V = (const bf16_t*)(ws + WS_VM) + (size_t)b * MEML * MW + h * 256 + e * 128; u.ldk = MW;
                  u.O = (bf16_t*)(ws + WS_Y) + (size_t)b * SEQ * KP + AW + BW + h * 256 + e * 128; u.ldo = KP; u.lse = nullptr; u.cs = nullptr; u.relb = nullptr;
                  u.v0 = qb * 256; u.Lm = 0x3fffffff; u.Ls = 30; u.dil = 1; u.kb0 = 0; u.NT = 4;
                  if (ATT_MASK & 2) att::attn_unit<2>(al, u, wave0_);
                  if (ATT_DUP & 2) att::attn_unit<2>(al, u, wave0_); } }
            { float* const outp = args->out; const float* const relbp = args->in[7];
              auto genA = [=](int i, att::AU& u) {
                const int b = v >> 5, w_ = 32 * i + (v & 31), h = w_ / 24, rem_ = w_ - 24 * h, pat = rem_ >> 3, vb = rem_ & 7;
                u.Q = (const bf16_t*)(ws + WS_QA) + (size_t)b * SEQ * AW + h * 128; u.ldq = AW;
                u.K = (const bf16_t*)(ws + WS_KA) + (size_t)b * SEQ * AW + h * 128; u.V = (const bf16_t*)(ws + WS_VA) + (size_t)b * SEQ * AW + h * 128; u.ldk = AW;
                bf16_t* ob = pat == 0 ? (bf16_t*)outp : (pat == 1 ? (bf16_t*)outp + (size_t)TOK * AW : (bf16_t*)(ws + WS_OA2));
                u.O = ob + (size_t)b * SEQ * AW + h * 128; u.ldo = AW;
                u.lse = (float*)(ws + WS_LSE) + ((size_t)pat * TOK + (size_t)b * SEQ) * 12 + h; u.cs = nullptr; u.relb = relbp + h; u.hh = h;
                u.v0 = vb * 256; u.Ls = pat == 0 ? 11 : (pat == 1 ? 9 : 7); u.Lm = (1 << u.Ls) - 1; u.dil = pat == 0 ? 1 : (pat == 1 ? 4 : 16);
                if (pat == 2) { u.kb0 = u.v0; u.NT = 2; } else { u.kb0 = u.v0 - 128; u.NT = 4; }
              };
              if (ATT_MASK & 4) att::attn_a2_stream(al, 9, genA, relbp, wave0_);
              if (ATT_DUP & 4) att::attn_a2_stream(al, 9, genA, relbp, wave0_); }
        }
        if (BOTH(2)) xcd_barrier_arrive(bar, wave0_);
    }

    if (IN(3)) {
        const KArgP args = fresh_args(); unsigned char* ws = args->ws;
        if (bx >= 128 && bx < 256) {
            const int tid = opaque_tid(), lane = tid & 63, wave = __builtin_amdgcn_readfirstlane(tid >> 6);
            LAS float* scr = (LAS float*)(lds + wave * 16384);
            TR_STREAM((bx - 128) * 8 + wave, 5632, 1024, map_p3);
            __syncthreads();
        }
        EpiZG E; E.ws = ws; E.oa0 = (const bf16_t*)args->out; E.oa1 = (const bf16_t*)args->out + (size_t)TOK * AW; E.bgate = args->in[6]; E.wb = bar; E.lazy = BOTH(2);
        pg8::Gemm g{(const bf16_t*)(ws + WS_H), (const bf16_t*)(ws + WS_WT2), DM, DM}; pg8::StaticOrder S; S.init(TOK, N2, DM, G, bx, P3_ROT * (bx & 7));
        pg8::gemm_phase<EpiZG, pg8::StaticOrder>(lds, g, S, E, wave0_);
        if (BOTH(3)) GRID_BAR();
    }

    if (IN(4)) {
        const KArgP args = fresh_args(); unsigned char* ws = args->ws;
        EpiMerge E; E.ws = ws;
        pg8::Gemm g{(const bf16_t*)(ws + WS_Y), (const bf16_t*)(ws + WS_WTP), KP, KP}; pg8::Sub3Order S; S.init(TOK, DM, G, bx, bx & 7);
        pg8::gemm_phase<EpiMerge, pg8::Sub3Order>(lds, g, S, E, wave0_);
        if (BOTH(4)) xcd_barrier_arrive(bar, wave0_);
    }

    if (IN(5)) {
        const KArgP args = fresh_args(); unsigned char* ws = args->ws; const float* x = args->in[0];
        EpiOut E; E.x = x; E.out = args->out; E.wb = bar; E.lazy = BOTH(4);
        pg8::Gemm g{(const bf16_t*)(ws + WS_MRG), (const bf16_t*)(ws + WS_WTO), DM, DM}; pg8::StaticOrder S; S.init(TOK, DM, DM, G, bx);
        pg8::gemm_phase<EpiOut, pg8::StaticOrder>(lds, g, S, E, wave0_);
    }
#undef IN
#undef BOTH
#undef GRID_BAR
}

extern "C" void kernel_launch(void* const* d_in, const int* in_sizes, int n_in, void* d_out, int out_size, void* d_ws, size_t ws_size, hipStream_t stream) {
    static int grid = 0;
    if (grid == 0) {
        if (n_in != 19 || in_sizes[0] != TOK * DM || out_size != TOK * DM || ws_size < WS_END) {
            fprintf(stderr, "kernel_launch: shape/workspace mismatch (n_in %d, in0 %d, out %d, ws %zu, need %zu)\n", n_in, n_in > 0 ? in_sizes[0] : -1, out_size, ws_size, (size_t)WS_END); grid = -1; return; }
        int dev = 0, cus = 0;
        if (hipGetDevice(&dev) != hipSuccess || hipDeviceGetAttribute(&cus, hipDeviceAttributeMultiprocessorCount, dev) != hipSuccess) { grid = -1; return; }
        if (hipFuncSetAttribute((const void*)fwd_kernel, hipFuncAttributeMaxDynamicSharedMemorySize, LDS_BYTES) != hipSuccess) { fprintf(stderr, "kernel_launch: hipFuncSetAttribute failed\n"); grid = -1; return; }
        (void)hipGetLastError();
        grid = cus;
    }
    if (grid < 0) return;
    (void)hipMemsetAsync((char*)d_ws + WS_CTL, 0, CTL_ZERO_BYTES, stream);
    Args a{};
    for (int i = 0; i < 19; ++i) a.in[i] = (const float*)d_in[i];
    a.out = (float*)d_out; a.ws = (unsigned char*)d_ws;
#if MK_N_LAUNCHES == 1
    a.ph_lo = 0; a.ph_hi = 6;
    hipLaunchKernelGGL(fwd_kernel, dim3(grid), dim3(512), LDS_BYTES, stream, a);
#else
    for (int p = 0; p < 6; ++p) { a.ph_lo = p; a.ph_hi = p + 1; hipLaunchKernelGGL(fwd_kernel, dim3(grid), dim3(512), LDS_BYTES, stream, a);
#if defined(DUP_PHASE)
        if (p == DUP_PHASE) hipLaunchKernelGGL(fwd_kernel, dim3(grid), dim3(512), LDS_BYTES, stream, a);
#endif
    }
#endif
    const hipError_t le = hipPeekAtLastError();
    if (le != hipSuccess) fprintf(stderr, "kernel_launch: launch failed: %s\n", hipGetErrorName(le));
}
```

```cpp
#pragma clang diagnostic ignored "-Winline-asm"
#include <hip/hip_runtime.h>
#include <hip/hip_bf16.h>
#include <cstdio>
#include <cstdint>

#ifndef P3_ROT
#define P3_ROT 1
#endif
#ifndef DUP_EPI
#define DUP_EPI 0
#endif
#ifndef MK_N_LAUNCHES
#define MK_N_LAUNCHES 1
#endif

#define LAS __attribute__((address_space(3)))
#define GAS __attribute__((address_space(1)))
typedef unsigned short bf16_t;
typedef short bf16x8 __attribute__((ext_vector_type(8)));
typedef short s16x4 __attribute__((ext_vector_type(4)));
typedef float f32x4 __attribute__((ext_vector_type(4)));
typedef float f32x2 __attribute__((ext_vector_type(2)));
typedef float f32x16 __attribute__((ext_vector_type(16)));
typedef unsigned u32x4 __attribute__((ext_vector_type(4)));
typedef unsigned u32x2 __attribute__((ext_vector_type(2)));

constexpr int NB = 8, SEQ = 2048, DM = 2048, TOK = NB * SEQ;
constexpr int AW = 1536, BW = 1024, MW = 1024, MEML = 256, INC = 18440;
constexpr int N1 = 8704, N2 = 9728, KP = 3584;
constexpr float EPS = 1e-6f, LOG2E = 1.4426950408889634f;
constexpr float SCQ128 = 0.08838834764831845f * LOG2E, SCQ256 = 0.0625f * LOG2E;

constexpr size_t MiB = 1u << 20;
constexpr size_t WS_CTL = 0, CTL_ZERO_BYTES = 1 * MiB;
constexpr size_t WS_F = 1 * MiB;
constexpr size_t WS_CS = WS_F + 512 * 1024;
constexpr size_t WS_LSE = 2 * MiB;
constexpr size_t WS_KM = 5 * MiB, WS_VM = 9 * MiB;
constexpr size_t WS_WTP = 13 * MiB;
constexpr size_t WS_WTO = 27 * MiB;
constexpr size_t WS_WT2 = 35 * MiB;
constexpr size_t WS_WT1 = 73 * MiB;
constexpr size_t WS_WTKV = 107 * MiB;
constexpr size_t WS_MH = 115 * MiB;
constexpr size_t WS_OA2 = 73 * MiB;
constexpr size_t WS_H = 123 * MiB;
constexpr size_t WS_MRG = 123 * MiB;
constexpr size_t WS_QA = 187 * MiB, WS_KA = 235 * MiB, WS_VA = 283 * MiB;
constexpr size_t WS_KB = 331 * MiB, WS_VB = 363 * MiB;
constexpr size_t WS_G = 187 * MiB;
constexpr size_t WS_QB = 395 * MiB, WS_QM = 427 * MiB;
constexpr size_t WS_Y = 459 * MiB;
constexpr size_t WS_END = 571 * MiB;

constexpr int RING_BYTES = 131072;
constexpr int LDSCTL_OFF = RING_BYTES, MISC_OFF = LDSCTL_OFF + 320;
constexpr int PSUM_OFF = RING_BYTES + 1024;
constexpr int LDS_BYTES = 147456;

#define LDS_WAIT() asm volatile("s_waitcnt lgkmcnt(0)" ::: "memory")
#define VM_WAIT() asm volatile("s_waitcnt vmcnt(0)" ::: "memory")
#define RLX_AGENT __ATOMIC_RELAXED, __HIP_MEMORY_SCOPE_AGENT
typedef GAS unsigned gu32;

#define opaque_tid() opaque_tid_(wave0_)
__device__ __forceinline__ int opaque_tid_(int wave0) { int l; asm volatile("v_mbcnt_lo_u32_b32 %0, -1, 0\n\tv_mbcnt_hi_u32_b32 %0, -1, %0" : "=v"(l)); return wave0 * 64 + l; }
typedef __bf16 bf16x2_t __attribute__((ext_vector_type(2)));
__device__ __forceinline__ unsigned cvt_pk_bf16(float lo, float hi) { f32x2 v = {lo, hi}; bf16x2_t b = __builtin_convertvector(v, bf16x2_t); return __builtin_bit_cast(unsigned, b); }
template <int CTRL> __device__ __forceinline__ float dpp_f(float v) { return __int_as_float(__builtin_amdgcn_update_dpp(0, __float_as_int(v), CTRL, 0xF, 0xF, true)); }
__device__ __forceinline__ float xor16_add(float v) { auto r = __builtin_amdgcn_permlane16_swap(__float_as_uint(v), __float_as_uint(v), false, false); return __uint_as_float(r[0]) + __uint_as_float(r[1]); }
__device__ __forceinline__ float xor32_add(float v) { auto r = __builtin_amdgcn_permlane32_swap(__float_as_uint(v), __float_as_uint(v), false, false); return __uint_as_float(r[0]) + __uint_as_float(r[1]); }
__device__ __forceinline__ float bf_lo(unsigned w) { return __uint_as_float(w << 16); }
__device__ __forceinline__ float bf_hi(unsigned w) { return __uint_as_float(w & 0xffff0000u); }
__device__ __forceinline__ float fast_sigmoid(float x) { return __builtin_amdgcn_rcpf(1.0f + __builtin_amdgcn_exp2f(-x * LOG2E)); }

#define XB_TMO      128
#define XB_XCNT(j)  (256  + 64 * (j))
#define XB_XSUB(j)  (1280 + 64 * (j))
#define XB_XGEN(j)  (2304 + 64 * (j))
#define XB_TOP      3328
#define XB_TOPGEN   3392
#define XCD_BAR_WORDS 3456
#define XB_SPIN_CAP (1u << 18)
__device__ __forceinline__ unsigned xb_ld(unsigned* p)              { return __hip_atomic_load(p, __ATOMIC_RELAXED, __HIP_MEMORY_SCOPE_AGENT); }
__device__ __forceinline__ unsigned xb_add(unsigned* p, unsigned v) { return __hip_atomic_fetch_add(p, v, __ATOMIC_RELAXED, __HIP_MEMORY_SCOPE_AGENT); }
__device__ __forceinline__ unsigned xb_xcc_id() { return (unsigned)__builtin_amdgcn_s_getreg((3 << 11) | 20) & 0xFu; }
#define XB_SPIN(cond, bar) do { unsigned _sp = 0; while (cond) { __builtin_amdgcn_s_sleep(1); \
    if ((++_sp & 255u) == 0u) { if (xb_ld(&(bar)[XB_TMO])) break; if (_sp > XB_SPIN_CAP) { atomicAdd(&(bar)[XB_TMO], 1u); break; } } } } while (0)
struct XcdBarrier { unsigned* bar; unsigned x; volatile LAS unsigned* st; };
__device__ __forceinline__ XcdBarrier xcd_barrier_post(unsigned* bar, volatile LAS unsigned* st, const int wave0_) {
    XcdBarrier b; b.bar = bar; b.x = xb_xcc_id(); b.st = st;
    if (opaque_tid() == 0) (void)xb_add(&bar[XB_XCNT(b.x)], 1u);
    return b;
}
__device__ __forceinline__ void xcd_barrier_complete(unsigned* bar, unsigned x, unsigned& nloc, unsigned& nx) {
    const unsigned G = gridDim.x * gridDim.y * gridDim.z;
    unsigned sum, cnt, mine, sp = 0u;
    for (;;) {
        sum = 0u; cnt = 0u; mine = 0u;
#pragma unroll
        for (unsigned j = 0; j < 16; ++j) { const unsigned c = xb_ld(&bar[XB_XCNT(j)]); sum += c; cnt += (c > 0u) ? 1u : 0u; mine = (j == x) ? c : mine; }
        if (sum == G) break;
        __builtin_amdgcn_s_sleep(1);
        if ((++sp & 255u) == 0u) { if (xb_ld(&bar[XB_TMO])) break; if (sp > XB_SPIN_CAP) { atomicAdd(&bar[XB_TMO], 1u); break; } }
    }
    nloc = mine > 0u ? mine : 1u; nx = cnt > 0u ? cnt : 1u;
}
__device__ __forceinline__ void xcd_barrier(const XcdBarrier& b, const int wave0_) {
    asm volatile("s_waitcnt vmcnt(0)" ::: "memory");
    __syncthreads();
    if (opaque_tid() == 0) {
        unsigned* bar = b.bar;
        __builtin_amdgcn_s_waitcnt(0);
        unsigned nloc = b.st[0], nx = b.st[1];
        if (nloc == 0u) { xcd_barrier_complete(bar, b.x, nloc, nx); b.st[0] = nloc; b.st[1] = nx; }
        const unsigned old = xb_add(&bar[XB_XSUB(b.x)], 1u);
        const unsigned gen = old / nloc;
        if (old + 1u == (gen + 1u) * nloc) {
            __builtin_amdgcn_fence(__ATOMIC_RELEASE, "agent");
            asm volatile("s_waitcnt vmcnt(0)" ::: "memory");
            const unsigned og = xb_add(&bar[XB_TOP], 1u);
            const unsigned tg = og / nx;
            if (og + 1u == (tg + 1u) * nx) xb_add(&bar[XB_TOPGEN], 1u);
            else XB_SPIN(xb_ld(&bar[XB_TOPGEN]) == tg, bar);
            __builtin_amdgcn_fence(__ATOMIC_ACQUIRE, "agent");
            xb_add(&bar[XB_XGEN(b.x)], 1u);
            asm volatile("s_waitcnt vmcnt(0)" ::: "memory");
        } else {
            XB_SPIN(xb_ld(&bar[XB_XGEN(b.x)]) == gen, bar);
            __builtin_amdgcn_fence(__ATOMIC_ACQUIRE, "agent");
            asm volatile("s_waitcnt vmcnt(0)" ::: "memory");
        }
    }
    __syncthreads();
}

__device__ __forceinline__ void xcd_barrier_arrive(const XcdBarrier& b, const int wave0_) {
    asm volatile("s_waitcnt vmcnt(0)" ::: "memory");
    __syncthreads();
    if (opaque_tid() == 0) {
        unsigned* bar = b.bar;
        __builtin_amdgcn_s_waitcnt(0);
        unsigned nloc = b.st[0], nx = b.st[1];
        if (nloc == 0u) { xcd_barrier_complete(bar, b.x, nloc, nx); b.st[0] = nloc; b.st[1] = nx; }
        const unsigned old = xb_add(&bar[XB_XSUB(b.x)], 1u);
        const unsigned gen = old / nloc;
        unsigned role = 0u, tg = 0u;
        if (old + 1u == (gen + 1u) * nloc) {
            __builtin_amdgcn_fence(__ATOMIC_RELEASE, "agent");
            asm volatile("s_waitcnt vmcnt(0)" ::: "memory");
            const unsigned og = xb_add(&bar[XB_TOP], 1u);
            tg = og / nx;
            if (og + 1u == (tg + 1u) * nx) { xb_add(&bar[XB_TOPGEN], 1u); xb_add(&bar[XB_XGEN(b.x)], 1u); role = 2u; } else role = 1u;
        }
        b.st[2] = gen; b.st[3] = tg; b.st[4] = role;
    }
}
__device__ __forceinline__ void xcd_barrier_wait(const XcdBarrier& b, const int wave0_) {
    if (opaque_tid() == 0) {
        unsigned* bar = b.bar; const unsigned gen = b.st[2], tg = b.st[3], role = b.st[4];
        if (role == 1u) { XB_SPIN(xb_ld(&bar[XB_TOPGEN]) == tg, bar); __builtin_amdgcn_fence(__ATOMIC_ACQUIRE, "agent"); xb_add(&bar[XB_XGEN(b.x)], 1u); }
        else if (role == 0u) { XB_SPIN(xb_ld(&bar[XB_XGEN(b.x)]) == gen, bar); __builtin_amdgcn_fence(__ATOMIC_ACQUIRE, "agent"); }
        else __builtin_amdgcn_fence(__ATOMIC_ACQUIRE, "agent");
    }
    __syncthreads();
}

namespace pg8 {
constexpr int BM = 256, BK = 64, HALF = 128, HTB = HALF * BK * 2, STAGE_BYTES = 8 * HTB, NXCD = 8, WGM = 8;
__host__ __device__ __forceinline__ int lds_byte(int r, int c) { const int st = (r >> 4) * 2 + (c >> 5), rr = r & 15, cc = c & 31, ob = rr * 64 + cc * 2; return st * 1024 + (ob ^ (((ob >> 9) & 1) << 5)); }
__host__ __device__ __forceinline__ void stage_rc(int b, int& R, int& C) { const int st = b / 1024, sb = b % 1024, swz = sb ^ (((sb >> 9) & 1) << 5); R = (st >> 1) * 16 + swz / 64; C = (st & 1) * 32 + (swz % 64) / 2; }
__host__ __device__ __forceinline__ int perm32(int rho) { const int n = rho >> 4, i = rho & 15; return 8 * (i >> 2) + 4 * n + (i & 3); }

struct Unit { int pm, pn, koff, nt, first, tag; };
struct Gemm { const bf16_t* A; const bf16_t* Bt; int lda, ldb; };

__device__ __forceinline__ void tile_of(int L, int nM, int nN, int& pm, int& pn) {
    const int nwg = nM * nN; int wgid = L;
    { const int q = nwg / NXCD, r = nwg % NXCD, xcd = wgid % NXCD, off = wgid / NXCD; wgid = (xcd < r ? xcd * (q + 1) : r * (q + 1) + (xcd - r) * q) + off; }
    const int nig = WGM * nN, gid = wgid / nig, fm = gid * WGM, gsz = (nM - fm) < WGM ? (nM - fm) : WGM;
    pm = fm + ((wgid % nig) % gsz); pn = (wgid % nig) / gsz;
}
struct StaticOrder {
    int nM, nN, nwg, G, c, nt, nu, rot;
    __device__ __forceinline__ void init(int M, int N, int K, int G_, int c_, int rot_ = 0) { nM = M / BM; nN = N / BM; nwg = nM * nN; G = G_; c = c_; nt = K / BK;
        nu = c < nwg ? (nwg - 1 - c) / G + 1 : 0; rot = nu > 0 ? rot_ % nu : 0; }
    __device__ __forceinline__ bool next(int i, Unit& u) const {
        if (i >= nu) return false; int ir = i + rot; if (ir >= nu) ir -= nu;
        const long L = (long)ir * G + c;
        tile_of((int)L, nM, nN, u.pm, u.pn); u.koff = 0; u.nt = nt; u.first = 1; u.tag = 0; return true;
    }
};
struct Sub3Order {
    int nM, nN, nwg, G, c, perm;
    __device__ __forceinline__ void init(int M, int N, int G_, int c_, int perm_) { nM = M / BM; nN = N / BM; nwg = nM * nN; G = G_; c = c_; perm = perm_ % 3; }
    __device__ __forceinline__ bool next(int i, Unit& u) const {
        const int ti = i / 3, s = i - 3 * ti; const long L = (long)ti * G + c; if (L >= nwg) return false;
        tile_of((int)L, nM, nN, u.pm, u.pn);
        int br = s + perm; if (br >= 3) br -= 3; int brn = br + 1; if (brn >= 3) brn -= 3;
        u.koff = br == 0 ? 0 : (br == 1 ? 1536 : 2560); u.nt = br == 0 ? 24 : 16; u.first = s == 0; u.tag = br | (brn << 2) | ((s == 2) << 4); return true;
    }
};

template <class Epi, class Sched>
__device__ __forceinline__ void gemm_phase(LAS unsigned char* lds, const Gemm g, const Sched& S, const Epi& E, const int wave0_) {
    const int tid = opaque_tid(), wid = __builtin_amdgcn_readfirstlane(tid >> 6), lane = tid & 63, wr = wid >> 2, wc = wid & 3, fr = lane & 15, fq = lane >> 4;
    unsigned voffA[2], voffB[2];
#pragma unroll
    for (int i = 0; i < 2; ++i) { int R, C; stage_rc(tid * 16 + i * 8192, R, C); const int Rb = Epi::PERM ? ((R & ~31) + perm32(R & 31)) : R;
        voffA[i] = (unsigned)(R * g.lda + C) * 2u; voffB[i] = (unsigned)(Rb * g.ldb + C) * 2u; }
    const size_t kstep = (size_t)(BK * 2);
    const size_t hstepA = (size_t)HALF * g.lda * 2, hstepB = (size_t)HALF * g.ldb * 2;
    const size_t tstepA = 2 * hstepA, tstepB = 2 * hstepB;
    const unsigned ldsw = (unsigned)wid * 1024u;
    const int aoff = lds_byte(wr * 64 + fr, fq * 8), boff = lds_byte(wc * 32 + fr, fq * 8);
#define PG8_SA(b, h) (((b) * 2 + (h)) * HTB)
#define PG8_SB(b, h) ((4 + (b) * 2 + (h)) * HTB)
#define PG8_STAGE(bufoff, gbase, voff) do { _Pragma("unroll") for (int _i = 0; _i < 2; ++_i) \
        __builtin_amdgcn_global_load_lds((const unsigned*)((const char*)(gbase) + (voff)[_i]), (LAS unsigned*)(lds + (bufoff) + ldsw + _i * 8192), 16, 0, 0); } while (0)
#define PG8_LDA(dst, b, h) do { _Pragma("unroll") for (int m = 0; m < 4; ++m) _Pragma("unroll") for (int k = 0; k < 2; ++k) dst[m][k] = *(const LAS bf16x8*)(lds + PG8_SA(b, h) + aoff + m * 2048 + k * 1024); } while (0)
#define PG8_LDB(dst, b, h) do { _Pragma("unroll") for (int n = 0; n < 2; ++n) _Pragma("unroll") for (int k = 0; k < 2; ++k) dst[n][k] = *(const LAS bf16x8*)(lds + PG8_SB(b, h) + boff + n * 2048 + k * 1024); } while (0)
#define PG8_MMA(ai, bj, At, Bt) do { __builtin_amdgcn_s_setprio(1); _Pragma("unroll") for (int m = 0; m < 4; ++m) _Pragma("unroll") for (int n = 0; n < 2; ++n) _Pragma("unroll") for (int k = 0; k < 2; ++k) \
        acc[ai][bj][m][n] = __builtin_amdgcn_mfma_f32_16x16x32_bf16(Bt[n][k], At[m][k], acc[ai][bj][m][n], 0, 0, 0); __builtin_amdgcn_s_setprio(0); } while (0)
#define PG8_WAIT_V(n) asm volatile("s_waitcnt vmcnt(" #n ")" ::: "memory")
#define PG8_WAIT_L(n) asm volatile("s_waitcnt lgkmcnt(" #n ")" ::: "memory")
#define PG8_BAR __builtin_amdgcn_s_barrier()
#define PG8_SCHED __builtin_amdgcn_sched_barrier(0)
    Unit cur, nxt; int ui = 0;
    if (!S.next(0, cur)) return;
    f32x4 acc[2][2][4][2];
#pragma unroll
    for (int a = 0; a < 2; ++a)
#pragma unroll
        for (int b = 0; b < 2; ++b)
#pragma unroll
            for (int m = 0; m < 4; ++m)
#pragma unroll
                for (int n = 0; n < 2; ++n) acc[a][b][m][n] = (f32x4){0.f, 0.f, 0.f, 0.f};
    if constexpr (Epi::ACCINIT) { E.acc_init(acc, cur, wr, wc, fr, fq); cur.tag |= 256; }
    if constexpr (Epi::PREWAIT) E.pre_wait(wave0_);
    u32x4 carry_[Epi::CARRY ? 8 : 1];
    bf16x8 At[4][2], B0[2][2], B1[2][2];
    const char* cA = (const char*)g.A + (size_t)cur.pm * tstepA + (size_t)cur.koff * 2; const char* cB = (const char*)g.Bt + (size_t)cur.pn * tstepB + (size_t)cur.koff * 2;
    PG8_STAGE(PG8_SB(0, 0), cB, voffB); PG8_STAGE(PG8_SB(0, 1), cB + hstepB, voffB); PG8_STAGE(PG8_SA(0, 0), cA, voffA); PG8_STAGE(PG8_SA(0, 1), cA + hstepA, voffA);
    if (wr == 1) PG8_BAR;
    PG8_WAIT_V(2); PG8_BAR;
    PG8_STAGE(PG8_SB(1, 0), cB + kstep, voffB); PG8_STAGE(PG8_SA(1, 0), cA + kstep, voffA); PG8_STAGE(PG8_SB(1, 1), cB + hstepB + kstep, voffB);
    PG8_WAIT_V(6); PG8_BAR;
    for (;;) {
        const bool has_next = S.next(ui + 1, nxt);
        const char* nA = has_next ? (const char*)g.A + (size_t)nxt.pm * tstepA + (size_t)nxt.koff * 2 : cA; const char* nB = has_next ? (const char*)g.Bt + (size_t)nxt.pn * tstepB + (size_t)nxt.koff * 2 : cB;
        const int nt = cur.nt;
        for (int t = 0; t < nt; t += 2) {
            const bool last = (t == nt - 2);
            const char* a1 = cA + (size_t)(t + 1) * kstep;
            const char* a2 = last ? nA : cA + (size_t)(t + 2) * kstep; const char* b2 = last ? nB : cB + (size_t)(t + 2) * kstep;
            const char* a3 = a2 + kstep; const char* b3 = b2 + kstep;
            PG8_LDB(B0, 0, 0); PG8_LDB(B1, 0, 1); PG8_SCHED; PG8_LDA(At, 0, 0); PG8_STAGE(PG8_SA(1, 1), a1 + hstepA, voffA);
            PG8_WAIT_V(8); PG8_WAIT_L(0); PG8_BAR; PG8_MMA(0, 0, At, B0); PG8_MMA(0, 1, At, B1); PG8_BAR; PG8_SCHED;
            PG8_LDA(At, 0, 1); PG8_STAGE(PG8_SB(0, 0), b2, voffB); PG8_STAGE(PG8_SB(0, 1), b2 + hstepB, voffB); PG8_STAGE(PG8_SA(0, 0), a2, voffA);
            PG8_WAIT_V(8); PG8_WAIT_L(0); PG8_BAR; PG8_MMA(1, 0, At, B0); PG8_MMA(1, 1, At, B1); PG8_BAR; PG8_SCHED;
            PG8_LDB(B0, 1, 0); PG8_LDB(B1, 1, 1); PG8_SCHED; PG8_LDA(At, 1, 0); PG8_STAGE(PG8_SA(0, 1), a2 + hstepA, voffA);
            PG8_WAIT_V(8); PG8_WAIT_L(0); PG8_BAR; PG8_MMA(0, 0, At, B0); PG8_MMA(0, 1, At, B1); PG8_BAR; PG8_SCHED;
            PG8_LDA(At, 1, 1); PG8_STAGE(PG8_SB(1, 0), b3, voffB); PG8_STAGE(PG8_SB(1, 1), b3 + hstepB, voffB); PG8_STAGE(PG8_SA(1, 0), a3, voffA);
            PG8_WAIT_V(8); PG8_WAIT_L(0); PG8_BAR; PG8_MMA(1, 0, At, B0); PG8_MMA(1, 1, At, B1); PG8_BAR; PG8_SCHED;
        }
        if (wr == 0) PG8_BAR;
        if constexpr (Epi::LAZYBAR) { if (ui == 0) E.lazy_wait(wave0_); }
        if constexpr (Epi::CARRY) E.call(acc, cur, wr, wc, fr, fq, wid, lane, carry_);
        else { E(acc, cur, wr, wc, fr, fq, wid, lane);
        if (Epi::DUP) E(acc, cur, wr, wc, fr, fq, wid, lane); }
        if (!has_next) break;
        if (nxt.first) {
#pragma unroll
            for (int a = 0; a < 2; ++a)
#pragma unroll
                for (int b = 0; b < 2; ++b)
#pragma unroll
                    for (int m = 0; m < 4; ++m)
#pragma unroll
                        for (int n = 0; n < 2; ++n) acc[a][b][m][n] = (f32x4){0.f, 0.f, 0.f, 0.f};
        }
        cur = nxt; cA = nA; cB = nB; ++ui;
        if (wr == 1) PG8_BAR;
    }
    PG8_WAIT_V(0);
    PG8_BAR;
#undef PG8_SA
#undef PG8_SB
#undef PG8_STAGE
#undef PG8_LDA
#undef PG8_LDB
#undef PG8_MMA
#undef PG8_WAIT_V
#undef PG8_WAIT_L
#undef PG8_BAR
#undef PG8_SCHED
}
}

typedef f32x4 AccT[2][2][4][2];

struct EpiQKV {
    static constexpr bool PERM = true, DUP = (DUP_EPI == 1), LAZYBAR = false, ACCINIT = false, PREWAIT = false, CARRY = false;
    unsigned char* ws; const float* gains[6]; int which;
    LAS unsigned char* lds;
    __device__ __forceinline__ void operator()(AccT& acc, const pg8::Unit& u, int wr, int wc, int fr, int fq, int wid, int lane) const {
        int mode, ldc, col; bf16_t* O; const float* gain = nullptr; float sc = 1.f; const int pn = u.pn;
        if (which == 0) {
            if (pn < 6)       { mode = 1; O = (bf16_t*)(ws + WS_QA); ldc = AW; col = pn * 256;        gain = gains[0]; sc = SCQ128; }
            else if (pn < 12) { mode = 1; O = (bf16_t*)(ws + WS_KA); ldc = AW; col = (pn - 6) * 256;  gain = gains[1]; }
            else if (pn < 18) { mode = 0; O = (bf16_t*)(ws + WS_VA); ldc = AW; col = (pn - 12) * 256; }
            else if (pn < 22) { mode = 1; O = (bf16_t*)(ws + WS_QB); ldc = BW; col = (pn - 18) * 256; gain = gains[2]; sc = SCQ128; }
            else if (pn < 26) { mode = 1; O = (bf16_t*)(ws + WS_KB); ldc = BW; col = (pn - 22) * 256; gain = gains[3]; }
            else if (pn < 30) { mode = 0; O = (bf16_t*)(ws + WS_VB); ldc = BW; col = (pn - 26) * 256; }
            else              { mode = 2; O = (bf16_t*)(ws + WS_QM); ldc = MW; col = (pn - 30) * 256; gain = gains[4]; sc = SCQ256; }
        } else {
            if (pn < 4)       { mode = 2; O = (bf16_t*)(ws + WS_KM); ldc = MW; col = pn * 256;        gain = gains[5]; }
            else              { mode = 0; O = (bf16_t*)(ws + WS_VM); ldc = MW; col = (pn - 4) * 256; }
        }
        float rs[2][4][2];
        if (mode != 0) {
            LAS float* P = (LAS float*)(lds + PSUM_OFF);
#pragma unroll
            for (int ai = 0; ai < 2; ++ai)
#pragma unroll
                for (int m = 0; m < 4; ++m)
#pragma unroll
                    for (int bj = 0; bj < 2; ++bj) {
                        const f32x4 a = acc[ai][bj][m][0], b = acc[ai][bj][m][1];
                        float s = (a[0] * a[0] + a[1] * a[1]) + (a[2] * a[2] + a[3] * a[3]) + (b[0] * b[0] + b[1] * b[1]) + (b[2] * b[2] + b[3] * b[3]);
                        s = xor16_add(s); s = xor32_add(s);
                        if (fq == 0) P[((ai * 128 + wr * 64 + m * 16 + fr) * 2 + bj) * 4 + wc] = s;
                    }
            asm volatile("s_waitcnt lgkmcnt(0)" ::: "memory"); __builtin_amdgcn_s_barrier(); asm volatile("" ::: "memory");
#pragma unroll
            for (int ai = 0; ai < 2; ++ai)
#pragma unroll
                for (int m = 0; m < 4; ++m) {
                    const LAS f32x4* pr = (const LAS f32x4*)(P + (ai * 128 + wr * 64 + m * 16 + fr) * 8);
                    const f32x4 s0 = pr[0], s1 = pr[1];
                    const float t0 = (s0[0] + s0[1]) + (s0[2] + s0[3]), t1 = (s1[0] + s1[1]) + (s1[2] + s1[3]);
                    if (mode == 1) { rs[ai][m][0] = sc * __builtin_amdgcn_rsqf(t0 * (1.f / 128.f) + EPS); rs[ai][m][1] = sc * __builtin_amdgcn_rsqf(t1 * (1.f / 128.f) + EPS); }
                    else { const float r = sc * __builtin_amdgcn_rsqf((t0 + t1) * (1.f / 256.f) + EPS); rs[ai][m][0] = r; rs[ai][m][1] = r; }
                }
        }
        const int row0 = u.pm * 256 + wr * 64 + fr, col0 = col + wc * 32 + 8 * fq;
        f32x4 gv[2][2];
#pragma unroll
        for (int bj = 0; bj < 2; ++bj)
#pragma unroll
            for (int n = 0; n < 2; ++n) {
                if (mode == 0) gv[bj][n] = (f32x4){1.f, 1.f, 1.f, 1.f};
                else { const int gc = (mode == 1 ? 0 : bj * 128) + wc * 32 + 8 * fq + 4 * n; gv[bj][n] = *(const f32x4*)(gain + gc); }
            }
#pragma unroll
        for (int ai = 0; ai < 2; ++ai)
#pragma unroll
            for (int m = 0; m < 4; ++m) { bf16_t* rowp = O + (size_t)(row0 + ai * 128 + m * 16) * ldc + col0;
#pragma unroll
                for (int bj = 0; bj < 2; ++bj) {
                    f32x4 v0 = acc[ai][bj][m][0] * gv[bj][0], v1 = acc[ai][bj][m][1] * gv[bj][1];
                    if (mode != 0) { const float r = rs[ai][m][bj]; v0 = v0 * r; v1 = v1 * r; }
                    u32x4 w; w.x = cvt_pk_bf16(v0[0], v0[1]); w.y = cvt_pk_bf16(v0[2], v0[3]); w.z = cvt_pk_bf16(v1[0], v1[1]); w.w = cvt_pk_bf16(v1[2], v1[3]);
                    *(u32x4*)(rowp + bj * 128) = w; } }
    }
};

struct EpiZG {
    static constexpr bool PERM = true, DUP = false, LAZYBAR = true, ACCINIT = false, PREWAIT = false, CARRY = false;
    unsigned char* ws; const bf16_t* oa0; const bf16_t* oa1; const float* bgate;
    XcdBarrier wb; bool lazy;
    __device__ __forceinline__ void lazy_wait(const int wave0_) const { if (lazy) xcd_barrier_wait(wb, wave0_); }
    __device__ __forceinline__ void operator()(AccT& acc, const pg8::Unit& u, int wr, int wc, int fr, int fq, int wid, int lane) const {
        const int pn = u.pn; const int row0 = u.pm * 256 + wr * 64 + fr, cw = wc * 32 + 8 * fq;
        bf16_t* Y = (bf16_t*)(ws + WS_Y);
        if (pn < 6) {
            const bf16_t* oa2 = (const bf16_t*)(ws + WS_OA2); const float* lse = (const float*)(ws + WS_LSE);
#pragma unroll
            for (int ab = 0; ab < 4; ++ab) { const int ai = ab >> 1, m0 = (ab & 1) * 2;
                float L[2][2][3]; u32x4 P[2][2][3];
#pragma unroll
                for (int mm = 0; mm < 2; ++mm) { const int row = row0 + ai * 128 + (m0 + mm) * 16;
#pragma unroll
                    for (int bj = 0; bj < 2; ++bj) { const int head = 2 * pn + bj, c = pn * 256 + bj * 128 + cw;
                        L[mm][bj][0] = lse[(size_t)row * 12 + head]; L[mm][bj][1] = lse[((size_t)TOK + row) * 12 + head]; L[mm][bj][2] = lse[((size_t)2 * TOK + row) * 12 + head];
                        P[mm][bj][0] = *(const u32x4*)(oa0 + (size_t)row * AW + c); P[mm][bj][1] = *(const u32x4*)(oa1 + (size_t)row * AW + c); P[mm][bj][2] = *(const u32x4*)(oa2 + (size_t)row * AW + c); } }
                asm volatile("" ::: "memory");
#pragma unroll
                for (int mm = 0; mm < 2; ++mm) { const int m = m0 + mm, row = row0 + ai * 128 + m * 16;
#pragma unroll
                    for (int bj = 0; bj < 2; ++bj) { const int c = pn * 256 + bj * 128 + cw;
                        const float l0 = L[mm][bj][0], l1 = L[mm][bj][1], l2 = L[mm][bj][2];
                        const float mx = fmaxf(l0, fmaxf(l1, l2));
                        float w0 = __builtin_amdgcn_exp2f(l0 - mx), w1 = __builtin_amdgcn_exp2f(l1 - mx), w2 = __builtin_amdgcn_exp2f(l2 - mx);
                        const float inv = __builtin_amdgcn_rcpf(w0 + w1 + w2); w0 *= inv; w1 *= inv; w2 *= inv;
                        const u32x4 p0 = P[mm][bj][0], p1 = P[mm][bj][1], p2 = P[mm][bj][2];
                        const f32x4 z0 = acc[ai][bj][m][0], z1 = acc[ai][bj][m][1]; float y[8];
#pragma unroll
                        for (int j = 0; j < 4; ++j) { const unsigned a = p0[j], b = p1[j], d = p2[j];
                            const float olo = w0 * bf_lo(a) + w1 * bf_lo(b) + w2 * bf_lo(d), ohi = w0 * bf_hi(a) + w1 * bf_hi(b) + w2 * bf_hi(d);
                            const float zl = j < 2 ? z0[2 * j] : z1[2 * j - 4], zh = j < 2 ? z0[2 * j + 1] : z1[2 * j - 3];
                            y[2 * j] = olo * zl * fast_sigmoid(zl); y[2 * j + 1] = ohi * zh * fast_sigmoid(zh); }
                        u32x4 w; w.x = cvt_pk_bf16(y[0], y[1]); w.y = cvt_pk_bf16(y[2], y[3]); w.z = cvt_pk_bf16(y[4], y[5]); w.w = cvt_pk_bf16(y[6], y[7]);
                        *(u32x4*)(Y + (size_t)row * KP + c) = w; } }
                asm volatile("" ::: "memory"); }
        } else if (pn < 14) {
            const int cb = (pn < 10 ? AW + (pn - 6) * 256 : AW + BW + (pn - 10) * 256) + cw;
#pragma unroll
            for (int ai = 0; ai < 2; ++ai) { u32x4 P[4][2];
#pragma unroll
                for (int m = 0; m < 4; ++m) { const bf16_t* rowp = Y + (size_t)(row0 + ai * 128 + m * 16) * KP + cb;
#pragma unroll
                    for (int bj = 0; bj < 2; ++bj) P[m][bj] = *(const u32x4*)(rowp + bj * 128); }
                asm volatile("" ::: "memory");
#pragma unroll
                for (int m = 0; m < 4; ++m) { bf16_t* rowp = Y + (size_t)(row0 + ai * 128 + m * 16) * KP + cb;
#pragma unroll
                    for (int bj = 0; bj < 2; ++bj) { const u32x4 p = P[m][bj];
                        const f32x4 z0 = acc[ai][bj][m][0], z1 = acc[ai][bj][m][1]; float y[8];
#pragma unroll
                        for (int j = 0; j < 4; ++j) { const float zl = j < 2 ? z0[2 * j] : z1[2 * j - 4], zh = j < 2 ? z0[2 * j + 1] : z1[2 * j - 3];
                            y[2 * j] = bf_lo(p[j]) * zl * fast_sigmoid(zl); y[2 * j + 1] = bf_hi(p[j]) * zh * fast_sigmoid(zh); }
                        u32x4 w; w.x = cvt_pk_bf16(y[0], y[1]); w.y = cvt_pk_bf16(y[2], y[3]); w.z = cvt_pk_bf16(y[4], y[5]); w.w = cvt_pk_bf16(y[6], y[7]);
                        *(u32x4*)(rowp + bj * 128) = w; } }
                asm volatile("" ::: "memory"); }
        } else {
            const int idx = pn - 14, br = idx >> 3, cg = (idx & 7) * 256 + cw;
            unsigned char* G8 = (unsigned char*)(ws + WS_G) + (size_t)br * TOK * DM + (idx & 7) * 256 + (wc * 4 + fq) * 16; const float* bg = bgate + br * DM + cg;
            f32x4 bv[2][2];
#pragma unroll
            for (int bj = 0; bj < 2; ++bj)
#pragma unroll
                for (int n = 0; n < 2; ++n) bv[bj][n] = *(const f32x4*)(bg + bj * 128 + 4 * n);
#define GQ8(x) fmaxf(255.f * fast_sigmoid(x), 1.f)
#define PK8(v) __builtin_amdgcn_cvt_pk_u8_f32(GQ8(v[3]), 3, __builtin_amdgcn_cvt_pk_u8_f32(GQ8(v[2]), 2, __builtin_amdgcn_cvt_pk_u8_f32(GQ8(v[1]), 1, __builtin_amdgcn_cvt_pk_u8_f32(GQ8(v[0]), 0, 0u))))
#pragma unroll
            for (int ai = 0; ai < 2; ++ai)
#pragma unroll
                for (int m = 0; m < 4; ++m) { u32x4 w;
                    { const f32x4 v0 = acc[ai][0][m][0] + bv[0][0], v1 = acc[ai][0][m][1] + bv[0][1]; w.x = PK8(v0); w.y = PK8(v1); }
                    { const f32x4 v0 = acc[ai][1][m][0] + bv[1][0], v1 = acc[ai][1][m][1] + bv[1][1]; w.z = PK8(v0); w.w = PK8(v1); }
                    *(u32x4*)(G8 + (size_t)(row0 + ai * 128 + m * 16) * DM) = w; }
#undef PK8
#undef GQ8
        }
    }
};

struct EpiMerge {
    static constexpr bool PERM = true, DUP = false, LAZYBAR = false, ACCINIT = false, PREWAIT = false, CARRY = true;
    unsigned char* ws;
    __device__ __forceinline__ void call(AccT& acc, const pg8::Unit& u, int wr, int wc, int fr, int fq, int wid, int lane, u32x4 (&cy)[8]) const {
        const int br = u.tag & 3, brn = (u.tag >> 2) & 3; const bool last = (u.tag >> 4) != 0, first = u.first != 0;
        const int row0 = u.pm * 256 + wr * 64 + fr, c0 = u.pn * 256 + wc * 32 + 8 * fq;
        const unsigned char* Ga = (const unsigned char*)(ws + WS_G) + (size_t)br * TOK * DM + u.pn * 256 + (wc * 4 + fq) * 16;
        const unsigned char* Gb = (const unsigned char*)(ws + WS_G) + (size_t)brn * TOK * DM + u.pn * 256 + (wc * 4 + fq) * 16;
        bf16_t* Mg = (bf16_t*)(ws + WS_MRG);
#define UB(w, k) ((float)(((w) >> (8 * (k))) & 0xffu))
#pragma unroll
        for (int ai = 0; ai < 2; ++ai) { u32x4 ga[4], gb[4];
            if (first) {
#pragma unroll
                for (int m = 0; m < 4; ++m) ga[m] = *(const u32x4*)(Ga + (size_t)(row0 + ai * 128 + m * 16) * DM);
            } else {
#pragma unroll
                for (int m = 0; m < 4; ++m) ga[m] = cy[ai * 4 + m];
            }
            if (!last) {
#pragma unroll
                for (int m = 0; m < 4; ++m) gb[m] = *(const u32x4*)(Gb + (size_t)(row0 + ai * 128 + m * 16) * DM);
            } else {
#pragma unroll
                for (int m = 0; m < 4; ++m) gb[m] = ga[m];
            }
            asm volatile("" ::: "memory");
#pragma unroll
            for (int m = 0; m < 4; ++m) { const size_t off = (size_t)(row0 + ai * 128 + m * 16) * DM + c0;
#pragma unroll
                for (int bj = 0; bj < 2; ++bj) { float f[8];
#pragma unroll
                    for (int j = 0; j < 8; ++j) { const unsigned wa = ga[m][2 * bj + (j >> 2)], wb = gb[m][2 * bj + (j >> 2)];
                        f[j] = UB(wa, j & 3) * (last ? (1.f / 255.f) : __builtin_amdgcn_rcpf(UB(wb, j & 3))); }
                    f32x4 v0 = acc[ai][bj][m][0], v1 = acc[ai][bj][m][1];
                    v0 = v0 * (f32x4){f[0], f[1], f[2], f[3]}; v1 = v1 * (f32x4){f[4], f[5], f[6], f[7]};
                    acc[ai][bj][m][0] = v0; acc[ai][bj][m][1] = v1;
                    if (last) { u32x4 w; w.x = cvt_pk_bf16(v0[0], v0[1]); w.y = cvt_pk_bf16(v0[2], v0[3]); w.z = cvt_pk_bf16(v1[0], v1[1]); w.w = cvt_pk_bf16(v1[2], v1[3]);
                        *(u32x4*)(Mg + off + bj * 128) = w; } }
                cy[ai * 4 + m] = gb[m]; }
            asm volatile("" ::: "memory"); }
#undef UB
    }
    __device__ __forceinline__ void operator()(AccT&, const pg8::Unit&, int, int, int, int, int, int) const {}
};

struct EpiOut {
    static constexpr bool PERM = false, DUP = (DUP_EPI == 5), LAZYBAR = false, ACCINIT = true, PREWAIT = true, CARRY = false;
    const float* x; float* out;
    XcdBarrier wb; bool lazy;
    __device__ __forceinline__ void pre_wait(const int wave0_) const { if (lazy) xcd_barrier_wait(wb, wave0_); }
    __device__ __forceinline__ void acc_init(AccT& acc, const pg8::Unit& u, int wr, int wc, int fr, int fq) const {
        const int row0 = u.pm * 256 + wr * 64 + fr, col0 = u.pn * 256 + wc * 32 + 4 * fq;
#pragma unroll
        for (int ai = 0; ai < 2; ++ai)
#pragma unroll
            for (int m = 0; m < 4; ++m) { const size_t off = (size_t)(row0 + ai * 128 + m * 16) * DM + col0;
#pragma unroll
                for (int bj = 0; bj < 2; ++bj)
#pragma unroll
                    for (int n = 0; n < 2; ++n) acc[ai][bj][m][n] = *(const f32x4*)(x + off + bj * 128 + n * 16); }
    }
    __device__ __forceinline__ void operator()(AccT& acc, const pg8::Unit& u, int wr, int wc, int fr, int fq, int wid, int lane) const {
        const int row0 = u.pm * 256 + wr * 64 + fr, col0 = u.pn * 256 + wc * 32 + 4 * fq;
        if (u.tag & 256) {
#pragma unroll
            for (int ai = 0; ai < 2; ++ai)
#pragma unroll
                for (int m = 0; m < 4; ++m) { const size_t off = (size_t)(row0 + ai * 128 + m * 16) * DM + col0;
#pragma unroll
                    for (int bj = 0; bj < 2; ++bj)
#pragma unroll
                        for (int n = 0; n < 2; ++n) *(f32x4*)(out + off + bj * 128 + n * 16) = acc[ai][bj][m][n]; }
            return;
        }
#pragma unroll
        for (int ab = 0; ab < 2; ++ab) { const int ai = ab, m0 = 0; f32x4 xv[4][2][2];
#pragma unroll
            for (int mm = 0; mm < 4; ++mm) { const size_t off = (size_t)(row0 + ai * 128 + (m0 + mm) * 16) * DM + col0;
#pragma unroll
                for (int bj = 0; bj < 2; ++bj)
#pragma unroll
                    for (int n = 0; n < 2; ++n) xv[mm][bj][n] = *(const f32x4*)(x + off + bj * 128 + n * 16); }
            asm volatile("" ::: "memory");
#pragma unroll
            for (int mm = 0; mm < 4; ++mm) { const size_t off = (size_t)(row0 + ai * 128 + (m0 + mm) * 16) * DM + col0;
#pragma unroll
                for (int bj = 0; bj < 2; ++bj)
#pragma unroll
                    for (int n = 0; n < 2; ++n) *(f32x4*)(out + off + bj * 128 + n * 16) = xv[mm][bj][n] + acc[ai][bj][m0 + mm][n]; }
            asm volatile("" ::: "memory"); }
    }
};

namespace att {
#define KSWZ(row, colB) ((row) * 256 + ((colB) ^ (((row) & 7) << 4)))
#define SBAR() __builtin_amdgcn_sched_barrier(0)
constexpr int SHM_V = 16384, SHM_K = 16384;
constexpr int V_OFF = 0, K_OFF = 49152, WS_OFF = 114688, TAB_OFF = 116736, CSL_OFF = 118784;
constexpr float THR2 = 8.f;
__device__ __forceinline__ int crow(int r, int hi) { return (r & 3) + 8 * (r >> 2) + 4 * hi; }
__device__ __forceinline__ int v_st(int k, int c) { const int kk = (k & ~0xC) | ((k & 4) << 1) | ((k & 8) >> 1); return ((kk >> 3) * 4 + (c >> 5)) * 512 + ((kk & 7) * 32 + (c & 31)) * 2; }
__device__ __forceinline__ int swap23(int k) { return (k & ~0xC) | ((k & 4) << 1) | ((k & 8) >> 1); }
#define GLDS(src, dst) asm volatile("s_mov_b32 m0, %1\n\tglobal_load_lds_dwordx4 %0, off" :: "v"(src), "s"((unsigned)(uintptr_t)(dst)) : "memory", "m0")
__device__ __forceinline__ int v_rd_base(int lane) { return ((lane & 3) << 3) | (((lane >> 2) & 3) << 6) | (((lane >> 4) & 1) << 5) | (((lane >> 5) & 1) << 8); }
constexpr int v_rd_off(int d0, int ks, int half) { return d0 * 512 + ks * 4096 + half * 2048; }

template <bool ACCUM>
__device__ __forceinline__ void qkt(f32x16& p0, f32x16& p1, const LAS char* Kimg, int r32, int hi, const bf16x8* qr) {
    if (!ACCUM) { p0 = f32x16{}; p1 = f32x16{}; }
    const LAS char* kb[4];
#pragma unroll
    for (int dd = 0; dd < 4; ++dd) kb[dd] = Kimg + KSWZ(r32, (dd * 16 + hi * 8) * 2);
    __builtin_amdgcn_s_setprio(1);
    bf16x8 f0[8], f1[8];
#pragma unroll
    for (int d0 = 0; d0 < 8; ++d0) { const LAS char* a = kb[d0 & 3] + (d0 >> 2) * 128; f0[d0] = *(const LAS bf16x8*)(a); f1[d0] = *(const LAS bf16x8*)(a + 32 * 256); }
#pragma unroll
    for (int d0 = 0; d0 < 8; ++d0) { p0 = __builtin_amdgcn_mfma_f32_32x32x16_bf16(f0[d0], qr[d0], p0, 0, 0, 0); p1 = __builtin_amdgcn_mfma_f32_32x32x16_bf16(f1[d0], qr[d0], p1, 0, 0, 0); }
    __builtin_amdgcn_sched_group_barrier(0x100, 4, 0);
#pragma unroll
    for (int d0 = 0; d0 < 6; ++d0) { __builtin_amdgcn_sched_group_barrier(0x008, 2, 0); __builtin_amdgcn_sched_group_barrier(0x100, 2, 0); }
    __builtin_amdgcn_sched_group_barrier(0x008, 4, 0);
    __builtin_amdgcn_s_setprio(0);
}
typedef short v4i16_t __attribute__((ext_vector_type(4)));
__device__ __forceinline__ s16x4 vtr(int addr) { return __builtin_bit_cast(s16x4, __builtin_amdgcn_ds_read_tr16_b64_v4i16((LAS v4i16_t*)(uintptr_t)(unsigned)addr)); }
__device__ __forceinline__ void pv_tile(f32x16* o, int vb, bf16x8 pa0, bf16x8 pa1, bf16x8 pa2, bf16x8 pa3) {
#define PV_D0(d0) do { constexpr int b_ = v_rd_off(d0, 0, 0); \
        const s16x4 l0 = vtr(vb + b_), h0 = vtr(vb + b_ + 2048), l1 = vtr(vb + b_ + 4096), h1 = vtr(vb + b_ + 6144), l2 = vtr(vb + b_ + 8192), h2 = vtr(vb + b_ + 10240), l3 = vtr(vb + b_ + 12288), h3 = vtr(vb + b_ + 14336); \
        o[d0] = __builtin_amdgcn_mfma_f32_32x32x16_bf16((bf16x8){l0[0], l0[1], l0[2], l0[3], h0[0], h0[1], h0[2], h0[3]}, pa0, o[d0], 0, 0, 0);   \
        o[d0] = __builtin_amdgcn_mfma_f32_32x32x16_bf16((bf16x8){l1[0], l1[1], l1[2], l1[3], h1[0], h1[1], h1[2], h1[3]}, pa1, o[d0], 0, 0, 0);   \
        o[d0] = __builtin_amdgcn_mfma_f32_32x32x16_bf16((bf16x8){l2[0], l2[1], l2[2], l2[3], h2[0], h2[1], h2[2], h2[3]}, pa2, o[d0], 0, 0, 0);   \
        o[d0] = __builtin_amdgcn_mfma_f32_32x32x16_bf16((bf16x8){l3[0], l3[1], l3[2], l3[3], h3[0], h3[1], h3[2], h3[3]}, pa3, o[d0], 0, 0, 0); } while (0)
    __builtin_amdgcn_s_setprio(1);
    PV_D0(0); PV_D0(1); PV_D0(2); PV_D0(3);
    __builtin_amdgcn_s_setprio(0);
#undef PV_D0
}
__device__ __forceinline__ void store_o_rows(bf16_t* rowp, const f32x16* o, const float rl) {
#pragma unroll
    for (int d0 = 0; d0 < 4; ++d0)
#pragma unroll
        for (int j = 0; j < 2; ++j) { const int a = 8 * j, b = 8 * j + 4;
            const unsigned A0 = cvt_pk_bf16(o[d0][a] * rl, o[d0][a + 1] * rl), A1 = cvt_pk_bf16(o[d0][a + 2] * rl, o[d0][a + 3] * rl);
            const unsigned B0 = cvt_pk_bf16(o[d0][b] * rl, o[d0][b + 1] * rl), B1 = cvt_pk_bf16(o[d0][b + 2] * rl, o[d0][b + 3] * rl);
            auto r0 = __builtin_amdgcn_permlane32_swap(A0, B0, false, false); auto r1 = __builtin_amdgcn_permlane32_swap(A1, B1, false, false);
            const u32x4 w = {r0[0], r1[0], r0[1], r1[1]};
            *(u32x4*)(rowp + d0 * 32 + j * 16) = w; }
}
__device__ __forceinline__ void softmax_tile(f32x16& p0, f32x16& p1, float& m_reg, float& l_reg, float& alpha, bf16x8& pa0, bf16x8& pa1, bf16x8& pa2, bf16x8& pa3) {
    float pmax = p0[0];
#pragma unroll
    for (int r = 1; r < 16; ++r) pmax = fmaxf(pmax, p0[r]);
#pragma unroll
    for (int r = 0; r < 16; ++r) pmax = fmaxf(pmax, p1[r]);
    { auto rr = __builtin_amdgcn_permlane32_swap(__float_as_uint(pmax), __float_as_uint(pmax), false, false);
      pmax = fmaxf(__uint_as_float(rr[0]), __uint_as_float(rr[1])); }
    float mn;
    if (__builtin_expect(__all(pmax - m_reg <= THR2), 1)) { mn = m_reg; alpha = 1.f; }
    else { mn = fmaxf(m_reg, pmax); alpha = __builtin_amdgcn_exp2f(m_reg - mn); m_reg = mn; }
    const f32x2 mn2 = {mn, mn}; f32x2 ps2a = {0.f, 0.f}, ps2b = {0.f, 0.f};
#pragma unroll
    for (int r = 0; r < 8; ++r) { f32x2 v = {p0[2 * r], p0[2 * r + 1]}; v = v - mn2; v[0] = __builtin_amdgcn_exp2f(v[0]); v[1] = __builtin_amdgcn_exp2f(v[1]); p0[2 * r] = v[0]; p0[2 * r + 1] = v[1]; ps2a += v; }
#pragma unroll
    for (int r = 0; r < 8; ++r) { f32x2 v = {p1[2 * r], p1[2 * r + 1]}; v = v - mn2; v[0] = __builtin_amdgcn_exp2f(v[0]); v[1] = __builtin_amdgcn_exp2f(v[1]); p1[2 * r] = v[0]; p1[2 * r + 1] = v[1]; ps2b += v; }
    ps2a += ps2b; float ps = ps2a[0] + ps2a[1];
    { auto rr = __builtin_amdgcn_permlane32_swap(__float_as_uint(ps), __float_as_uint(ps), false, false);
      ps = __uint_as_float(rr[0]) + __uint_as_float(rr[1]); }
    l_reg = l_reg * alpha + ps;
#define PK4(P, B_, OUT) do { unsigned a0 = cvt_pk_bf16(P[B_+0], P[B_+1]), a1 = cvt_pk_bf16(P[B_+2], P[B_+3]);                          \
        unsigned b0 = cvt_pk_bf16(P[B_+4], P[B_+5]), b1 = cvt_pk_bf16(P[B_+6], P[B_+7]);                                             \
        auto r0 = __builtin_amdgcn_permlane32_swap(a0, b0, false, false); auto r1 = __builtin_amdgcn_permlane32_swap(a1, b1, false, false); \
        u32x4 w = {r0[0], r1[0], r0[1], r1[1]}; OUT = *reinterpret_cast<bf16x8*>(&w); } while (0)
    PK4(p0, 0, pa0); PK4(p0, 8, pa1); PK4(p1, 0, pa2); PK4(p1, 8, pa3);
#undef PK4
}

struct AU {
    const bf16_t* Q; int ldq;
    const bf16_t* K; const bf16_t* V; int ldk;
    bf16_t* O; int ldo;
    float* lse;
    const float* cs;
    const float* relb;
    int hh;
    int v0;
    int Lm, Ls, dil;
    int kb0, NT;
};

__device__ __forceinline__ void pv_softmax(f32x16* o, const int vb, const bf16x8 q0, const bf16x8 q1, const bf16x8 q2, const bf16x8 q3,
                                           f32x16& p0, f32x16& p1, float& m_reg, float& l_reg, float& alpha, bf16x8& pa0, bf16x8& pa1, bf16x8& pa2, bf16x8& pa3) {
#define PVQ_D0(d0) do { constexpr int b_ = v_rd_off(d0, 0, 0); \
        const s16x4 l0 = vtr(vb + b_), h0 = vtr(vb + b_ + 2048), l1 = vtr(vb + b_ + 4096), h1 = vtr(vb + b_ + 6144), l2 = vtr(vb + b_ + 8192), h2 = vtr(vb + b_ + 10240), l3 = vtr(vb + b_ + 12288), h3 = vtr(vb + b_ + 14336); \
        o[d0] = __builtin_amdgcn_mfma_f32_32x32x16_bf16((bf16x8){l0[0], l0[1], l0[2], l0[3], h0[0], h0[1], h0[2], h0[3]}, q0, o[d0], 0, 0, 0);   \
        o[d0] = __builtin_amdgcn_mfma_f32_32x32x16_bf16((bf16x8){l1[0], l1[1], l1[2], l1[3], h1[0], h1[1], h1[2], h1[3]}, q1, o[d0], 0, 0, 0);   \
        o[d0] = __builtin_amdgcn_mfma_f32_32x32x16_bf16((bf16x8){l2[0], l2[1], l2[2], l2[3], h2[0], h2[1], h2[2], h2[3]}, q2, o[d0], 0, 0, 0);   \
        o[d0] = __builtin_amdgcn_mfma_f32_32x32x16_bf16((bf16x8){l3[0], l3[1], l3[2], l3[3], h3[0], h3[1], h3[2], h3[3]}, q3, o[d0], 0, 0, 0); } while (0)
    PVQ_D0(0); PVQ_D0(1); PVQ_D0(2); PVQ_D0(3);
#undef PVQ_D0
    float pmax = p0[0];
#pragma unroll
    for (int r = 1; r < 16; ++r) pmax = fmaxf(pmax, p0[r]);
#pragma unroll
    for (int r = 0; r < 16; ++r) pmax = fmaxf(pmax, p1[r]);
    { auto rr = __builtin_amdgcn_permlane32_swap(__float_as_uint(pmax), __float_as_uint(pmax), false, false);
      pmax = fmaxf(__uint_as_float(rr[0]), __uint_as_float(rr[1])); }
    const bool ok = __all(pmax - m_reg <= THR2);
    const float mn = ok ? m_reg : fmaxf(m_reg, pmax);
    alpha = __builtin_amdgcn_exp2f(m_reg - mn); m_reg = mn;
    const f32x2 mn2 = {mn, mn}; f32x2 ps2a = {0.f, 0.f}, ps2b = {0.f, 0.f};
#pragma unroll
    for (int r = 0; r < 8; ++r) { f32x2 v = {p0[2 * r], p0[2 * r + 1]}; v = v - mn2; v[0] = __builtin_amdgcn_exp2f(v[0]); v[1] = __builtin_amdgcn_exp2f(v[1]); p0[2 * r] = v[0]; p0[2 * r + 1] = v[1]; ps2a += v; }
#pragma unroll
    for (int r = 0; r < 8; ++r) { f32x2 v = {p1[2 * r], p1[2 * r + 1]}; v = v - mn2; v[0] = __builtin_amdgcn_exp2f(v[0]); v[1] = __builtin_amdgcn_exp2f(v[1]); p1[2 * r] = v[0]; p1[2 * r + 1] = v[1]; ps2b += v; }
    ps2a += ps2b; float ps = ps2a[0] + ps2a[1];
    { auto rr = __builtin_amdgcn_permlane32_swap(__float_as_uint(ps), __float_as_uint(ps), false, false);
      ps = __uint_as_float(rr[0]) + __uint_as_float(rr[1]); }
    l_reg = l_reg * alpha + ps;
#define PK4(P, B_, OUT) do { unsigned a0 = cvt_pk_bf16(P[B_+0], P[B_+1]), a1 = cvt_pk_bf16(P[B_+2], P[B_+3]);                          \
        unsigned b0 = cvt_pk_bf16(P[B_+4], P[B_+5]), b1 = cvt_pk_bf16(P[B_+6], P[B_+7]);                                             \
        auto r0 = __builtin_amdgcn_permlane32_swap(a0, b0, false, false); auto r1 = __builtin_amdgcn_permlane32_swap(a1, b1, false, false); \
        u32x4 w = {r0[0], r1[0], r0[1], r1[1]}; OUT = *reinterpret_cast<bf16x8*>(&w); } while (0)
    PK4(p0, 0, pa0); PK4(p0, 8, pa1); PK4(p1, 0, pa2); PK4(p1, 8, pa3);
#undef PK4
    __builtin_amdgcn_sched_group_barrier(0x100, 8, 0);
#pragma unroll
    for (int i = 0; i < 16; ++i) { __builtin_amdgcn_sched_group_barrier(0x008, 1, 0); __builtin_amdgcn_sched_group_barrier(0x002, 6, 0); __builtin_amdgcn_sched_group_barrier(0x400, 2, 0);
        __builtin_amdgcn_sched_group_barrier(0x100, 2, 0); }
}
template <int MODE>
__device__ __forceinline__ void attn_unit(LAS char* lds, const AU& u, const int wave0_) {
    constexpr int NKH = MODE == 2 ? 2 : 1;
    const int tid = opaque_tid(), wid = __builtin_amdgcn_readfirstlane(tid >> 6), lane = tid & 63, r32 = lane & 31, hi = lane >> 5;
    LAS char* V_lds = lds + V_OFF; LAS char* K_lds = lds + K_OFF;
    LAS float* tab = (LAS float*)(lds + TAB_OFF); LAS float* csl = (LAS float*)(lds + CSL_OFF);
    const int Lm = u.Lm, Ls = u.Ls, dil = u.dil;
#define TOKV(v) ((((v) & Lm) * dil) + ((v) >> Ls))
    const int vw = u.v0 + wid * 32, vq = vw + r32, qm = vq - 4 * hi;
    bf16x8 qr[8 * NKH];
    { const bf16_t* qp = u.Q + (size_t)TOKV(vq) * u.ldq + hi * 8;
#pragma unroll
      for (int d0 = 0; d0 < 8 * NKH; ++d0) qr[d0] = *(const bf16x8*)(qp + d0 * 16); }
    if (MODE == 0) {
        const int delta = tid - 160; float val = -__builtin_inff();
        if (delta >= 0 && delta <= 128) { const int dist = delta * dil; int bk = dist;
            if (dist >= 16) { bk = 16 + (int)(log2f((float)dist * 0.0625f) * (16.0f / 7.0f)); bk = bk > 31 ? 31 : bk; }
            val = u.relb[bk * 12] * LOG2E; }
        tab[tid] = val;
    }
    float m_reg = -1e30f, l_reg = 0.f; f32x16 o[4] = {};
    const int l4 = lane >> 4, kr0 = 8 * wid + l4, kc0 = ((lane & 15) ^ l4) * 8, kc1 = ((lane & 15) ^ (4 + l4)) * 8;
    const int vrow = swap23(8 * wid + ((lane & 31) >> 2)), vc0 = (lane >> 5) * 32 + (lane & 3) * 8;
    const int vb0 = (int)(uintptr_t)V_lds + v_rd_base(lane);
    float st_c = 0.f;
#define SLOAD(kbv, kbf, vbf) do { int a0_ = (kbv) + kr0, a1_ = a0_ + 4, av_ = (kbv) + vrow; a0_ = a0_ < 0 ? 0 : a0_; a1_ = a1_ < 0 ? 0 : a1_; av_ = av_ < 0 ? 0 : av_; \
        const bf16_t* k0_ = u.K + (size_t)TOKV(a0_) * u.ldk + kc0; const bf16_t* k1_ = u.K + (size_t)TOKV(a1_) * u.ldk + kc1; const bf16_t* v0_ = u.V + (size_t)TOKV(av_) * u.ldk + vc0; \
        LAS char* kd_ = K_lds + (kbf) * (NKH * SHM_K) + wid * 2048; LAS char* vd_ = V_lds + (vbf) * SHM_V + wid * 2048; \
        GLDS(k0_, kd_); GLDS(k1_, kd_ + 1024); if (NKH == 2) { GLDS(k0_ + 128, kd_ + SHM_K); GLDS(k1_ + 128, kd_ + SHM_K + 1024); } \
        GLDS(v0_, vd_); GLDS(v0_ + 64, vd_ + 1024); \
        if (MODE == 1) { if (tid < 64) st_c = u.cs[(kbv) + tid]; } } while (0)
#define SWRITE(kbf) do { if (MODE == 1) { if (tid < 64) csl[(kbf) * 64 + tid] = -st_c; } } while (0)
#define RESC(a) do { if (__any((a) < 1.f)) { _Pragma("unroll") for (int d_ = 0; d_ < 4; ++d_) _Pragma("unroll") for (int r = 0; r < 16; ++r) o[d_][r] *= (a); } } while (0)
    const bool need_lim = MODE == 0 && (vw & Lm) < 128; const int lim = vq & Lm;
    f32x16 p0, p1; bf16x8 pa0, pa1, pa2, pa3; float alpha;
    bf16x8 q0, q1, q2, q3;
    SLOAD(u.kb0, 0, 0); VM_WAIT(); SWRITE(0);
#pragma unroll
    for (int d0 = 0; d0 < 8 * NKH; ++d0) asm volatile("" :: "v"(qr[d0]));
    __syncthreads();
    bool act_prev = false; int vcur = 0, vprev = 0;
    for (int t = 0; t < u.NT; ++t) {
        int kbo_ = u.kb0 + 64 * t; asm volatile("" : "+s"(kbo_)); const int kb_ = kbo_;
        const int kbf = t & 1, vnext = vcur == 2 ? 0 : vcur + 1; const bool HN = t + 1 < u.NT;
        if (HN) SLOAD(kb_ + 64, kbf ^ 1, vnext);
        bool act_ = true;
        if (MODE == 0) act_ = (kb_ <= vw + 31) && (kb_ + 63 >= vw - 128);
        if (MODE == 1) act_ = (kb_ <= vw + 31);
        if (act_) {
            SBAR();
            if (MODE == 1) { const LAS f32x4* cp_ = (const LAS f32x4*)(csl + kbf * 64 + 4 * hi);
#pragma unroll
                for (int g_ = 0; g_ < 4; ++g_) { const f32x4 c0_ = cp_[2 * g_], c1_ = cp_[2 * g_ + 8];
#pragma unroll
                    for (int i_ = 0; i_ < 4; ++i_) { p0[4 * g_ + i_] = c0_[i_]; p1[4 * g_ + i_] = c1_[i_]; } }
                qkt<true>(p0, p1, K_lds + kbf * (NKH * SHM_K), r32, hi, qr); }
            else qkt<false>(p0, p1, K_lds + kbf * (NKH * SHM_K), r32, hi, qr);
            if (NKH == 2) qkt<true>(p0, p1, K_lds + kbf * (NKH * SHM_K) + SHM_K, r32, hi, qr + 8);
            const int dq_ = qm - kb_;
            if (MODE == 0) { const LAS float* tb_ = tab + (dq_ + 101);
#pragma unroll
                for (int r = 0; r < 16; ++r) { const int c_ = (r & 3) + 8 * (r >> 2); p0[r] += tb_[59 - c_]; p1[r] += tb_[27 - c_]; }
                if (need_lim) {
#pragma unroll
                    for (int r = 0; r < 16; ++r) { const int c_ = (r & 3) + 8 * (r >> 2);
                        if (dq_ - c_ > lim) p0[r] = -__builtin_inff(); if (dq_ - c_ - 32 > lim) p1[r] = -__builtin_inff(); } } }
            if (MODE == 1) {
                if (kb_ + 63 > vw) {
#pragma unroll
                    for (int r = 0; r < 16; ++r) { const int c_ = (r & 3) + 8 * (r >> 2);
                        if (dq_ - c_ < 0) p0[r] = -__builtin_inff(); if (dq_ - c_ - 32 < 0) p1[r] = -__builtin_inff(); } } }
            SBAR();
            if (act_prev) pv_softmax(o, vb0 + vprev * SHM_V, q0, q1, q2, q3, p0, p1, m_reg, l_reg, alpha, pa0, pa1, pa2, pa3);
            else softmax_tile(p0, p1, m_reg, l_reg, alpha, pa0, pa1, pa2, pa3);
            SBAR(); RESC(alpha); SBAR();
            q0 = pa0; q1 = pa1; q2 = pa2; q3 = pa3;
        } else if (act_prev) { SBAR(); pv_tile(o, vb0 + vprev * SHM_V, q0, q1, q2, q3); SBAR(); }
        if (HN) { VM_WAIT(); SWRITE(kbf ^ 1); }
        __syncthreads();
        act_prev = act_; vprev = vcur; vcur = vnext;
    }
    if (act_prev) { SBAR(); pv_tile(o, vb0 + vprev * SHM_V, q0, q1, q2, q3); }
    if (MODE == 0) { if (hi == 0) u.lse[(size_t)TOKV(vq) * 12] = m_reg + log2f(l_reg); }
    store_o_rows(u.O + (size_t)TOKV(vq) * u.ldo + 8 * hi, o, __builtin_amdgcn_rcpf(l_reg));
    __syncthreads();
#undef TOKV
#undef SLOAD
#undef SWRITE
#undef RESC
}
constexpr int A2_GRP = 65536, A2_WS = 132096, A2_TAB = 134144;
template <class Gen>
__device__ __forceinline__ void attn_a2_stream(LAS char* lds, const int NU, const Gen& gen, const float* relb_g, const int wave0_) {
    const int tid = opaque_tid(), wid = __builtin_amdgcn_readfirstlane(tid >> 6), lane = tid & 63, r32 = lane & 31, hi = lane >> 5;
    const int grp = wid >> 2;
    LAS char* V_lds = lds + grp * A2_GRP; LAS char* K_lds = V_lds + 32768;
    const int wg = wid & 3, l4 = lane >> 4, kr0 = 16 * wg + l4, kc0 = ((lane & 15) ^ l4) * 8, kc1 = ((lane & 15) ^ (4 + l4)) * 8;
    const int vr0 = swap23(16 * wg + ((lane & 31) >> 2)), vr1 = swap23(16 * wg + 8 + ((lane & 31) >> 2)), vc0 = (lane >> 5) * 32 + (lane & 3) * 8;
    const int vb0 = (int)(uintptr_t)V_lds + v_rd_base(lane);
#define TOKU(U, v) ((((v) & (U).Lm) * (U).dil) + ((v) >> (U).Ls))
#define SLOADU(U, kbv, bf) do { LAS char* kd_ = K_lds + (bf) * SHM_K + wg * 4096; LAS char* vd_ = V_lds + (bf) * SHM_V + wg * 4096; \
        _Pragma("unroll") for (int i_ = 0; i_ < 4; ++i_) { int a_ = (kbv) + kr0 + 4 * i_; a_ = a_ < 0 ? 0 : a_; GLDS((U).K + (size_t)TOKU(U, a_) * (U).ldk + ((i_ & 1) ? kc1 : kc0), kd_ + i_ * 1024); } \
        _Pragma("unroll") for (int h_ = 0; h_ < 2; ++h_) { int a_ = (kbv) + (h_ ? vr1 : vr0); a_ = a_ < 0 ? 0 : a_; const bf16_t* p_ = (U).V + (size_t)TOKU(U, a_) * (U).ldk + vc0; \
            GLDS(p_, vd_ + h_ * 2048); GLDS(p_ + 64, vd_ + h_ * 2048 + 1024); } } while (0)
#define LOADQU(U) do { const bf16_t* qp_ = (U).Q + (size_t)TOKU(U, (U).v0 + wid * 32 + r32) * (U).ldq + hi * 8; \
        _Pragma("unroll") for (int d0 = 0; d0 < 8; ++d0) qr[d0] = *(const bf16x8*)(qp_ + d0 * 16); } while (0)
#define TABU(U, tb) do { const int delta = tid - 160; float val = -__builtin_inff();          \
        if (delta >= 0 && delta <= 128) { const int dist = delta * (U).dil; int bk = dist; \
            if (dist >= 16) { bk = 16 + (int)(log2f((float)dist * 0.0625f) * (16.0f / 7.0f)); bk = bk > 31 ? 31 : bk; } \
            val = relb_l[bk * 12 + (U).hh] * LOG2E; } \
        ((LAS float*)(lds + A2_TAB))[(tb) * 512 + tid] = val; } while (0)
#define RESC(a) do { if (__any((a) < 1.f)) { _Pragma("unroll") for (int d_ = 0; d_ < 4; ++d_) _Pragma("unroll") for (int r = 0; r < 16; ++r) o[d_][r] *= (a); } } while (0)
    AU u; gen(0, u);
    LAS float* relb_l = (LAS float*)(lds + A2_TAB) + 1024;
    if (tid < 384) relb_l[tid] = relb_g[tid];
    __syncthreads();
    bf16x8 qr[8];
    LOADQU(u); TABU(u, 0); SLOADU(u, u.kb0 + 128 * grp + ((grp != 0 && u.NT == 4) ? 128 : 0), 0);
    for (int iu = 0; iu < NU; ++iu) {
        const bool hasn = iu + 1 < NU; AU un = u; if (hasn) gen(iu + 1, un);
        const LAS float* tab = (const LAS float*)(lds + A2_TAB) + (iu & 1) * 512;
        const int Lm = u.Lm;
        const int vw = u.v0 + wid * 32, vq = vw + r32, qm = vq - 4 * hi;
        const int cstart = vw - (vw & Lm);
        const bool need_lim = (vw & Lm) < 128; const int lim = vq & Lm;
        const int kbg = u.kb0 + 128 * grp;
        const int ntm = u.NT - 1, rot = (grp != 0 && u.NT == 4) ? 2 : 0;
        float m_reg = -1e30f, l_reg = 0.f; f32x16 o[4] = {};
        f32x16 p0, p1; bf16x8 pa0, pa1, pa2, pa3; float alpha;
        VM_WAIT();
#pragma unroll
        for (int d0 = 0; d0 < 8; ++d0) asm volatile("" :: "v"(qr[d0]));
        __syncthreads();
#define TILE2(t, BF, LAST) do { int kbo_ = kbg + 64 * (((t) + rot) & ntm); asm volatile("" : "+s"(kbo_)); const int kb_ = kbo_; \
        const bool shr_ = rot != 0 && (t) >= 2;                       \
        const LAS char* kimg_ = (shr_ ? lds + 32768 : K_lds) + (BF) * SHM_K; const int vimg_ = (shr_ ? vb0 - A2_GRP : vb0) + (BF) * SHM_V; \
        if (!(LAST)) { if (!(rot != 0 && (t) + 1 >= 2)) SLOADU(u, kbg + 64 * (((t) + 1 + rot) & ntm), (BF) ^ 1); } \
        else if (hasn) SLOADU(un, un.kb0 + 128 * grp + ((grp != 0 && un.NT == 4) ? 128 : 0), 0); \
        const bool act_ = (kb_ <= vw + 31) && (kb_ + 63 >= vw - 128) && (kb_ + 63 >= cstart); \
        if (act_) { \
            const int dq_ = qm - kb_; SBAR(); \
            { const LAS float* tb_ = tab + (dq_ + 101);                \
              _Pragma("unroll") for (int r = 0; r < 16; ++r) { const int c_ = (r & 3) + 8 * (r >> 2); p0[r] = tb_[59 - c_]; p1[r] = tb_[27 - c_]; } \
              qkt<true>(p0, p1, kimg_, r32, hi, qr); \
              if (need_lim) { _Pragma("unroll") for (int r = 0; r < 16; ++r) { const int c_ = (r & 3) + 8 * (r >> 2); \
                  if (dq_ - c_ > lim) p0[r] = -__builtin_inff(); if (dq_ - c_ - 32 > lim) p1[r] = -__builtin_inff(); } } } } \
        if ((LAST) && hasn) { SBAR(); LOADQU(un); TABU(un, (iu + 1) & 1); SBAR(); } \
        if (act_) { \
            SBAR(); softmax_tile(p0, p1, m_reg, l_reg, alpha, pa0, pa1, pa2, pa3); \
            RESC(alpha); SBAR(); \
            pv_tile(o, vimg_, pa0, pa1, pa2, pa3); } \
        if (!(LAST)) { VM_WAIT(); __syncthreads(); } } while (0)
        int t = 0;
        for (; t + 2 < u.NT; t += 2) { TILE2(t, 0, false); TILE2(t + 1, 1, false); }
        TILE2(t, 0, false); TILE2(t + 1, 1, true);
#undef TILE2
        if (hi == 0) u.lse[(size_t)TOKU(u, vq) * 12] = m_reg + log2f(l_reg);
        store_o_rows(u.O + (size_t)TOKU(u, vq) * u.ldo + 8 * hi, o, __builtin_amdgcn_rcpf(l_reg));
        u = un;
    }
    __syncthreads();
#undef TOKU
#undef SLOADU
#undef LOADQU
#undef TABU
#undef RESC
}
}

__device__ __forceinline__ unsigned f2bf(float f) { unsigned u = __builtin_bit_cast(unsigned, f); return (u + 0x7fffu + ((u >> 16) & 1u)) >> 16; }
__device__ __forceinline__ unsigned pk2(float lo, float hi) { return f2bf(lo) | (f2bf(hi) << 16); }
__device__ __forceinline__ float wave_sum(float v) {
    v += dpp_f<0xB1>(v); v += dpp_f<0x4E>(v);
    v += dpp_f<0x141>(v); v += dpp_f<0x140>(v);
    v = xor16_add(v); v = xor32_add(v);
    return v;
}
struct TrItem { const float* wp; size_t rs; bf16_t* dp; int ldt; };
__device__ __forceinline__ void tr_load(const TrItem& t, f32x4 (&v)[8]) {
#pragma unroll
    for (int i = 0; i < 8; ++i) v[i] = *(const f32x4*)(t.wp + (size_t)(8 * i) * t.rs);
}
__device__ __forceinline__ void tr_store(const TrItem& t, const f32x4 (&v)[8], LAS float* scr, int lane) {
    const int r = lane >> 3, c4 = lane & 7;
#pragma unroll
    for (int i = 0; i < 8; ++i) { LAS float* d = scr + (8 * i + r) * 33 + 4 * c4; d[0] = v[i][0]; d[1] = v[i][1]; d[2] = v[i][2]; d[3] = v[i][3]; }
    LDS_WAIT(); asm volatile("" ::: "memory");
    const int c = lane & 7;
#pragma unroll
    for (int j = 0; j < 4; ++j) { const int n = (lane >> 3) + 8 * j; const LAS float* s = scr + (8 * c) * 33 + n;
        u32x4 o; o.x = pk2(s[0 * 33], s[1 * 33]); o.y = pk2(s[2 * 33], s[3 * 33]); o.z = pk2(s[4 * 33], s[5 * 33]); o.w = pk2(s[6 * 33], s[7 * 33]);
        *(u32x4*)(t.dp + (size_t)(8 * j) * t.ldt) = o; }
    LDS_WAIT(); asm volatile("" ::: "memory");
}
struct Args { const float* in[19]; float* out; unsigned char* ws; int ph_lo, ph_hi; };
typedef __attribute__((address_space(4))) const Args* KArgP;
__device__ __forceinline__ KArgP fresh_args() { KArgP p = (KArgP)__builtin_amdgcn_kernarg_segment_ptr(); asm volatile("" : "+s"(p)); return p; }

__device__ __forceinline__ TrItem tr_decode(KArgP args, unsigned char* ws, int lane, int it) {
    const float* w_in = args->in[4];
    int r = it; const float* src; int ldw, ldt, nkb; bf16_t* dst;
    if (r < 4608) { src = w_in + 0; ldw = INC; dst = (bf16_t*)(ws + WS_WT1); ldt = DM; nkb = 32; }
    else if ((r -= 4608) < 1536) { src = w_in + 4608; ldw = INC; dst = (bf16_t*)(ws + WS_WT2); ldt = DM; nkb = 32; }
    else if ((r -= 1536) < 3072) { src = w_in + 6144; ldw = INC; dst = (bf16_t*)(ws + WS_WT1) + (size_t)4608 * DM; ldt = DM; nkb = 32; }
    else if ((r -= 3072) < 1024) { src = w_in + 9216; ldw = INC; dst = (bf16_t*)(ws + WS_WT2) + (size_t)1536 * DM; ldt = DM; nkb = 32; }
    else if ((r -= 1024) < 1024) { src = w_in + 10248; ldw = INC; dst = (bf16_t*)(ws + WS_WT1) + (size_t)7680 * DM; ldt = DM; nkb = 32; }
    else if ((r -= 1024) < 1024) { src = w_in + 11272; ldw = INC; dst = (bf16_t*)(ws + WS_WT2) + (size_t)2560 * DM; ldt = DM; nkb = 32; }
    else if ((r -= 1024) < 6144) { src = w_in + 12296; ldw = INC; dst = (bf16_t*)(ws + WS_WT2) + (size_t)3584 * DM; ldt = DM; nkb = 32; }
    else if ((r -= 6144) < 2048) { src = args->in[14]; ldw = 2048; dst = (bf16_t*)(ws + WS_WTKV); ldt = DM; nkb = 32; }
    else if ((r -= 2048) < 1536) { src = args->in[15]; ldw = DM; dst = (bf16_t*)(ws + WS_WTP); ldt = KP; nkb = 24; }
    else if ((r -= 1536) < 1024) { src = args->in[16]; ldw = DM; dst = (bf16_t*)(ws + WS_WTP) + 1536; ldt = KP; nkb = 16; }
    else if ((r -= 1024) < 1024) { src = args->in[17]; ldw = DM; dst = (bf16_t*)(ws + WS_WTP) + 2560; ldt = KP; nkb = 16; }
    else { r -= 1024; src = args->in[18]; ldw = DM; dst = (bf16_t*)(ws + WS_WTO); ldt = DM; nkb = 32; }
    const int nb = r / nkb, kb = r - nb * nkb, k0 = 64 * kb, n0 = 32 * nb;
    TrItem t; t.wp = src + (size_t)(k0 + (lane >> 3)) * ldw + n0 + 4 * (lane & 7); t.rs = (size_t)ldw;
    t.dp = dst + (size_t)(n0 + (lane >> 3)) * ldt + k0 + 8 * (lane & 7); t.ldt = ldt; return t;
}
#define TR_LD(V, T, idx) do { if ((idx) < tot_) { T = tr_decode(args, ws, lane, MAP_((idx))); tr_load(T, V); } } while (0)
#define TR_STREAM(first, total, stride, MAPF) do { const int tot_ = (total), st_ = (stride); int j_ = (first); \
        f32x4 va_[8], vb_[8], vc_[8], vd_[8]; TrItem ta_, tb_, tc_, td_; ta_.wp = nullptr; tb_ = ta_; tc_ = ta_; td_ = ta_; \
        auto MAP_ = [](int q_) { return MAPF(q_); }; \
        TR_LD(va_, ta_, j_); TR_LD(vb_, tb_, j_ + st_); TR_LD(vc_, tc_, j_ + 2 * st_); \
        while (j_ < tot_) { \
            TR_LD(vd_, td_, j_ + 3 * st_); tr_store(ta_, va_, scr, lane); j_ += st_; if (j_ >= tot_) break; \
            TR_LD(va_, ta_, j_ + 3 * st_); tr_store(tb_, vb_, scr, lane); j_ += st_; if (j_ >= tot_) break; \
            TR_LD(vb_, tb_, j_ + 3 * st_); tr_store(tc_, vc_, scr, lane); j_ += st_; if (j_ >= tot_) break; \
            TR_LD(vc_, tc_, j_ + 3 * st_); tr_store(td_, vd_, scr, lane); j_ += st_; } } while (0)
__device__ __forceinline__ int map_p0(int r) { if (r < 4608) return r; if ((r -= 4608) < 3072) return 6144 + r; if ((r -= 3072) < 1024) return 10240 + r; return 18432 + (r - 1024); }
__device__ __forceinline__ int map_p1(int r) { if (r < 1536) return 4608 + r; if ((r -= 1536) < 1024) return 9216 + r; if ((r -= 1024) < 1024) return 11264 + r; return 12288 + (r - 1024); }
__device__ __forceinline__ int map_p3(int r) { return 20480 + r; }
constexpr int P1_SIDE = 5632;
__device__ __forceinline__ int map_p1b(int r) { return map_p1(P1_SIDE + r); }
__global__ void __launch_bounds__(512, 2) fwd_kernel(Args args_) {
    extern __shared__ __attribute__((aligned(16))) unsigned char lds_raw[];
    LAS unsigned char* lds = (LAS unsigned char*)lds_raw;
    volatile LAS unsigned* MISC = (volatile LAS unsigned*)(lds + MISC_OFF);
    const int wave0_ = __builtin_amdgcn_readfirstlane((int)threadIdx.x >> 6);
    const int G = gridDim.x; const int bx = blockIdx.x; const int vcu = (G % 8 == 0) ? (bx % 8) * (G / 8) + bx / 8 : bx;
    gu32* ctl = (gu32*)(fresh_args()->ws + WS_CTL);
    for (int i = threadIdx.x; i < (LDS_BYTES - LDSCTL_OFF) / 4; i += 512) ((LAS unsigned*)(lds + LDSCTL_OFF))[i] = 0u;
    __syncthreads();
    XcdBarrier bar; bar.bar = (unsigned*)(ctl + 4096); bar.x = 0; bar.st = nullptr;
    const int lo = fresh_args()->ph_lo, hi_ = fresh_args()->ph_hi;
    const bool one_launch = (hi_ - lo) > 1;
    if (one_launch) bar = xcd_barrier_post((unsigned*)(ctl + 4096), MISC + 8, wave0_);
#ifndef ATT_DUP
#define ATT_DUP 0
#endif
#ifndef ATT_MASK
#define ATT_MASK 7
#endif
#ifndef PH_MASK
#define PH_MASK 63
#endif
#define IN(k) (((PH_MASK >> (k)) & 1) && lo <= (k) && (k) < hi_)
#define BOTH(k) (IN(k) && IN((k) + 1))
#define GRID_BAR() xcd_barrier(bar, wave0_)

    if (IN(0)) {
        const KArgP args = fresh_args(); unsigned char* ws = args->ws; const float* x = args->in[0];
        const int tid = opaque_tid(), lane = tid & 63, wave = __builtin_amdgcn_readfirstlane(tid >> 6);
        LAS float* scr = (LAS float*)(lds + wave * 16384);
        const int gw = vcu * 8 + wave, NGW = G * 8;
        const float* w_in = args->in[4];
        TR_STREAM(gw, 10752, NGW, map_p0);
        __syncthreads();
        LAS float* wfT = (LAS float*)lds;
        { f32x4 wa[4], wb[4];
#pragma unroll
          for (int j = 0; j < 4; ++j) { const float* p = w_in + (size_t)(tid + 512 * j) * INC + 10240; wa[j] = *(const f32x4*)p; wb[j] = *(const f32x4*)(p + 4); }
#pragma unroll
          for (int j = 0; j < 4; ++j) { const int k = tid + 512 * j;
#pragma unroll
              for (int e = 0; e < 4; ++e) { wfT[e * DM + k] = wa[j][e]; wfT[(4 + e) * DM + k] = wb[j][e]; } } }
        __syncthreads();
        const float* ng = args->in[2]; const float* bfg = args->in[5];
        { const int lane_h = opaque_tid() & 63;
#define lane lane_h
        bf16_t* H = (bf16_t*)(ws + WS_H); float* F = (float*)(ws + WS_F);
#pragma unroll 1
        for (int m = gw; m < TOK; m += NGW) {
            const f32x4* xr = (const f32x4*)(x + (size_t)m * DM) + lane;
            f32x4 v[8]; float s = 0.f;
#pragma unroll
            for (int j = 0; j < 8; ++j) { v[j] = xr[64 * j]; s += (v[j][0] * v[j][0] + v[j][1] * v[j][1]) + (v[j][2] * v[j][2] + v[j][3] * v[j][3]); }
            const float rstd = 1.0f / sqrtf(wave_sum(s) * (1.f / DM) + EPS);
            u32x2* o8 = (u32x2*)(H + (size_t)m * DM) + lane;
#pragma unroll
            for (int j = 0; j < 8; ++j) { const f32x4 gj = *((const f32x4*)ng + lane + 64 * j); v[j] = (v[j] * rstd) * gj;
                u32x2 w; w.x = pk2(v[j][0], v[j][1]); w.y = pk2(v[j][2], v[j][3]); o8[64 * j] = w; }
            float fb[8];
#pragma unroll
            for (int hh = 0; hh < 8; ++hh) fb[hh] = 0.f;
#pragma unroll
            for (int j = 0; j < 8; ++j) {
#pragma unroll
                for (int hh = 0; hh < 8; ++hh) { const f32x4 w4 = *((const LAS f32x4*)(wfT + hh * DM) + lane + 64 * j); fb[hh] += (v[j][0] * w4[0] + v[j][1] * w4[1]) + (v[j][2] * w4[2] + v[j][3] * w4[3]); }
                asm volatile("" ::: "memory"); }
#pragma unroll
            for (int hh = 0; hh < 8; ++hh) { fb[hh] = wave_sum(fb[hh]); __builtin_amdgcn_sched_barrier(0); }
            if (lane < 8) { float f = fb[0];
#pragma unroll
                for (int hh = 1; hh < 8; ++hh) f = lane == hh ? fb[hh] : f;
                const float xx = f + bfg[lane]; F[(size_t)m * 8 + lane] = fminf(xx, 0.f) - log1pf(expf(-fabsf(xx))); }
        }
#undef lane
        }
        const float* mem = args->in[1]; const float* mg = args->in[3]; bf16_t* MH = (bf16_t*)(ws + WS_MH);
        { const int lane_m = opaque_tid() & 63;
#define lane lane_m
#pragma unroll 1
        for (int m = gw; m < NB * MEML; m += NGW) {
            const f32x4* xr = (const f32x4*)(mem + (size_t)m * DM) + lane;
            f32x4 v[8]; float s = 0.f;
#pragma unroll
            for (int j = 0; j < 8; ++j) { v[j] = xr[64 * j]; s += (v[j][0] * v[j][0] + v[j][1] * v[j][1]) + (v[j][2] * v[j][2] + v[j][3] * v[j][3]); }
            const float rstd = 1.0f / sqrtf(wave_sum(s) * (1.f / DM) + EPS);
            u32x2* o8 = (u32x2*)(MH + (size_t)m * DM) + lane;
#pragma unroll
            for (int j = 0; j < 8; ++j) { const f32x4 gj = *((const f32x4*)mg + lane + 64 * j); v[j] = (v[j] * rstd) * gj;
                u32x2 w; w.x = pk2(v[j][0], v[j][1]); w.y = pk2(v[j][2], v[j][3]); o8[64 * j] = w; }
        }
#undef lane
        }
        if (BOTH(0)) xcd_barrier_arrive(bar, wave0_); else __syncthreads();
        { const KArgP args = fresh_args(); unsigned char* ws = args->ws;
          const int tid = opaque_tid(), lane = tid & 63, wave = __builtin_amdgcn_readfirstlane(tid >> 6);
          LAS float* scr = (LAS float*)(lds + wave * 16384);
          TR_STREAM(vcu * 8 + wave, 9728 - P1_SIDE, G * 8, map_p1b); }
        if (BOTH(0)) xcd_barrier_wait(bar, wave0_); else __syncthreads();
    }

    if (IN(1)) {
        const KArgP args = fresh_args(); unsigned char* ws = args->ws;
        if (bx >= 192 && bx < 256) {                 const int tid = opaque_tid(), lane = tid & 63, wave = __builtin_amdgcn_readfirstlane(tid >> 6);
            const int j = bx - 192, b = j >> 3, hh = j & 7;
            const float* F = (const float*)(ws + WS_F) + ((size_t)b * SEQ) * 8 + hh; float* CS = (float*)(ws + WS_CS) + (size_t)j * SEQ;
            LAS float* wt = (LAS float*)lds;
            float a0 = F[(size_t)(4 * tid + 0) * 8], a1 = F[(size_t)(4 * tid + 1) * 8], a2 = F[(size_t)(4 * tid + 2) * 8], a3 = F[(size_t)(4 * tid + 3) * 8];
            a1 += a0; a2 += a1; a3 += a2;
            float sc = a3;
#pragma unroll
            for (int o = 1; o < 64; o <<= 1) { const float t = __shfl_up(sc, o); if (lane >= o) sc += t; }
            if (lane == 63) wt[wave] = sc;
            __syncthreads();
            float base = 0.f;
            for (int w = 0; w < wave; ++w) base += wt[w];
            const float ex = base + sc - a3;
            CS[4 * tid + 0] = (ex + a0) * LOG2E; CS[4 * tid + 1] = (ex + a1) * LOG2E; CS[4 * tid + 2] = (ex + a2) * LOG2E; CS[4 * tid + 3] = (ex + a3) * LOG2E;
            __syncthreads();
            { LAS float* scr = (LAS float*)(lds + wave * 16384);
              TR_STREAM((bx - 192) * 8 + wave, P1_SIDE, 512, map_p1); }
            __syncthreads();
        }
        EpiQKV E; E.ws = ws; E.gains[0] = args->in[8]; E.gains[1] = args->in[9]; E.gains[2] = args->in[10]; E.gains[3] = args->in[11]; E.gains[4] = args->in[12]; E.gains[5] = args->in[13]; E.lds = lds;
        { E.which = 0; pg8::Gemm g{(const bf16_t*)(ws + WS_H), (const bf16_t*)(ws + WS_WT1), DM, DM}; pg8::StaticOrder S; S.init(TOK, N1, DM, G, bx);
          pg8::gemm_phase<EpiQKV, pg8::StaticOrder>(lds, g, S, E, wave0_); }
        { E.which = 1; pg8::Gemm g{(const bf16_t*)(ws + WS_MH), (const bf16_t*)(ws + WS_WTKV), DM, DM}; pg8::StaticOrder S; S.init(NB * MEML, 2048, DM, G, (bx + 128) % G);
          pg8::gemm_phase<EpiQKV, pg8::StaticOrder>(lds, g, S, E, wave0_); }
        if (BOTH(1)) GRID_BAR();
    }

    if (IN(2)) {
        const KArgP args = fresh_args(); unsigned char* ws = args->ws;
        LAS char* al = (LAS char*)lds;
        const float* CS = (const float*)(ws + WS_CS);
        for (int v = vcu; v < 256; v += G) {
            { const int bh = v >> 2, s = v & 3, b = bh >> 3, h = bh & 7;
              for (int pass = 0; pass < 2; ++pass) { const int qb = pass ? 7 - s : s;
                  att::AU u; u.Q = (const bf16_t*)(ws + WS_QB) + (size_t)b * SEQ * BW + h * 128; u.ldq = BW;
                  u.K = (const bf16_t*)(ws + WS_KB) + (size_t)b * SEQ * BW + h * 128; u.V = (const bf16_t*)(ws + WS_VB) + (size_t)b * SEQ * BW + h * 128; u.ldk = BW;
                  u.O = (bf16_t*)(ws + WS_Y) + (size_t)b * SEQ * KP + AW + h * 128; u.ldo = KP; u.lse = nullptr; u.cs = CS + (size_t)(b * 8 + h) * SEQ; u.relb = nullptr;
                  u.v0 = qb * 256; u.Lm = 0x3fffffff; u.Ls = 30; u.dil = 1; u.kb0 = 0; u.NT = 4 * (qb + 1);
                  if (ATT_MASK & 1) att::attn_unit<1>(al, u, wave0_);
                  if (ATT_DUP & 1) att::attn_unit<1>(al, u, wave0_); } }
            { const int b = v >> 5, h = (v >> 3) & 3, qb = v & 7;
              for (int e = 0; e < 2; ++e) {
                  att::AU u; u.Q = (const bf16_t*)(ws + WS_QM) + (size_t)b * SEQ * MW + h * 256; u.ldq = MW;
                  u.K = (const bf16_t*)(ws + WS_KM) + (size_t)b * MEML * MW + h * 256; u.V = (const bf16_t*)(ws + WS_VM) + (size_t)b * MEML * MW + h * 256 + e * 128; u.ldk = MW;
                  u.O = (bf16_t*)(ws + WS_Y) + (size_t)b * SEQ * KP + AW + BW + h * 256 + e * 128; u.ldo = KP; u.lse = nullptr; u.cs = nullptr; u.relb = nullptr;
                  u.v0 = qb * 256; u.Lm = 0x3fffffff; u.Ls = 30; u.dil = 1; u.kb0 = 0; u.NT = 4;
                  if (ATT_MASK & 2) att::attn_unit<2>(al, u, wave0_);
                  if (ATT_DUP & 2) att::attn_unit<2>(al, u, wave0_); } }
            { float* const outp = args->out; const float* const relbp = args->in[7];
              auto genA = [=](int i, att::AU& u) {
                const int b = v >> 5, w_ = 32 * i + (v & 31), h = w_ / 24, rem_ = w_ - 24 * h, pat = rem_ >> 3, vb = rem_ & 7;
                u.Q = (const bf16_t*)(ws + WS_QA) + (size_t)b * SEQ * AW + h * 128; u.ldq = AW;
                u.K = (const bf16_t*)(ws + WS_KA) + (size_t)b * SEQ * AW + h * 128; u.V = (const bf16_t*)(ws + WS_VA) + (size_t)b * SEQ * AW + h * 128; u.ldk = AW;
                bf16_t* ob = pat == 0 ? (bf16_t*)outp : (pat == 1 ? (bf16_t*)outp + (size_t)TOK * AW : (bf16_t*)(ws + WS_OA2));
                u.O = ob + (size_t)b * SEQ * AW + h * 128; u.ldo = AW;
                u.lse = (float*)(ws + WS_LSE) + ((size_t)pat * TOK + (size_t)b * SEQ) * 12 + h; u.cs = nullptr; u.relb = relbp + h; u.hh = h;
                u.v0 = vb * 256; u.Ls = pat == 0 ? 11 : (pat == 1 ? 9 : 7); u.Lm = (1 << u.Ls) - 1; u.dil = pat == 0 ? 1 : (pat == 1 ? 4 : 16);
                if (pat == 2) { u.kb0 = u.v0; u.NT = 2; } else { u.kb0 = u.v0 - 128; u.NT = 4; }
              };
              if (ATT_MASK & 4) att::attn_a2_stream(al, 9, genA, relbp, wave0_);
              if (ATT_DUP & 4) att::attn_a2_stream(al, 9, genA, relbp, wave0_); }
        }
        if (BOTH(2)) xcd_barrier_arrive(bar, wave0_);
    }

    if (IN(3)) {
        const KArgP args = fresh_args(); unsigned char* ws = args->ws;
        if (bx >= 128 && bx < 256) {
            const int tid = opaque_tid(), lane = tid & 63, wave = __builtin_amdgcn_readfirstlane(tid >> 6);
            LAS float* scr = (LAS float*)(lds + wave * 16384);
            TR_STREAM((bx - 128) * 8 + wave, 5632, 1024, map_p3);
            __syncthreads();
        }
        EpiZG E; E.ws = ws; E.oa0 = (const bf16_t*)args->out; E.oa1 = (const bf16_t*)args->out + (size_t)TOK * AW; E.bgate = args->in[6]; E.wb = bar; E.lazy = BOTH(2);
        pg8::Gemm g{(const bf16_t*)(ws + WS_H), (const bf16_t*)(ws + WS_WT2), DM, DM}; pg8::StaticOrder S; S.init(TOK, N2, DM, G, bx, P3_ROT * (bx & 7));
        pg8::gemm_phase<EpiZG, pg8::StaticOrder>(lds, g, S, E, wave0_);
        if (BOTH(3)) GRID_BAR();
    }

    if (IN(4)) {
        const KArgP args = fresh_args(); unsigned char* ws = args->ws;
        EpiMerge E; E.ws = ws;
        pg8::Gemm g{(const bf16_t*)(ws + WS_Y), (const bf16_t*)(ws + WS_WTP), KP, KP}; pg8::Sub3Order S; S.init(TOK, DM, G, bx, bx & 7);
        pg8::gemm_phase<EpiMerge, pg8::Sub3Order>(lds, g, S, E, wave0_);
        if (BOTH(4)) xcd_barrier_arrive(bar, wave0_);
    }

    if (IN(5)) {
        const KArgP args = fresh_args(); unsigned char* ws = args->ws; const float* x = args->in[0];
        EpiOut E; E.x = x; E.out = args->out; E.wb = bar; E.lazy = BOTH(4);
        pg8::Gemm g{(const bf16_t*)(ws + WS_MRG), (const bf16_t*)(ws + WS_WTO), DM, DM}; pg8::StaticOrder S; S.init(TOK, DM, DM, G, bx);
        pg8::gemm_phase<EpiOut, pg8::StaticOrder>(lds, g, S, E, wave0_);
    }
#undef IN
#undef BOTH
#undef GRID_BAR
}

extern "C" void kernel_launch(void* const* d_in, const int* in_sizes, int n_in, void* d_out, int out_size, void* d_ws, size_t ws_size, hipStream_t stream) {
    static int grid = 0;
    if (grid == 0) {
        if (n_in != 19 || in_sizes[0] != TOK * DM || out_size != TOK * DM || ws_size < WS_END) {
            fprintf(stderr, "kernel_launch: shape/workspace mismatch (n_in %d, in0 %d, out %d, ws %zu, need %zu)\n", n_in, n_in > 0 ? in_sizes[0] : -1, out_size, ws_size, (size_t)WS_END); grid = -1; return; }
        int dev = 0, cus = 0;
        if (hipGetDevice(&dev) != hipSuccess || hipDeviceGetAttribute(&cus, hipDeviceAttributeMultiprocessorCount, dev) != hipSuccess) { grid = -1; return; }
        if (hipFuncSetAttribute((const void*)fwd_kernel, hipFuncAttributeMaxDynamicSharedMemorySize, LDS_BYTES) != hipSuccess) { fprintf(stderr, "kernel_launch: hipFuncSetAttribute failed\n"); grid = -1; return; }
        (void)hipGetLastError();
        grid = cus;
    }
    if (grid < 0) return;
    (void)hipMemsetAsync((char*)d_ws + WS_CTL, 0, CTL_ZERO_BYTES, stream);
    Args a{};
    for (int i = 0; i < 19; ++i) a.in[i] = (const float*)d_in[i];
    a.out = (float*)d_out; a.ws = (unsigned char*)d_ws;
#if MK_N_LAUNCHES == 1
    a.ph_lo = 0; a.ph_hi = 6;
    hipLaunchKernelGGL(fwd_kernel, dim3(grid), dim3(512), LDS_BYTES, stream, a);
#else
    for (int p = 0; p < 6; ++p) { a.ph_lo = p; a.ph_hi = p + 1; hipLaunchKernelGGL(fwd_kernel, dim3(grid), dim3(512), LDS_BYTES, stream, a);
#if defined(DUP_PHASE)
        if (p == DUP_PHASE) hipLaunchKernelGGL(fwd_kernel, dim3(grid), dim3(512), LDS_BYTES, stream, a);
#endif
    }
#endif
    const hipError_t le = hipPeekAtLastError();
    if (le != hipSuccess) fprintf(stderr, "kernel_launch: launch failed: %s\n", hipGetErrorName(le));
}
```

```cpp
#pragma clang diagnostic ignored "-Winline-asm"
#include <hip/hip_runtime.h>
#include <hip/hip_bf16.h>
#include <cstdio>
#include <cstdint>

#ifndef P3_ROT
#define P3_ROT 1
#endif
#ifndef DUP_EPI
#define DUP_EPI 0
#endif
#ifndef MK_N_LAUNCHES
#define MK_N_LAUNCHES 1
#endif

#define LAS __attribute__((address_space(3)))
#define GAS __attribute__((address_space(1)))
typedef unsigned short bf16_t;
typedef short bf16x8 __attribute__((ext_vector_type(8)));
typedef short s16x4 __attribute__((ext_vector_type(4)));
typedef float f32x4 __attribute__((ext_vector_type(4)));
typedef float f32x2 __attribute__((ext_vector_type(2)));
typedef float f32x16 __attribute__((ext_vector_type(16)));
typedef unsigned u32x4 __attribute__((ext_vector_type(4)));
typedef unsigned u32x2 __attribute__((ext_vector_type(2)));

constexpr int NB = 8, SEQ = 2048, DM = 2048, TOK = NB * SEQ;
constexpr int AW = 1536, BW = 1024, MW = 1024, MEML = 256, INC = 18440;
constexpr int N1 = 8704, N2 = 9728, KP = 3584;
constexpr float EPS = 1e-6f, LOG2E = 1.4426950408889634f;
constexpr float SCQ128 = 0.08838834764831845f * LOG2E, SCQ256 = 0.0625f * LOG2E;

constexpr size_t MiB = 1u << 20;
constexpr size_t WS_CTL = 0, CTL_ZERO_BYTES = 1 * MiB;
constexpr size_t WS_F = 1 * MiB;
constexpr size_t WS_CS = WS_F + 512 * 1024;
constexpr size_t WS_LSE = 2 * MiB;
constexpr size_t WS_KM = 5 * MiB, WS_VM = 9 * MiB;
constexpr size_t WS_WTP = 13 * MiB;
constexpr size_t WS_WTO = 27 * MiB;
constexpr size_t WS_WT2 = 35 * MiB;
constexpr size_t WS_WT1 = 73 * MiB;
constexpr size_t WS_WTKV = 107 * MiB;
constexpr size_t WS_MH = 115 * MiB;
constexpr size_t WS_OA2 = 73 * MiB;
constexpr size_t WS_H = 123 * MiB;
constexpr size_t WS_MRG = 123 * MiB;
constexpr size_t WS_QA = 187 * MiB, WS_KA = 235 * MiB, WS_VA = 283 * MiB;
constexpr size_t WS_KB = 331 * MiB, WS_VB = 363 * MiB;
constexpr size_t WS_G = 187 * MiB;
constexpr size_t WS_QB = 395 * MiB, WS_QM = 427 * MiB;
constexpr size_t WS_Y = 459 * MiB;
constexpr size_t WS_END = 571 * MiB;

constexpr int RING_BYTES = 131072;
constexpr int LDSCTL_OFF = RING_BYTES, MISC_OFF = LDSCTL_OFF + 320;
constexpr int PSUM_OFF = RING_BYTES + 1024;
constexpr int LDS_BYTES = 147456;

#define LDS_WAIT() asm volatile("s_waitcnt lgkmcnt(0)" ::: "memory")
#define VM_WAIT() asm volatile("s_waitcnt vmcnt(0)" ::: "memory")
#define RLX_AGENT __ATOMIC_RELAXED, __HIP_MEMORY_SCOPE_AGENT
typedef GAS unsigned gu32;

#define opaque_tid() opaque_tid_(wave0_)
__device__ __forceinline__ int opaque_tid_(int wave0) { int l; asm volatile("v_mbcnt_lo_u32_b32 %0, -1, 0\n\tv_mbcnt_hi_u32_b32 %0, -1, %0" : "=v"(l)); return wave0 * 64 + l; }
typedef __bf16 bf16x2_t __attribute__((ext_vector_type(2)));
__device__ __forceinline__ unsigned cvt_pk_bf16(float lo, float hi) { f32x2 v = {lo, hi}; bf16x2_t b = __builtin_convertvector(v, bf16x2_t); return __builtin_bit_cast(unsigned, b); }
template <int CTRL> __device__ __forceinline__ float dpp_f(float v) { return __int_as_float(__builtin_amdgcn_update_dpp(0, __float_as_int(v), CTRL, 0xF, 0xF, true)); }
__device__ __forceinline__ float xor16_add(float v) { auto r = __builtin_amdgcn_permlane16_swap(__float_as_uint(v), __float_as_uint(v), false, false); return __uint_as_float(r[0]) + __uint_as_float(r[1]); }
__device__ __forceinline__ float xor32_add(float v) { auto r = __builtin_amdgcn_permlane32_swap(__float_as_uint(v), __float_as_uint(v), false, false); return __uint_as_float(r[0]) + __uint_as_float(r[1]); }
__device__ __forceinline__ float bf_lo(unsigned w) { return __uint_as_float(w << 16); }
__device__ __forceinline__ float bf_hi(unsigned w) { return __uint_as_float(w & 0xffff0000u); }
__device__ __forceinline__ float fast_sigmoid(float x) { return __builtin_amdgcn_rcpf(1.0f + __builtin_amdgcn_exp2f(-x * LOG2E)); }

#define XB_TMO      128
#define XB_XCNT(j)  (256  + 64 * (j))
#define XB_XSUB(j)  (1280 + 64 * (j))
#define XB_XGEN(j)  (2304 + 64 * (j))
#define XB_TOP      3328
#define XB_TOPGEN   3392
#define XCD_BAR_WORDS 3456
#define XB_SPIN_CAP (1u << 18)
__device__ __forceinline__ unsigned xb_ld(unsigned* p)              { return __hip_atomic_load(p, __ATOMIC_RELAXED, __HIP_MEMORY_SCOPE_AGENT); }
__device__ __forceinline__ unsigned xb_add(unsigned* p, unsigned v) { return __hip_atomic_fetch_add(p, v, __ATOMIC_RELAXED, __HIP_MEMORY_SCOPE_AGENT); }
__device__ __forceinline__ unsigned xb_xcc_id() { return (unsigned)__builtin_amdgcn_s_getreg((3 << 11) | 20) & 0xFu; }
#define XB_SPIN(cond, bar) do { unsigned _sp = 0; while (cond) { __builtin_amdgcn_s_sleep(1); \
    if ((++_sp & 255u) == 0u) { if (xb_ld(&(bar)[XB_TMO])) break; if (_sp > XB_SPIN_CAP) { atomicAdd(&(bar)[XB_TMO], 1u); break; } } } } while (0)
struct XcdBarrier { unsigned* bar; unsigned x; volatile LAS unsigned* st; };
__device__ __forceinline__ XcdBarrier xcd_barrier_post(unsigned* bar, volatile LAS unsigned* st, const int wave0_) {
    XcdBarrier b; b.bar = bar; b.x = xb_xcc_id(); b.st = st;
    if (opaque_tid() == 0) (void)xb_add(&bar[XB_XCNT(b.x)], 1u);
    return b;
}
__device__ __forceinline__ void xcd_barrier_complete(unsigned* bar, unsigned x, unsigned& nloc, unsigned& nx) {
    const unsigned G = gridDim.x * gridDim.y * gridDim.z;
    unsigned sum, cnt, mine, sp = 0u;
    for (;;) {
        sum = 0u; cnt = 0u; mine = 0u;
#pragma unroll
        for (unsigned j = 0; j < 16; ++j) { const unsigned c = xb_ld(&bar[XB_XCNT(j)]); sum += c; cnt += (c > 0u) ? 1u : 0u; mine = (j == x) ? c : mine; }
        if (sum == G) break;
        __builtin_amdgcn_s_sleep(1);
        if ((++sp & 255u) == 0u) { if (xb_ld(&bar[XB_TMO])) break; if (sp > XB_SPIN_CAP) { atomicAdd(&bar[XB_TMO], 1u); break; } }
    }
    nloc = mine > 0u ? mine : 1u; nx = cnt > 0u ? cnt : 1u;
}
__device__ __forceinline__ void xcd_barrier(const XcdBarrier& b, const int wave0_) {
    asm volatile("s_waitcnt vmcnt(0)" ::: "memory");
    __syncthreads();
    if (opaque_tid() == 0) {
        unsigned* bar = b.bar;
        __builtin_amdgcn_s_waitcnt(0);
        unsigned nloc = b.st[0], nx = b.st[1];
        if (nloc == 0u) { xcd_barrier_complete(bar, b.x, nloc, nx); b.st[0] = nloc; b.st[1] = nx; }
        const unsigned old = xb_add(&bar[XB_XSUB(b.x)], 1u);
        const unsigned gen = old / nloc;
        if (old + 1u == (gen + 1u) * nloc) {
            __builtin_amdgcn_fence(__ATOMIC_RELEASE, "agent");
            asm volatile("s_waitcnt vmcnt(0)" ::: "memory");
            const unsigned og = xb_add(&bar[XB_TOP], 1u);
            const unsigned tg = og / nx;
            if (og + 1u == (tg + 1u) * nx) xb_add(&bar[XB_TOPGEN], 1u);
            else XB_SPIN(xb_ld(&bar[XB_TOPGEN]) == tg, bar);
            __builtin_amdgcn_fence(__ATOMIC_ACQUIRE, "agent");
            xb_add(&bar[XB_XGEN(b.x)], 1u);
            asm volatile("s_waitcnt vmcnt(0)" ::: "memory");
        } else {
            XB_SPIN(xb_ld(&bar[XB_XGEN(b.x)]) == gen, bar);
            __builtin_amdgcn_fence(__ATOMIC_ACQUIRE, "agent");
            asm volatile("s_waitcnt vmcnt(0)" ::: "memory");
        }
    }
    __syncthreads();
}

__device__ __forceinline__ void xcd_barrier_arrive(const XcdBarrier& b, const int wave0_) {
    asm volatile("s_waitcnt vmcnt(0)" ::: "memory");
    __syncthreads();
    if (opaque_tid() == 0) {
        unsigned* bar = b.bar;
        __builtin_amdgcn_s_waitcnt(0);
        unsigned nloc = b.st[0], nx = b.st[1];
        if (nloc == 0u) { xcd_barrier_complete(bar, b.x, nloc, nx); b.st[0] = nloc; b.st[1] = nx; }
        const unsigned old = xb_add(&bar[XB_XSUB(b.x)], 1u);
        const unsigned gen = old / nloc;
        unsigned role = 0u, tg = 0u;
        if (old + 1u == (gen + 1u) * nloc) {
            __builtin_amdgcn_fence(__ATOMIC_RELEASE, "agent");
            asm volatile("s_waitcnt vmcnt(0)" ::: "memory");
            const unsigned og = xb_add(&bar[XB_TOP], 1u);
            tg = og / nx;
            if (og + 1u == (tg + 1u) * nx) { xb_add(&bar[XB_TOPGEN], 1u); xb_add(&bar[XB_XGEN(b.x)], 1u); role = 2u; } else role = 1u;
        }
        b.st[2] = gen; b.st[3] = tg; b.st[4] = role;
    }
}
__device__ __forceinline__ void xcd_barrier_wait(const XcdBarrier& b, const int wave0_) {
    if (opaque_tid() == 0) {
        unsigned* bar = b.bar; const unsigned gen = b.st[2], tg = b.st[3], role = b.st[4];
        if (role == 1u) { XB_SPIN(xb_ld(&bar[XB_TOPGEN]) == tg, bar); __builtin_amdgcn_fence(__ATOMIC_ACQUIRE, "agent"); xb_add(&bar[XB_XGEN(b.x)], 1u); }
        else if (role == 0u) { XB_SPIN(xb_ld(&bar[XB_XGEN(b.x)]) == gen, bar); __builtin_amdgcn_fence(__ATOMIC_ACQUIRE, "agent"); }
        else __builtin_amdgcn_fence(__ATOMIC_ACQUIRE, "agent");
    }
    __syncthreads();
}

namespace pg8 {
constexpr int BM = 256, BK = 64, HALF = 128, HTB = HALF * BK * 2, STAGE_BYTES = 8 * HTB, NXCD = 8, WGM = 8;
__host__ __device__ __forceinline__ int lds_byte(int r, int c) { const int st = (r >> 4) * 2 + (c >> 5), rr = r & 15, cc = c & 31, ob = rr * 64 + cc * 2; return st * 1024 + (ob ^ (((ob >> 9) & 1) << 5)); }
__host__ __device__ __forceinline__ void stage_rc(int b, int& R, int& C) { const int st = b / 1024, sb = b % 1024, swz = sb ^ (((sb >> 9) & 1) << 5); R = (st >> 1) * 16 + swz / 64; C = (st & 1) * 32 + (swz % 64) / 2; }
__host__ __device__ __forceinline__ int perm32(int rho) { const int n = rho >> 4, i = rho & 15; return 8 * (i >> 2) + 4 * n + (i & 3); }

struct Unit { int pm, pn, koff, nt, first, tag; };
struct Gemm { const bf16_t* A; const bf16_t* Bt; int lda, ldb; };

__device__ __forceinline__ void tile_of(int L, int nM, int nN, int& pm, int& pn) {
    const int nwg = nM * nN; int wgid = L;
    { const int q = nwg / NXCD, r = nwg % NXCD, xcd = wgid % NXCD, off = wgid / NXCD; wgid = (xcd < r ? xcd * (q + 1) : r * (q + 1) + (xcd - r) * q) + off; }
    const int nig = WGM * nN, gid = wgid / nig, fm = gid * WGM, gsz = (nM - fm) < WGM ? (nM - fm) : WGM;
    pm = fm + ((wgid % nig) % gsz); pn = (wgid % nig) / gsz;
}
struct StaticOrder {
    int nM, nN, nwg, G, c, nt, nu, rot;
    __device__ __forceinline__ void init(int M, int N, int K, int G_, int c_, int rot_ = 0) { nM = M / BM; nN = N / BM; nwg = nM * nN; G = G_; c = c_; nt = K / BK;
        nu = c < nwg ? (nwg - 1 - c) / G + 1 : 0; rot = nu > 0 ? rot_ % nu : 0; }
    __device__ __forceinline__ bool next(int i, Unit& u) const {
        if (i >= nu) return false; int ir = i + rot; if (ir >= nu) ir -= nu;
        const long L = (long)ir * G + c;
        tile_of((int)L, nM, nN, u.pm, u.pn); u.koff = 0; u.nt = nt; u.first = 1; u.tag = 0; return true;
    }
};
struct Sub3Order {
    int nM, nN, nwg, G, c, perm;
    __device__ __forceinline__ void init(int M, int N, int G_, int c_, int perm_) { nM = M / BM; nN = N / BM; nwg = nM * nN; G = G_; c = c_; perm = perm_ % 3; }
    __device__ __forceinline__ bool next(int i, Unit& u) const {
        const int ti = i / 3, s = i - 3 * ti; const long L = (long)ti * G + c; if (L >= nwg) return false;
        tile_of((int)L, nM, nN, u.pm, u.pn);
        int br = s + perm; if (br >= 3) br -= 3; int brn = br + 1; if (brn >= 3) brn -= 3;
        u.koff = br == 0 ? 0 : (br == 1 ? 1536 : 2560); u.nt = br == 0 ? 24 : 16; u.first = s == 0; u.tag = br | (brn << 2) | ((s == 2) << 4); return true;
    }
};

template <class Epi, class Sched>
__device__ __forceinline__ void gemm_phase(LAS unsigned char* lds, const Gemm g, const Sched& S, const Epi& E, const int wave0_) {
    const int tid = opaque_tid(), wid = __builtin_amdgcn_readfirstlane(tid >> 6), lane = tid & 63, wr = wid >> 2, wc = wid & 3, fr = lane & 15, fq = lane >> 4;
    unsigned voffA[2], voffB[2];
#pragma unroll
    for (int i = 0; i < 2; ++i) { int R, C; stage_rc(tid * 16 + i * 8192, R, C); const int Rb = Epi::PERM ? ((R & ~31) + perm32(R & 31)) : R;
        voffA[i] = (unsigned)(R * g.lda + C) * 2u; voffB[i] = (unsigned)(Rb * g.ldb + C) * 2u; }
    const size_t kstep = (size_t)(BK * 2);
    const size_t hstepA = (size_t)HALF * g.lda * 2, hstepB = (size_t)HALF * g.ldb * 2;
    const size_t tstepA = 2 * hstepA, tstepB = 2 * hstepB;
    const unsigned ldsw = (unsigned)wid * 1024u;
    const int aoff = lds_byte(wr * 64 + fr, fq * 8), boff = lds_byte(wc * 32 + fr, fq * 8);
#define PG8_SA(b, h) (((b) * 2 + (h)) * HTB)
#define PG8_SB(b, h) ((4 + (b) * 2 + (h)) * HTB)
#define PG8_STAGE(bufoff, gbase, voff) do { _Pragma("unroll") for (int _i = 0; _i < 2; ++_i) \
        __builtin_amdgcn_global_load_lds((const unsigned*)((const char*)(gbase) + (voff)[_i]), (LAS unsigned*)(lds + (bufoff) + ldsw + _i * 8192), 16, 0, 0); } while (0)
#define PG8_LDA(dst, b, h) do { _Pragma("unroll") for (int m = 0; m < 4; ++m) _Pragma("unroll") for (int k = 0; k < 2; ++k) dst[m][k] = *(const LAS bf16x8*)(lds + PG8_SA(b, h) + aoff + m * 2048 + k * 1024); } while (0)
#define PG8_LDB(dst, b, h) do { _Pragma("unroll") for (int n = 0; n < 2; ++n) _Pragma("unroll") for (int k = 0; k < 2; ++k) dst[n][k] = *(const LAS bf16x8*)(lds + PG8_SB(b, h) + boff + n * 2048 + k * 1024); } while (0)
#define PG8_MMA(ai, bj, At, Bt) do { __builtin_amdgcn_s_setprio(1); _Pragma("unroll") for (int m = 0; m < 4; ++m) _Pragma("unroll") for (int n = 0; n < 2; ++n) _Pragma("unroll") for (int k = 0; k < 2; ++k) \
        acc[ai][bj][m][n] = __builtin_amdgcn_mfma_f32_16x16x32_bf16(Bt[n][k], At[m][k], acc[ai][bj][m][n], 0, 0, 0); __builtin_amdgcn_s_setprio(0); } while (0)
#define PG8_WAIT_V(n) asm volatile("s_waitcnt vmcnt(" #n ")" ::: "memory")
#define PG8_WAIT_L(n) asm volatile("s_waitcnt lgkmcnt(" #n ")" ::: "memory")
#define PG8_BAR __builtin_amdgcn_s_barrier()
#define PG8_SCHED __builtin_amdgcn_sched_barrier(0)
    Unit cur, nxt; int ui = 0;
    if (!S.next(0, cur)) return;
    f32x4 acc[2][2][4][2];
#pragma unroll
    for (int a = 0; a < 2; ++a)
#pragma unroll
        for (int b = 0; b < 2; ++b)
#pragma unroll
            for (int m = 0; m < 4; ++m)
#pragma unroll
                for (int n = 0; n < 2; ++n) acc[a][b][m][n] = (f32x4){0.f, 0.f, 0.f, 0.f};
    if constexpr (Epi::ACCINIT) { E.acc_init(acc, cur, wr, wc, fr, fq); cur.tag |= 256; }
    if constexpr (Epi::PREWAIT) E.pre_wait(wave0_);
    u32x4 carry_[Epi::CARRY ? 8 : 1];
    bf16x8 At[4][2], B0[2][2], B1[2][2];
    const char* cA = (const char*)g.A + (size_t)cur.pm * tstepA + (size_t)cur.koff * 2; const char* cB = (const char*)g.Bt + (size_t)cur.pn * tstepB + (size_t)cur.koff * 2;
    PG8_STAGE(PG8_SB(0, 0), cB, voffB); PG8_STAGE(PG8_SB(0, 1), cB + hstepB, voffB); PG8_STAGE(PG8_SA(0, 0), cA, voffA); PG8_STAGE(PG8_SA(0, 1), cA + hstepA, voffA);
    if (wr == 1) PG8_BAR;
    PG8_WAIT_V(2); PG8_BAR;
    PG8_STAGE(PG8_SB(1, 0), cB + kstep, voffB); PG8_STAGE(PG8_SA(1, 0), cA + kstep, voffA); PG8_STAGE(PG8_SB(1, 1), cB + hstepB + kstep, voffB);
    PG8_WAIT_V(6); PG8_BAR;
    for (;;) {
        const bool has_next = S.next(ui + 1, nxt);
        const char* nA = has_next ? (const char*)g.A + (size_t)nxt.pm * tstepA + (size_t)nxt.koff * 2 : cA; const char* nB = has_next ? (const char*)g.Bt + (size_t)nxt.pn * tstepB + (size_t)nxt.koff * 2 : cB;
        const int nt = cur.nt;
        for (int t = 0; t < nt; t += 2) {
            const bool last = (t == nt - 2);
            const char* a1 = cA + (size_t)(t + 1) * kstep;
            const char* a2 = last ? nA : cA + (size_t)(t + 2) * kstep; const char* b2 = last ? nB : cB + (size_t)(t + 2) * kstep;
            const char* a3 = a2 + kstep; const char* b3 = b2 + kstep;
            PG8_LDB(B0, 0, 0); PG8_LDB(B1, 0, 1); PG8_SCHED; PG8_LDA(At, 0, 0); PG8_STAGE(PG8_SA(1, 1), a1 + hstepA, voffA);
            PG8_WAIT_V(8); PG8_WAIT_L(0); PG8_BAR; PG8_MMA(0, 0, At, B0); PG8_MMA(0, 1, At, B1); PG8_BAR; PG8_SCHED;
            PG8_LDA(At, 0, 1); PG8_STAGE(PG8_SB(0, 0), b2, voffB); PG8_STAGE(PG8_SB(0, 1), b2 + hstepB, voffB); PG8_STAGE(PG8_SA(0, 0), a2, voffA);
            PG8_WAIT_V(8); PG8_WAIT_L(0); PG8_BAR; PG8_MMA(1, 0, At, B0); PG8_MMA(1, 1, At, B1); PG8_BAR; PG8_SCHED;
            PG8_LDB(B0, 1, 0); PG8_LDB(B1, 1, 1); PG8_SCHED; PG8_LDA(At, 1, 0); PG8_STAGE(PG8_SA(0, 1), a2 + hstepA, voffA);
            PG8_WAIT_V(8); PG8_WAIT_L(0); PG8_BAR; PG8_MMA(0, 0, At, B0); PG8_MMA(0, 1, At, B1); PG8_BAR; PG8_SCHED;
            PG8_LDA(At, 1, 1); PG8_STAGE(PG8_SB(1, 0), b3, voffB); PG8_STAGE(PG8_SB(1, 1), b3 + hstepB, voffB); PG8_STAGE(PG8_SA(1, 0), a3, voffA);
            PG8_WAIT_V(8); PG8_WAIT_L(0); PG8_BAR; PG8_MMA(1, 0, At, B0); PG8_MMA(1, 1, At, B1); PG8_BAR; PG8_SCHED;
        }
        if (wr == 0) PG8_BAR;
        if constexpr (Epi::LAZYBAR) { if (ui == 0) E.lazy_wait(wave0_); }
        if constexpr (Epi::CARRY) E.call(acc, cur, wr, wc, fr, fq, wid, lane, carry_);
        else { E(acc, cur, wr, wc, fr, fq, wid, lane);
        if (Epi::DUP) E(acc, cur, wr, wc, fr, fq, wid, lane); }
        if (!has_next) break;
        if (nxt.first) {
#pragma unroll
            for (int a = 0; a < 2; ++a)
#pragma unroll
                for (int b = 0; b < 2; ++b)
#pragma unroll
                    for (int m = 0; m < 4; ++m)
#pragma unroll
                        for (int n = 0; n < 2; ++n) acc[a][b][m][n] = (f32x4){0.f, 0.f, 0.f, 0.f};
        }
        cur = nxt; cA = nA; cB = nB; ++ui;
        if (wr == 1) PG8_BAR;
    }
    PG8_WAIT_V(0);
    PG8_BAR;
#undef PG8_SA
#undef PG8_SB
#undef PG8_STAGE
#undef PG8_LDA
#undef PG8_LDB
#undef PG8_MMA
#undef PG8_WAIT_V
#undef PG8_WAIT_L
#undef PG8_BAR
#undef PG8_SCHED
}
}

typedef f32x4 AccT[2][2][4][2];

struct EpiQKV {
    static constexpr bool PERM = true, DUP = (DUP_EPI == 1), LAZYBAR = false, ACCINIT = false, PREWAIT = false, CARRY = false;
    unsigned char* ws; const float* gains[6]; int which;
    LAS unsigned char* lds;
    __device__ __forceinline__ void operator()(AccT& acc, const pg8::Unit& u, int wr, int wc, int fr, int fq, int wid, int lane) const {
        int mode, ldc, col; bf16_t* O; const float* gain = nullptr; float sc = 1.f; const int pn = u.pn;
        if (which == 0) {
            if (pn < 6)       { mode = 1; O = (bf16_t*)(ws + WS_QA); ldc = AW; col = pn * 256;        gain = gains[0]; sc = SCQ128; }
            else if (pn < 12) { mode = 1; O = (bf16_t*)(ws + WS_KA); ldc = AW; col = (pn - 6) * 256;  gain = gains[1]; }
            else if (pn < 18) { mode = 0; O = (bf16_t*)(ws + WS_VA); ldc = AW; col = (pn - 12) * 256; }
            else if (pn < 22) { mode = 1; O = (bf16_t*)(ws + WS_QB); ldc = BW; col = (pn - 18) * 256; gain = gains[2]; sc = SCQ128; }
            else if (pn < 26) { mode = 1; O = (bf16_t*)(ws + WS_KB); ldc = BW; col = (pn - 22) * 256; gain = gains[3]; }
            else if (pn < 30) { mode = 0; O = (bf16_t*)(ws + WS_VB); ldc = BW; col = (pn - 26) * 256; }
            else              { mode = 2; O = (bf16_t*)(ws + WS_QM); ldc = MW; col = (pn - 30) * 256; gain = gains[4]; sc = SCQ256; }
        } else {
            if (pn < 4)       { mode = 2; O = (bf16_t*)(ws + WS_KM); ldc = MW; col = pn * 256;        gain = gains[5]; }
            else              { mode = 0; O = (bf16_t*)(ws + WS_VM); ldc = MW; col = (pn - 4) * 256; }
        }
        float rs[2][4][2];
        if (mode != 0) {
            LAS float* P = (LAS float*)(lds + PSUM_OFF);
#pragma unroll
            for (int ai = 0; ai < 2; ++ai)
#pragma unroll
                for (int m = 0; m < 4; ++m)
#pragma unroll
                    for (int bj = 0; bj < 2; ++bj) {
                        const f32x4 a = acc[ai][bj][m][0], b = acc[ai][bj][m][1];
                        float s = (a[0] * a[0] + a[1] * a[1]) + (a[2] * a[2] + a[3] * a[3]) + (b[0] * b[0] + b[1] * b[1]) + (b[2] * b[2] + b[3] * b[3]);
                        s = xor16_add(s); s = xor32_add(s);
                        if (fq == 0) P[((ai * 128 + wr * 64 + m * 16 + fr) * 2 + bj) * 4 + wc] = s;
                    }
            asm volatile("s_waitcnt lgkmcnt(0)" ::: "memory"); __builtin_amdgcn_s_barrier(); asm volatile("" ::: "memory");
#pragma unroll
            for (int ai = 0; ai < 2; ++ai)
#pragma unroll
                for (int m = 0; m < 4; ++m) {
                    const LAS f32x4* pr = (const LAS f32x4*)(P + (ai * 128 + wr * 64 + m * 16 + fr) * 8);
                    const f32x4 s0 = pr[0], s1 = pr[1];
                    const float t0 = (s0[0] + s0[1]) + (s0[2] + s0[3]), t1 = (s1[0] + s1[1]) + (s1[2] + s1[3]);
                    if (mode == 1) { rs[ai][m][0] = sc * __builtin_amdgcn_rsqf(t0 * (1.f / 128.f) + EPS); rs[ai][m][1] = sc * __builtin_amdgcn_rsqf(t1 * (1.f / 128.f) + EPS); }
                    else { const float r = sc * __builtin_amdgcn_rsqf((t0 + t1) * (1.f / 256.f) + EPS); rs[ai][m][0] = r; rs[ai][m][1] = r; }
                }
        }
        const int row0 = u.pm * 256 + wr * 64 + fr, col0 = col + wc * 32 + 8 * fq;
        f32x4 gv[2][2];
#pragma unroll
        for (int bj = 0; bj < 2; ++bj)
#pragma unroll
            for (int n = 0; n < 2; ++n) {
                if (mode == 0) gv[bj][n] = (f32x4){1.f, 1.f, 1.f, 1.f};
                else { const int gc = (mode == 1 ? 0 : bj * 128) + wc * 32 + 8 * fq + 4 * n; gv[bj][n] = *(const f32x4*)(gain + gc); }
            }
#pragma unroll
        for (int ai = 0; ai < 2; ++ai)
#pragma unroll
            for (int m = 0; m < 4; ++m) { bf16_t* rowp = O + (size_t)(row0 + ai * 128 + m * 16) * ldc + col0;
#pragma unroll
                for (int bj = 0; bj < 2; ++bj) {
                    f32x4 v0 = acc[ai][bj][m][0] * gv[bj][0], v1 = acc[ai][bj][m][1] * gv[bj][1];
                    if (mode != 0) { const float r = rs[ai][m][bj]; v0 = v0 * r; v1 = v1 * r; }
                    u32x4 w; w.x = cvt_pk_bf16(v0[0], v0[1]); w.y = cvt_pk_bf16(v0[2], v0[3]); w.z = cvt_pk_bf16(v1[0], v1[1]); w.w = cvt_pk_bf16(v1[2], v1[3]);
                    *(u32x4*)(rowp + bj * 128) = w; } }
    }
};

struct EpiZG {
    static constexpr bool PERM = true, DUP = false, LAZYBAR = true, ACCINIT = false, PREWAIT = false, CARRY = false;
    unsigned char* ws; const bf16_t* oa0; const bf16_t* oa1; const float* bgate;
    XcdBarrier wb; bool lazy;
    __device__ __forceinline__ void lazy_wait(const int wave0_) const { if (lazy) xcd_barrier_wait(wb, wave0_); }
    __device__ __forceinline__ void operator()(AccT& acc, const pg8::Unit& u, int wr, int wc, int fr, int fq, int wid, int lane) const {
        const int pn = u.pn; const int row0 = u.pm * 256 + wr * 64 + fr, cw = wc * 32 + 8 * fq;
        bf16_t* Y = (bf16_t*)(ws + WS_Y);
        if (pn < 6) {
            const unsigned char* o0 = (const unsigned char*)oa0; const unsigned char* o1 = (const unsigned char*)oa1; const unsigned char* o2 = (const unsigned char*)(ws + WS_OA2);
            const float* lse = (const float*)(ws + WS_LSE); const float* scl = (const float*)(ws + WS_OA2 + 32 * MiB);
#define UB(w, k) ((float)(((w) >> (8 * (k))) & 0xffu))
#pragma unroll
            for (int ab = 0; ab < 4; ++ab) { const int ai = ab >> 1, m0 = (ab & 1) * 2;
                float L[2][2][3], S[2][2][3]; u32x2 P[2][2][3];
#pragma unroll
                for (int mm = 0; mm < 2; ++mm) { const int row = row0 + ai * 128 + (m0 + mm) * 16;
#pragma unroll
                    for (int bj = 0; bj < 2; ++bj) { const int head = 2 * pn + bj, c = pn * 256 + bj * 128 + cw;
                        L[mm][bj][0] = lse[(size_t)row * 12 + head]; L[mm][bj][1] = lse[((size_t)TOK + row) * 12 + head]; L[mm][bj][2] = lse[((size_t)2 * TOK + row) * 12 + head];
                        S[mm][bj][0] = scl[(size_t)row * 12 + head]; S[mm][bj][1] = scl[((size_t)TOK + row) * 12 + head]; S[mm][bj][2] = scl[((size_t)2 * TOK + row) * 12 + head];
                        P[mm][bj][0] = *(const u32x2*)(o0 + (size_t)row * AW + c); P[mm][bj][1] = *(const u32x2*)(o1 + (size_t)row * AW + c); P[mm][bj][2] = *(const u32x2*)(o2 + (size_t)row * AW + c); } }
                asm volatile("" ::: "memory");
#pragma unroll
                for (int mm = 0; mm < 2; ++mm) { const int m = m0 + mm, row = row0 + ai * 128 + m * 16;
#pragma unroll
                    for (int bj = 0; bj < 2; ++bj) { const int c = pn * 256 + bj * 128 + cw;
                        const float l0 = L[mm][bj][0], l1 = L[mm][bj][1], l2 = L[mm][bj][2];
                        const float mx = fmaxf(l0, fmaxf(l1, l2));
                        float w0 = __builtin_amdgcn_exp2f(l0 - mx), w1 = __builtin_amdgcn_exp2f(l1 - mx), w2 = __builtin_amdgcn_exp2f(l2 - mx);
                        const float inv = __builtin_amdgcn_rcpf(w0 + w1 + w2); w0 *= inv * S[mm][bj][0]; w1 *= inv * S[mm][bj][1]; w2 *= inv * S[mm][bj][2];
                        const float nb = -128.f * (w0 + w1 + w2);
                        const u32x2 p0 = P[mm][bj][0], p1 = P[mm][bj][1], p2 = P[mm][bj][2];
                        const f32x4 z0 = acc[ai][bj][m][0], z1 = acc[ai][bj][m][1]; float y[8];
#pragma unroll
                        for (int j = 0; j < 8; ++j) { const float ov = w0 * UB(p0[j >> 2], j & 3) + w1 * UB(p1[j >> 2], j & 3) + w2 * UB(p2[j >> 2], j & 3) + nb;
                            const float zv = j < 4 ? z0[j] : z1[j - 4];
                            y[j] = ov * zv * fast_sigmoid(zv); }
                        u32x4 w; w.x = cvt_pk_bf16(y[0], y[1]); w.y = cvt_pk_bf16(y[2], y[3]); w.z = cvt_pk_bf16(y[4], y[5]); w.w = cvt_pk_bf16(y[6], y[7]);
                        *(u32x4*)(Y + (size_t)row * KP + c) = w; } }
                asm volatile("" ::: "memory"); }
#undef UB
        } else if (pn < 14) {
            const int cb = (pn < 10 ? AW + (pn - 6) * 256 : AW + BW + (pn - 10) * 256) + cw;
#pragma unroll
            for (int ai = 0; ai < 2; ++ai) { u32x4 P[4][2];
#pragma unroll
                for (int m = 0; m < 4; ++m) { const bf16_t* rowp = Y + (size_t)(row0 + ai * 128 + m * 16) * KP + cb;
#pragma unroll
                    for (int bj = 0; bj < 2; ++bj) P[m][bj] = *(const u32x4*)(rowp + bj * 128); }
                asm volatile("" ::: "memory");
#pragma unroll
                for (int m = 0; m < 4; ++m) { bf16_t* rowp = Y + (size_t)(row0 + ai * 128 + m * 16) * KP + cb;
#pragma unroll
                    for (int bj = 0; bj < 2; ++bj) { const u32x4 p = P[m][bj];
                        const f32x4 z0 = acc[ai][bj][m][0], z1 = acc[ai][bj][m][1]; float y[8];
#pragma unroll
                        for (int j = 0; j < 4; ++j) { const float zl = j < 2 ? z0[2 * j] : z1[2 * j - 4], zh = j < 2 ? z0[2 * j + 1] : z1[2 * j - 3];
                            y[2 * j] = bf_lo(p[j]) * zl * fast_sigmoid(zl); y[2 * j + 1] = bf_hi(p[j]) * zh * fast_sigmoid(zh); }
                        u32x4 w; w.x = cvt_pk_bf16(y[0], y[1]); w.y = cvt_pk_bf16(y[2], y[3]); w.z = cvt_pk_bf16(y[4], y[5]); w.w = cvt_pk_bf16(y[6], y[7]);
                        *(u32x4*)(rowp + bj * 128) = w; } }
                asm volatile("" ::: "memory"); }
        } else {
            const int idx = pn - 14, br = idx >> 3, cg = (idx & 7) * 256 + cw;
            unsigned char* G8 = (unsigned char*)(ws + WS_G) + (size_t)br * TOK * DM + (idx & 7) * 256 + (wc * 4 + fq) * 16; const float* bg = bgate + br * DM + cg;
            f32x4 bv[2][2];
#pragma unroll
            for (int bj = 0; bj < 2; ++bj)
#pragma unroll
                for (int n = 0; n < 2; ++n) bv[bj][n] = *(const f32x4*)(bg + bj * 128 + 4 * n);
#define GQ8(x) fmaxf(255.f * fast_sigmoid(x), 1.f)
#define PK8(v) __builtin_amdgcn_cvt_pk_u8_f32(GQ8(v[3]), 3, __builtin_amdgcn_cvt_pk_u8_f32(GQ8(v[2]), 2, __builtin_amdgcn_cvt_pk_u8_f32(GQ8(v[1]), 1, __builtin_amdgcn_cvt_pk_u8_f32(GQ8(v[0]), 0, 0u))))
#pragma unroll
            for (int ai = 0; ai < 2; ++ai)
#pragma unroll
                for (int m = 0; m < 4; ++m) { u32x4 w;
                    { const f32x4 v0 = acc[ai][0][m][0] + bv[0][0], v1 = acc[ai][0][m][1] + bv[0][1]; w.x = PK8(v0); w.y = PK8(v1); }
                    { const f32x4 v0 = acc[ai][1][m][0] + bv[1][0], v1 = acc[ai][1][m][1] + bv[1][1]; w.z = PK8(v0); w.w = PK8(v1); }
                    *(u32x4*)(G8 + (size_t)(row0 + ai * 128 + m * 16) * DM) = w; }
#undef PK8
#undef GQ8
        }
    }
};

struct EpiMerge {
    static constexpr bool PERM = true, DUP = false, LAZYBAR = false, ACCINIT = false, PREWAIT = false, CARRY = true;
    unsigned char* ws;
    __device__ __forceinline__ void call(AccT& acc, const pg8::Unit& u, int wr, int wc, int fr, int fq, int wid, int lane, u32x4 (&cy)[8]) const {
        const int br = u.tag & 3, brn = (u.tag >> 2) & 3; const bool last = (u.tag >> 4) != 0, first = u.first != 0;
        const int row0 = u.pm * 256 + wr * 64 + fr, c0 = u.pn * 256 + wc * 32 + 8 * fq;
        const unsigned char* Ga = (const unsigned char*)(ws + WS_G) + (size_t)br * TOK * DM + u.pn * 256 + (wc * 4 + fq) * 16;
        const unsigned char* Gb = (const unsigned char*)(ws + WS_G) + (size_t)brn * TOK * DM + u.pn * 256 + (wc * 4 + fq) * 16;
        bf16_t* Mg = (bf16_t*)(ws + WS_MRG);
#define UB(w, k) ((float)(((w) >> (8 * (k))) & 0xffu))
#pragma unroll
        for (int ai = 0; ai < 2; ++ai) { u32x4 ga[4], gb[4];
            if (first) {
#pragma unroll
                for (int m = 0; m < 4; ++m) ga[m] = *(const u32x4*)(Ga + (size_t)(row0 + ai * 128 + m * 16) * DM);
            } else {
#pragma unroll
                for (int m = 0; m < 4; ++m) ga[m] = cy[ai * 4 + m];
            }
            if (!last) {
#pragma unroll
                for (int m = 0; m < 4; ++m) gb[m] = *(const u32x4*)(Gb + (size_t)(row0 + ai * 128 + m * 16) * DM);
            } else {
#pragma unroll
                for (int m = 0; m < 4; ++m) gb[m] = ga[m];
            }
            asm volatile("" ::: "memory");
#pragma unroll
            for (int m = 0; m < 4; ++m) { const size_t off = (size_t)(row0 + ai * 128 + m * 16) * DM + c0;
#pragma unroll
                for (int bj = 0; bj < 2; ++bj) { float f[8];
#pragma unroll
                    for (int j = 0; j < 8; ++j) { const unsigned wa = ga[m][2 * bj + (j >> 2)], wb = gb[m][2 * bj + (j >> 2)];
                        f[j] = UB(wa, j & 3) * (last ? (1.f / 255.f) : __builtin_amdgcn_rcpf(UB(wb, j & 3))); }
                    f32x4 v0 = acc[ai][bj][m][0], v1 = acc[ai][bj][m][1];
                    v0 = v0 * (f32x4){f[0], f[1], f[2], f[3]}; v1 = v1 * (f32x4){f[4], f[5], f[6], f[7]};
                    acc[ai][bj][m][0] = v0; acc[ai][bj][m][1] = v1;
                    if (last) { u32x4 w; w.x = cvt_pk_bf16(v0[0], v0[1]); w.y = cvt_pk_bf16(v0[2], v0[3]); w.z = cvt_pk_bf16(v1[0], v1[1]); w.w = cvt_pk_bf16(v1[2], v1[3]);
                        *(u32x4*)(Mg + off + bj * 128) = w; } }
                cy[ai * 4 + m] = gb[m]; }
            asm volatile("" ::: "memory"); }
#undef UB
    }
    __device__ __forceinline__ void operator()(AccT&, const pg8::Unit&, int, int, int, int, int, int) const {}
};

struct EpiOut {
    static constexpr bool PERM = false, DUP = (DUP_EPI == 5), LAZYBAR = false, ACCINIT = true, PREWAIT = true, CARRY = false;
    const float* x; float* out;
    XcdBarrier wb; bool lazy;
    __device__ __forceinline__ void pre_wait(const int wave0_) const { if (lazy) xcd_barrier_wait(wb, wave0_); }
    __device__ __forceinline__ void acc_init(AccT& acc, const pg8::Unit& u, int wr, int wc, int fr, int fq) const {
        const int row0 = u.pm * 256 + wr * 64 + fr, col0 = u.pn * 256 + wc * 32 + 4 * fq;
#pragma unroll
        for (int ai = 0; ai < 2; ++ai)
#pragma unroll
            for (int m = 0; m < 4; ++m) { const size_t off = (size_t)(row0 + ai * 128 + m * 16) * DM + col0;
#pragma unroll
                for (int bj = 0; bj < 2; ++bj)
#pragma unroll
                    for (int n = 0; n < 2; ++n) acc[ai][bj][m][n] = *(const f32x4*)(x + off + bj * 128 + n * 16); }
    }
    __device__ __forceinline__ void operator()(AccT& acc, const pg8::Unit& u, int wr, int wc, int fr, int fq, int wid, int lane) const {
        const int row0 = u.pm * 256 + wr * 64 + fr, col0 = u.pn * 256 + wc * 32 + 4 * fq;
        if (u.tag & 256) {
#pragma unroll
            for (int ai = 0; ai < 2; ++ai)
#pragma unroll
                for (int m = 0; m < 4; ++m) { const size_t off = (size_t)(row0 + ai * 128 + m * 16) * DM + col0;
#pragma unroll
                    for (int bj = 0; bj < 2; ++bj)
#pragma unroll
                        for (int n = 0; n < 2; ++n) *(f32x4*)(out + off + bj * 128 + n * 16) = acc[ai][bj][m][n]; }
            return;
        }
#pragma unroll
        for (int ab = 0; ab < 2; ++ab) { const int ai = ab, m0 = 0; f32x4 xv[4][2][2];
#pragma unroll
            for (int mm = 0; mm < 4; ++mm) { const size_t off = (size_t)(row0 + ai * 128 + (m0 + mm) * 16) * DM + col0;
#pragma unroll
                for (int bj = 0; bj < 2; ++bj)
#pragma unroll
                    for (int n = 0; n < 2; ++n) xv[mm][bj][n] = *(const f32x4*)(x + off + bj * 128 + n * 16); }
            asm volatile("" ::: "memory");
#pragma unroll
            for (int mm = 0; mm < 4; ++mm) { const size_t off = (size_t)(row0 + ai * 128 + (m0 + mm) * 16) * DM + col0;
#pragma unroll
                for (int bj = 0; bj < 2; ++bj)
#pragma unroll
                    for (int n = 0; n < 2; ++n) *(f32x4*)(out + off + bj * 128 + n * 16) = xv[mm][bj][n] + acc[ai][bj][m0 + mm][n]; }
            asm volatile("" ::: "memory"); }
    }
};

namespace att {
#define KSWZ(row, colB) ((row) * 256 + ((colB) ^ (((row) & 7) << 4)))
#define SBAR() __builtin_amdgcn_sched_barrier(0)
constexpr int SHM_V = 16384, SHM_K = 16384;
constexpr int V_OFF = 0, K_OFF = 49152, WS_OFF = 114688, TAB_OFF = 116736, CSL_OFF = 118784;
constexpr float THR2 = 8.f;
__device__ __forceinline__ int crow(int r, int hi) { return (r & 3) + 8 * (r >> 2) + 4 * hi; }
__device__ __forceinline__ int v_st(int k, int c) { const int kk = (k & ~0xC) | ((k & 4) << 1) | ((k & 8) >> 1); return ((kk >> 3) * 4 + (c >> 5)) * 512 + ((kk & 7) * 32 + (c & 31)) * 2; }
__device__ __forceinline__ int swap23(int k) { return (k & ~0xC) | ((k & 4) << 1) | ((k & 8) >> 1); }
#define GLDS(src, dst) asm volatile("s_mov_b32 m0, %1\n\tglobal_load_lds_dwordx4 %0, off" :: "v"(src), "s"((unsigned)(uintptr_t)(dst)) : "memory", "m0")
__device__ __forceinline__ int v_rd_base(int lane) { return ((lane & 3) << 3) | (((lane >> 2) & 3) << 6) | (((lane >> 4) & 1) << 5) | (((lane >> 5) & 1) << 8); }
constexpr int v_rd_off(int d0, int ks, int half) { return d0 * 512 + ks * 4096 + half * 2048; }

template <bool ACCUM>
__device__ __forceinline__ void qkt(f32x16& p0, f32x16& p1, const LAS char* Kimg, int r32, int hi, const bf16x8* qr) {
    if (!ACCUM) { p0 = f32x16{}; p1 = f32x16{}; }
    const LAS char* kb[4];
#pragma unroll
    for (int dd = 0; dd < 4; ++dd) kb[dd] = Kimg + KSWZ(r32, (dd * 16 + hi * 8) * 2);
    __builtin_amdgcn_s_setprio(1);
    bf16x8 f0[8], f1[8];
#pragma unroll
    for (int d0 = 0; d0 < 8; ++d0) { const LAS char* a = kb[d0 & 3] + (d0 >> 2) * 128; f0[d0] = *(const LAS bf16x8*)(a); f1[d0] = *(const LAS bf16x8*)(a + 32 * 256); }
#pragma unroll
    for (int d0 = 0; d0 < 8; ++d0) { p0 = __builtin_amdgcn_mfma_f32_32x32x16_bf16(f0[d0], qr[d0], p0, 0, 0, 0); p1 = __builtin_amdgcn_mfma_f32_32x32x16_bf16(f1[d0], qr[d0], p1, 0, 0, 0); }
    __builtin_amdgcn_sched_group_barrier(0x100, 4, 0);
#pragma unroll
    for (int d0 = 0; d0 < 6; ++d0) { __builtin_amdgcn_sched_group_barrier(0x008, 2, 0); __builtin_amdgcn_sched_group_barrier(0x100, 2, 0); }
    __builtin_amdgcn_sched_group_barrier(0x008, 4, 0);
    __builtin_amdgcn_s_setprio(0);
}
typedef short v4i16_t __attribute__((ext_vector_type(4)));
__device__ __forceinline__ s16x4 vtr(int addr) { return __builtin_bit_cast(s16x4, __builtin_amdgcn_ds_read_tr16_b64_v4i16((LAS v4i16_t*)(uintptr_t)(unsigned)addr)); }
__device__ __forceinline__ void pv_tile(f32x16* o, int vb, bf16x8 pa0, bf16x8 pa1, bf16x8 pa2, bf16x8 pa3) {
#define PV_D0(d0) do { constexpr int b_ = v_rd_off(d0, 0, 0); \
        const s16x4 l0 = vtr(vb + b_), h0 = vtr(vb + b_ + 2048), l1 = vtr(vb + b_ + 4096), h1 = vtr(vb + b_ + 6144), l2 = vtr(vb + b_ + 8192), h2 = vtr(vb + b_ + 10240), l3 = vtr(vb + b_ + 12288), h3 = vtr(vb + b_ + 14336); \
        o[d0] = __builtin_amdgcn_mfma_f32_32x32x16_bf16((bf16x8){l0[0], l0[1], l0[2], l0[3], h0[0], h0[1], h0[2], h0[3]}, pa0, o[d0], 0, 0, 0);   \
        o[d0] = __builtin_amdgcn_mfma_f32_32x32x16_bf16((bf16x8){l1[0], l1[1], l1[2], l1[3], h1[0], h1[1], h1[2], h1[3]}, pa1, o[d0], 0, 0, 0);   \
        o[d0] = __builtin_amdgcn_mfma_f32_32x32x16_bf16((bf16x8){l2[0], l2[1], l2[2], l2[3], h2[0], h2[1], h2[2], h2[3]}, pa2, o[d0], 0, 0, 0);   \
        o[d0] = __builtin_amdgcn_mfma_f32_32x32x16_bf16((bf16x8){l3[0], l3[1], l3[2], l3[3], h3[0], h3[1], h3[2], h3[3]}, pa3, o[d0], 0, 0, 0); } while (0)
    __builtin_amdgcn_s_setprio(1);
    PV_D0(0); PV_D0(1); PV_D0(2); PV_D0(3);
    __builtin_amdgcn_s_setprio(0);
#undef PV_D0
}
__device__ __forceinline__ void store_o_rows(bf16_t* rowp, const f32x16* o, const float rl) {
#pragma unroll
    for (int d0 = 0; d0 < 4; ++d0)
#pragma unroll
        for (int j = 0; j < 2; ++j) { const int a = 8 * j, b = 8 * j + 4;
            const unsigned A0 = cvt_pk_bf16(o[d0][a] * rl, o[d0][a + 1] * rl), A1 = cvt_pk_bf16(o[d0][a + 2] * rl, o[d0][a + 3] * rl);
            const unsigned B0 = cvt_pk_bf16(o[d0][b] * rl, o[d0][b + 1] * rl), B1 = cvt_pk_bf16(o[d0][b + 2] * rl, o[d0][b + 3] * rl);
            auto r0 = __builtin_amdgcn_permlane32_swap(A0, B0, false, false); auto r1 = __builtin_amdgcn_permlane32_swap(A1, B1, false, false);
            const u32x4 w = {r0[0], r1[0], r0[1], r1[1]};
            *(u32x4*)(rowp + d0 * 32 + j * 16) = w; }
}
__device__ __forceinline__ void softmax_tile(f32x16& p0, f32x16& p1, float& m_reg, float& l_reg, float& alpha, bf16x8& pa0, bf16x8& pa1, bf16x8& pa2, bf16x8& pa3) {
    float pmax = p0[0];
#pragma unroll
    for (int r = 1; r < 16; ++r) pmax = fmaxf(pmax, p0[r]);
#pragma unroll
    for (int r = 0; r < 16; ++r) pmax = fmaxf(pmax, p1[r]);
    { auto rr = __builtin_amdgcn_permlane32_swap(__float_as_uint(pmax), __float_as_uint(pmax), false, false);
      pmax = fmaxf(__uint_as_float(rr[0]), __uint_as_float(rr[1])); }
    float mn;
    if (__builtin_expect(__all(pmax - m_reg <= THR2), 1)) { mn = m_reg; alpha = 1.f; }
    else { mn = fmaxf(m_reg, pmax); alpha = __builtin_amdgcn_exp2f(m_reg - mn); m_reg = mn; }
    const f32x2 mn2 = {mn, mn}; f32x2 ps2a = {0.f, 0.f}, ps2b = {0.f, 0.f};
#pragma unroll
    for (int r = 0; r < 8; ++r) { f32x2 v = {p0[2 * r], p0[2 * r + 1]}; v = v - mn2; v[0] = __builtin_amdgcn_exp2f(v[0]); v[1] = __builtin_amdgcn_exp2f(v[1]); p0[2 * r] = v[0]; p0[2 * r + 1] = v[1]; ps2a += v; }
#pragma unroll
    for (int r = 0; r < 8; ++r) { f32x2 v = {p1[2 * r], p1[2 * r + 1]}; v = v - mn2; v[0] = __builtin_amdgcn_exp2f(v[0]); v[1] = __builtin_amdgcn_exp2f(v[1]); p1[2 * r] = v[0]; p1[2 * r + 1] = v[1]; ps2b += v; }
    ps2a += ps2b; float ps = ps2a[0] + ps2a[1];
    { auto rr = __builtin_amdgcn_permlane32_swap(__float_as_uint(ps), __float_as_uint(ps), false, false);
      ps = __uint_as_float(rr[0]) + __uint_as_float(rr[1]); }
    l_reg = l_reg * alpha + ps;
#define PK4(P, B_, OUT) do { unsigned a0 = cvt_pk_bf16(P[B_+0], P[B_+1]), a1 = cvt_pk_bf16(P[B_+2], P[B_+3]);                          \
        unsigned b0 = cvt_pk_bf16(P[B_+4], P[B_+5]), b1 = cvt_pk_bf16(P[B_+6], P[B_+7]);                                             \
        auto r0 = __builtin_amdgcn_permlane32_swap(a0, b0, false, false); auto r1 = __builtin_amdgcn_permlane32_swap(a1, b1, false, false); \
        u32x4 w = {r0[0], r1[0], r0[1], r1[1]}; OUT = *reinterpret_cast<bf16x8*>(&w); } while (0)
    PK4(p0, 0, pa0); PK4(p0, 8, pa1); PK4(p1, 0, pa2); PK4(p1, 8, pa3);
#undef PK4
}

struct AU {
    const bf16_t* Q; int ldq;
    const bf16_t* K; const bf16_t* V; int ldk;
    bf16_t* O; int ldo;
    float* lse;
    unsigned char* O8; float* sc;
    const float* cs;
    const float* relb;
    int hh;
    int v0;
    int Lm, Ls, dil;
    int kb0, NT;
};

__device__ __forceinline__ void pv_softmax(f32x16* o, const int vb, const bf16x8 q0, const bf16x8 q1, const bf16x8 q2, const bf16x8 q3,
                                           f32x16& p0, f32x16& p1, float& m_reg, float& l_reg, float& alpha, bf16x8& pa0, bf16x8& pa1, bf16x8& pa2, bf16x8& pa3) {
#define PVQ_D0(d0) do { constexpr int b_ = v_rd_off(d0, 0, 0); \
        const s16x4 l0 = vtr(vb + b_), h0 = vtr(vb + b_ + 2048), l1 = vtr(vb + b_ + 4096), h1 = vtr(vb + b_ + 6144), l2 = vtr(vb + b_ + 8192), h2 = vtr(vb + b_ + 10240), l3 = vtr(vb + b_ + 12288), h3 = vtr(vb + b_ + 14336); \
        o[d0] = __builtin_amdgcn_mfma_f32_32x32x16_bf16((bf16x8){l0[0], l0[1], l0[2], l0[3], h0[0], h0[1], h0[2], h0[3]}, q0, o[d0], 0, 0, 0);   \
        o[d0] = __builtin_amdgcn_mfma_f32_32x32x16_bf16((bf16x8){l1[0], l1[1], l1[2], l1[3], h1[0], h1[1], h1[2], h1[3]}, q1, o[d0], 0, 0, 0);   \
        o[d0] = __builtin_amdgcn_mfma_f32_32x32x16_bf16((bf16x8){l2[0], l2[1], l2[2], l2[3], h2[0], h2[1], h2[2], h2[3]}, q2, o[d0], 0, 0, 0);   \
        o[d0] = __builtin_amdgcn_mfma_f32_32x32x16_bf16((bf16x8){l3[0], l3[1], l3[2], l3[3], h3[0], h3[1], h3[2], h3[3]}, q3, o[d0], 0, 0, 0); } while (0)
    PVQ_D0(0); PVQ_D0(1); PVQ_D0(2); PVQ_D0(3);
#undef PVQ_D0
    float pmax = p0[0];
#pragma unroll
    for (int r = 1; r < 16; ++r) pmax = fmaxf(pmax, p0[r]);
#pragma unroll
    for (int r = 0; r < 16; ++r) pmax = fmaxf(pmax, p1[r]);
    { auto rr = __builtin_amdgcn_permlane32_swap(__float_as_uint(pmax), __float_as_uint(pmax), false, false);
      pmax = fmaxf(__uint_as_float(rr[0]), __uint_as_float(rr[1])); }
    const bool ok = __all(pmax - m_reg <= THR2);
    const float mn = ok ? m_reg : fmaxf(m_reg, pmax);
    alpha = __builtin_amdgcn_exp2f(m_reg - mn); m_reg = mn;
    const f32x2 mn2 = {mn, mn}; f32x2 ps2a = {0.f, 0.f}, ps2b = {0.f, 0.f};
#pragma unroll
    for (int r = 0; r < 8; ++r) { f32x2 v = {p0[2 * r], p0[2 * r + 1]}; v = v - mn2; v[0] = __builtin_amdgcn_exp2f(v[0]); v[1] = __builtin_amdgcn_exp2f(v[1]); p0[2 * r] = v[0]; p0[2 * r + 1] = v[1]; ps2a += v; }
#pragma unroll
    for (int r = 0; r < 8; ++r) { f32x2 v = {p1[2 * r], p1[2 * r + 1]}; v = v - mn2; v[0] = __builtin_amdgcn_exp2f(v[0]); v[1] = __builtin_amdgcn_exp2f(v[1]); p1[2 * r] = v[0]; p1[2 * r + 1] = v[1]; ps2b += v; }
    ps2a += ps2b; float ps = ps2a[0] + ps2a[1];
    { auto rr = __builtin_amdgcn_permlane32_swap(__float_as_uint(ps), __float_as_uint(ps), false, false);
      ps = __uint_as_float(rr[0]) + __uint_as_float(rr[1]); }
    l_reg = l_reg * alpha + ps;
#define PK4(P, B_, OUT) do { unsigned a0 = cvt_pk_bf16(P[B_+0], P[B_+1]), a1 = cvt_pk_bf16(P[B_+2], P[B_+3]);                          \
        unsigned b0 = cvt_pk_bf16(P[B_+4], P[B_+5]), b1 = cvt_pk_bf16(P[B_+6], P[B_+7]);                                             \
        auto r0 = __builtin_amdgcn_permlane32_swap(a0, b0, false, false); auto r1 = __builtin_amdgcn_permlane32_swap(a1, b1, false, false); \
        u32x4 w = {r0[0], r1[0], r0[1], r1[1]}; OUT = *reinterpret_cast<bf16x8*>(&w); } while (0)
    PK4(p0, 0, pa0); PK4(p0, 8, pa1); PK4(p1, 0, pa2); PK4(p1, 8, pa3);
#undef PK4
    __builtin_amdgcn_sched_group_barrier(0x100, 8, 0);
#pragma unroll
    for (int i = 0; i < 16; ++i) { __builtin_amdgcn_sched_group_barrier(0x008, 1, 0); __builtin_amdgcn_sched_group_barrier(0x002, 6, 0); __builtin_amdgcn_sched_group_barrier(0x400, 2, 0);
        __builtin_amdgcn_sched_group_barrier(0x100, 2, 0); }
}
template <int MODE>
__device__ __forceinline__ void attn_unit(LAS char* lds, const AU& u, const int wave0_) {
    constexpr int NKH = MODE == 2 ? 2 : 1;
    const int tid = opaque_tid(), wid = __builtin_amdgcn_readfirstlane(tid >> 6), lane = tid & 63, r32 = lane & 31, hi = lane >> 5;
    LAS char* V_lds = lds + V_OFF; LAS char* K_lds = lds + K_OFF;
    LAS float* tab = (LAS float*)(lds + TAB_OFF); LAS float* csl = (LAS float*)(lds + CSL_OFF);
    const int Lm = u.Lm, Ls = u.Ls, dil = u.dil;
#define TOKV(v) ((((v) & Lm) * dil) + ((v) >> Ls))
    const int vw = u.v0 + wid * 32, vq = vw + r32, qm = vq - 4 * hi;
    bf16x8 qr[8 * NKH];
    { const bf16_t* qp = u.Q + (size_t)TOKV(vq) * u.ldq + hi * 8;
#pragma unroll
      for (int d0 = 0; d0 < 8 * NKH; ++d0) qr[d0] = *(const bf16x8*)(qp + d0 * 16); }
    if (MODE == 0) {
        const int delta = tid - 160; float val = -__builtin_inff();
        if (delta >= 0 && delta <= 128) { const int dist = delta * dil; int bk = dist;
            if (dist >= 16) { bk = 16 + (int)(log2f((float)dist * 0.0625f) * (16.0f / 7.0f)); bk = bk > 31 ? 31 : bk; }
            val = u.relb[bk * 12] * LOG2E; }
        tab[tid] = val;
    }
    float m_reg = -1e30f, l_reg = 0.f; f32x16 o[4] = {};
    const int l4 = lane >> 4, kr0 = 8 * wid + l4, kc0 = ((lane & 15) ^ l4) * 8, kc1 = ((lane & 15) ^ (4 + l4)) * 8;
    const int vrow = swap23(8 * wid + ((lane & 31) >> 2)), vc0 = (lane >> 5) * 32 + (lane & 3) * 8;
    const int vb0 = (int)(uintptr_t)V_lds + v_rd_base(lane);
    float st_c = 0.f;
#define SLOAD(kbv, kbf, vbf) do { int a0_ = (kbv) + kr0, a1_ = a0_ + 4, av_ = (kbv) + vrow; a0_ = a0_ < 0 ? 0 : a0_; a1_ = a1_ < 0 ? 0 : a1_; av_ = av_ < 0 ? 0 : av_; \
        const bf16_t* k0_ = u.K + (size_t)TOKV(a0_) * u.ldk + kc0; const bf16_t* k1_ = u.K + (size_t)TOKV(a1_) * u.ldk + kc1; const bf16_t* v0_ = u.V + (size_t)TOKV(av_) * u.ldk + vc0; \
        LAS char* kd_ = K_lds + (kbf) * (NKH * SHM_K) + wid * 2048; LAS char* vd_ = V_lds + (vbf) * SHM_V + wid * 2048; \
        GLDS(k0_, kd_); GLDS(k1_, kd_ + 1024); if (NKH == 2) { GLDS(k0_ + 128, kd_ + SHM_K); GLDS(k1_ + 128, kd_ + SHM_K + 1024); } \
        GLDS(v0_, vd_); GLDS(v0_ + 64, vd_ + 1024); \
        if (MODE == 1) { if (tid < 64) st_c = u.cs[(kbv) + tid]; } } while (0)
#define SWRITE(kbf) do { if (MODE == 1) { if (tid < 64) csl[(kbf) * 64 + tid] = -st_c; } } while (0)
#define RESC(a) do { if (__any((a) < 1.f)) { _Pragma("unroll") for (int d_ = 0; d_ < 4; ++d_) _Pragma("unroll") for (int r = 0; r < 16; ++r) o[d_][r] *= (a); } } while (0)
    const bool need_lim = MODE == 0 && (vw & Lm) < 128; const int lim = vq & Lm;
    f32x16 p0, p1; bf16x8 pa0, pa1, pa2, pa3; float alpha;
    bf16x8 q0, q1, q2, q3;
    SLOAD(u.kb0, 0, 0); VM_WAIT(); SWRITE(0);
#pragma unroll
    for (int d0 = 0; d0 < 8 * NKH; ++d0) asm volatile("" :: "v"(qr[d0]));
    __syncthreads();
    bool act_prev = false; int vcur = 0, vprev = 0;
    for (int t = 0; t < u.NT; ++t) {
        int kbo_ = u.kb0 + 64 * t; asm volatile("" : "+s"(kbo_)); const int kb_ = kbo_;
        const int kbf = t & 1, vnext = vcur == 2 ? 0 : vcur + 1; const bool HN = t + 1 < u.NT;
        if (HN) SLOAD(kb_ + 64, kbf ^ 1, vnext);
        bool act_ = true;
        if (MODE == 0) act_ = (kb_ <= vw + 31) && (kb_ + 63 >= vw - 128);
        if (MODE == 1) act_ = (kb_ <= vw + 31);
        if (act_) {
            SBAR();
            if (MODE == 1) { const LAS f32x4* cp_ = (const LAS f32x4*)(csl + kbf * 64 + 4 * hi);
#pragma unroll
                for (int g_ = 0; g_ < 4; ++g_) { const f32x4 c0_ = cp_[2 * g_], c1_ = cp_[2 * g_ + 8];
#pragma unroll
                    for (int i_ = 0; i_ < 4; ++i_) { p0[4 * g_ + i_] = c0_[i_]; p1[4 * g_ + i_] = c1_[i_]; } }
                qkt<true>(p0, p1, K_lds + kbf * (NKH * SHM_K), r32, hi, qr); }
            else qkt<false>(p0, p1, K_lds + kbf * (NKH * SHM_K), r32, hi, qr);
            if (NKH == 2) qkt<true>(p0, p1, K_lds + kbf * (NKH * SHM_K) + SHM_K, r32, hi, qr + 8);
            const int dq_ = qm - kb_;
            if (MODE == 0) { const LAS float* tb_ = tab + (dq_ + 101);
#pragma unroll
                for (int r = 0; r < 16; ++r) { const int c_ = (r & 3) + 8 * (r >> 2); p0[r] += tb_[59 - c_]; p1[r] += tb_[27 - c_]; }
                if (need_lim) {
#pragma unroll
                    for (int r = 0; r < 16; ++r) { const int c_ = (r & 3) + 8 * (r >> 2);
                        if (dq_ - c_ > lim) p0[r] = -__builtin_inff(); if (dq_ - c_ - 32 > lim) p1[r] = -__builtin_inff(); } } }
            if (MODE == 1) {
                if (kb_ + 63 > vw) {
#pragma unroll
                    for (int r = 0; r < 16; ++r) { const int c_ = (r & 3) + 8 * (r >> 2);
                        if (dq_ - c_ < 0) p0[r] = -__builtin_inff(); if (dq_ - c_ - 32 < 0) p1[r] = -__builtin_inff(); } } }
            SBAR();
            if (act_prev) pv_softmax(o, vb0 + vprev * SHM_V, q0, q1, q2, q3, p0, p1, m_reg, l_reg, alpha, pa0, pa1, pa2, pa3);
            else softmax_tile(p0, p1, m_reg, l_reg, alpha, pa0, pa1, pa2, pa3);
            SBAR(); RESC(alpha); SBAR();
            q0 = pa0; q1 = pa1; q2 = pa2; q3 = pa3;
        } else if (act_prev) { SBAR(); pv_tile(o, vb0 + vprev * SHM_V, q0, q1, q2, q3); SBAR(); }
        if (HN) { VM_WAIT(); SWRITE(kbf ^ 1); }
        __syncthreads();
        act_prev = act_; vprev = vcur; vcur = vnext;
    }
    if (act_prev) { SBAR(); pv_tile(o, vb0 + vprev * SHM_V, q0, q1, q2, q3); }
    if (MODE == 0) { if (hi == 0) u.lse[(size_t)TOKV(vq) * 12] = m_reg + log2f(l_reg); }
    store_o_rows(u.O + (size_t)TOKV(vq) * u.ldo + 8 * hi, o, __builtin_amdgcn_rcpf(l_reg));
    __syncthreads();
#undef TOKV
#undef SLOAD
#undef SWRITE
#undef RESC
}
constexpr int A2_GRP = 65536, A2_WS = 132096, A2_TAB = 134144;
template <class Gen>
__device__ __forceinline__ void attn_a2_stream(LAS char* lds, const int NU, const Gen& gen, const float* relb_g, const int wave0_) {
    const int tid = opaque_tid(), wid = __builtin_amdgcn_readfirstlane(tid >> 6), lane = tid & 63, r32 = lane & 31, hi = lane >> 5;
    const int grp = wid >> 2;
    LAS char* V_lds = lds + grp * A2_GRP; LAS char* K_lds = V_lds + 32768;
    const int wg = wid & 3, l4 = lane >> 4, kr0 = 16 * wg + l4, kc0 = ((lane & 15) ^ l4) * 8, kc1 = ((lane & 15) ^ (4 + l4)) * 8;
    const int vr0 = swap23(16 * wg + ((lane & 31) >> 2)), vr1 = swap23(16 * wg + 8 + ((lane & 31) >> 2)), vc0 = (lane >> 5) * 32 + (lane & 3) * 8;
    const int vb0 = (int)(uintptr_t)V_lds + v_rd_base(lane);
#define TOKU(U, v) ((((v) & (U).Lm) * (U).dil) + ((v) >> (U).Ls))
#define SLOADU(U, kbv, bf) do { LAS char* kd_ = K_lds + (bf) * SHM_K + wg * 4096; LAS char* vd_ = V_lds + (bf) * SHM_V + wg * 4096; \
        _Pragma("unroll") for (int i_ = 0; i_ < 4; ++i_) { int a_ = (kbv) + kr0 + 4 * i_; a_ = a_ < 0 ? 0 : a_; GLDS((U).K + (size_t)TOKU(U, a_) * (U).ldk + ((i_ & 1) ? kc1 : kc0), kd_ + i_ * 1024); } \
        _Pragma("unroll") for (int h_ = 0; h_ < 2; ++h_) { int a_ = (kbv) + (h_ ? vr1 : vr0); a_ = a_ < 0 ? 0 : a_; const bf16_t* p_ = (U).V + (size_t)TOKU(U, a_) * (U).ldk + vc0; \
            GLDS(p_, vd_ + h_ * 2048); GLDS(p_ + 64, vd_ + h_ * 2048 + 1024); } } while (0)
#define LOADQU(U) do { const bf16_t* qp_ = (U).Q + (size_t)TOKU(U, (U).v0 + wid * 32 + r32) * (U).ldq + hi * 8; \
        _Pragma("unroll") for (int d0 = 0; d0 < 8; ++d0) qr[d0] = *(const bf16x8*)(qp_ + d0 * 16); } while (0)
#define TABU(U, tb) do { const int delta = tid - 160; float val = -__builtin_inff();          \
        if (delta >= 0 && delta <= 128) { const int dist = delta * (U).dil; int bk = dist; \
            if (dist >= 16) { bk = 16 + (int)(log2f((float)dist * 0.0625f) * (16.0f / 7.0f)); bk = bk > 31 ? 31 : bk; } \
            val = relb_l[bk * 12 + (U).hh] * LOG2E; } \
        ((LAS float*)(lds + A2_TAB))[(tb) * 512 + tid] = val; } while (0)
#define RESC(a) do { if (__any((a) < 1.f)) { _Pragma("unroll") for (int d_ = 0; d_ < 4; ++d_) _Pragma("unroll") for (int r = 0; r < 16; ++r) o[d_][r] *= (a); } } while (0)
    AU u; gen(0, u);
    LAS float* relb_l = (LAS float*)(lds + A2_TAB) + 1024;
    if (tid < 384) relb_l[tid] = relb_g[tid];
    __syncthreads();
    bf16x8 qr[8];
    LOADQU(u); TABU(u, 0); SLOADU(u, u.kb0 + 128 * grp + ((grp != 0 && u.NT == 4) ? 128 : 0), 0);
    for (int iu = 0; iu < NU; ++iu) {
        const bool hasn = iu + 1 < NU; AU un = u; if (hasn) gen(iu + 1, un);
        const LAS float* tab = (const LAS float*)(lds + A2_TAB) + (iu & 1) * 512;
        const int Lm = u.Lm;
        const int vw = u.v0 + wid * 32, vq = vw + r32, qm = vq - 4 * hi;
        const int cstart = vw - (vw & Lm);
        const bool need_lim = (vw & Lm) < 128; const int lim = vq & Lm;
        const int kbg = u.kb0 + 128 * grp;
        const int ntm = u.NT - 1, rot = (grp != 0 && u.NT == 4) ? 2 : 0;
        float m_reg = -1e30f, l_reg = 0.f; f32x16 o[4] = {};
        f32x16 p0, p1; bf16x8 pa0, pa1, pa2, pa3; float alpha;
        VM_WAIT();
#pragma unroll
        for (int d0 = 0; d0 < 8; ++d0) asm volatile("" :: "v"(qr[d0]));
        __syncthreads();
#define TILE2(t, BF, LAST) do { int kbo_ = kbg + 64 * (((t) + rot) & ntm); asm volatile("" : "+s"(kbo_)); const int kb_ = kbo_; \
        const bool shr_ = rot != 0 && (t) >= 2;                       \
        const LAS char* kimg_ = (shr_ ? lds + 32768 : K_lds) + (BF) * SHM_K; const int vimg_ = (shr_ ? vb0 - A2_GRP : vb0) + (BF) * SHM_V; \
        if (!(LAST)) { if (!(rot != 0 && (t) + 1 >= 2)) SLOADU(u, kbg + 64 * (((t) + 1 + rot) & ntm), (BF) ^ 1); } \
        else if (hasn) SLOADU(un, un.kb0 + 128 * grp + ((grp != 0 && un.NT == 4) ? 128 : 0), 0); \
        const bool act_ = (kb_ <= vw + 31) && (kb_ + 63 >= vw - 128) && (kb_ + 63 >= cstart); \
        if (act_) { \
            const int dq_ = qm - kb_; SBAR(); \
            { const LAS float* tb_ = tab + (dq_ + 101);                \
              _Pragma("unroll") for (int r = 0; r < 16; ++r) { const int c_ = (r & 3) + 8 * (r >> 2); p0[r] = tb_[59 - c_]; p1[r] = tb_[27 - c_]; } \
              qkt<true>(p0, p1, kimg_, r32, hi, qr); \
              if (need_lim) { _Pragma("unroll") for (int r = 0; r < 16; ++r) { const int c_ = (r & 3) + 8 * (r >> 2); \
                  if (dq_ - c_ > lim) p0[r] = -__builtin_inff(); if (dq_ - c_ - 32 > lim) p1[r] = -__builtin_inff(); } } } } \
        if ((LAST) && hasn) { SBAR(); LOADQU(un); TABU(un, (iu + 1) & 1); SBAR(); } \
        if (act_) { \
            SBAR(); softmax_tile(p0, p1, m_reg, l_reg, alpha, pa0, pa1, pa2, pa3); \
            RESC(alpha); SBAR(); \
            pv_tile(o, vimg_, pa0, pa1, pa2, pa3); } \
        if (!(LAST)) { VM_WAIT(); __syncthreads(); } } while (0)
        int t = 0;
        for (; t + 2 < u.NT; t += 2) { TILE2(t, 0, false); TILE2(t + 1, 1, false); }
        TILE2(t, 0, false); TILE2(t + 1, 1, true);
#undef TILE2
        if (hi == 0) u.lse[(size_t)TOKU(u, vq) * 12] = m_reg + log2f(l_reg);
        {
          const float rl_ = __builtin_amdgcn_rcpf(l_reg); float am = 0.f;
#pragma unroll
          for (int d_ = 0; d_ < 4; ++d_)
#pragma unroll
            for (int r = 0; r < 16; ++r) am = fmaxf(am, fabsf(o[d_][r]));
          am *= rl_;
          { auto rr = __builtin_amdgcn_permlane32_swap(__float_as_uint(am), __float_as_uint(am), false, false); am = fmaxf(__uint_as_float(rr[0]), __uint_as_float(rr[1])); }
          const float k_ = am > 0.f ? rl_ * 127.f * __builtin_amdgcn_rcpf(am) : 0.f;
          if (hi == 0) u.sc[(size_t)TOKU(u, vq) * 12] = am * (1.f / 127.f);
          unsigned char* rowp = u.O8 + (size_t)TOKU(u, vq) * u.ldo + 16 * hi;
#define Q8(x) __builtin_fmaf((x), k_, 128.f)
#define PK4Q(d0, g) __builtin_amdgcn_cvt_pk_u8_f32(Q8(o[d0][4 * (g) + 3]), 3, __builtin_amdgcn_cvt_pk_u8_f32(Q8(o[d0][4 * (g) + 2]), 2, __builtin_amdgcn_cvt_pk_u8_f32(Q8(o[d0][4 * (g) + 1]), 1, __builtin_amdgcn_cvt_pk_u8_f32(Q8(o[d0][4 * (g)]), 0, 0u))))
#pragma unroll
          for (int d0 = 0; d0 < 4; ++d0) { const unsigned W0 = PK4Q(d0, 0), W1 = PK4Q(d0, 1), W2 = PK4Q(d0, 2), W3 = PK4Q(d0, 3);
              auto r0 = __builtin_amdgcn_permlane32_swap(W0, W2, false, false); auto r1 = __builtin_amdgcn_permlane32_swap(W1, W3, false, false);
              const u32x4 w = {r0[0], r0[1], r1[0], r1[1]};
              *(u32x4*)(rowp + 32 * d0) = w; }
#undef PK4Q
#undef Q8
        }
        u = un;
    }
    __syncthreads();
#undef TOKU
#undef SLOADU
#undef LOADQU
#undef TABU
#undef RESC
}
}

__device__ __forceinline__ unsigned f2bf(float f) { unsigned u = __builtin_bit_cast(unsigned, f); return (u + 0x7fffu + ((u >> 16) & 1u)) >> 16; }
__device__ __forceinline__ unsigned pk2(float lo, float hi) { return f2bf(lo) | (f2bf(hi) << 16); }
__device__ __forceinline__ float wave_sum(float v) {
    v += dpp_f<0xB1>(v); v += dpp_f<0x4E>(v);
    v += dpp_f<0x141>(v); v += dpp_f<0x140>(v);
    v = xor16_add(v); v = xor32_add(v);
    return v;
}
struct TrItem { const float* wp; size_t rs; bf16_t* dp; int ldt; };
__device__ __forceinline__ void tr_load(const TrItem& t, f32x4 (&v)[8]) {
#pragma unroll
    for (int i = 0; i < 8; ++i) v[i] = *(const f32x4*)(t.wp + (size_t)(8 * i) * t.rs);
}
__device__ __forceinline__ void tr_store(const TrItem& t, const f32x4 (&v)[8], LAS float* scr, int lane) {
    const int r = lane >> 3, c4 = lane & 7;
#pragma unroll
    for (int i = 0; i < 8; ++i) { LAS float* d = scr + (8 * i + r) * 33 + 4 * c4; d[0] = v[i][0]; d[1] = v[i][1]; d[2] = v[i][2]; d[3] = v[i][3]; }
    LDS_WAIT(); asm volatile("" ::: "memory");
    const int c = lane & 7;
#pragma unroll
    for (int j = 0; j < 4; ++j) { const int n = (lane >> 3) + 8 * j; const LAS float* s = scr + (8 * c) * 33 + n;
        u32x4 o; o.x = pk2(s[0 * 33], s[1 * 33]); o.y = pk2(s[2 * 33], s[3 * 33]); o.z = pk2(s[4 * 33], s[5 * 33]); o.w = pk2(s[6 * 33], s[7 * 33]);
        *(u32x4*)(t.dp + (size_t)(8 * j) * t.ldt) = o; }
    LDS_WAIT(); asm volatile("" ::: "memory");
}
struct Args { const float* in[19]; float* out; unsigned char* ws; int ph_lo, ph_hi; };
typedef __attribute__((address_space(4))) const Args* KArgP;
__device__ __forceinline__ KArgP fresh_args() { KArgP p = (KArgP)__builtin_amdgcn_kernarg_segment_ptr(); asm volatile("" : "+s"(p)); return p; }

__device__ __forceinline__ TrItem tr_decode(KArgP args, unsigned char* ws, int lane, int it) {
    const float* w_in = args->in[4];
    int r = it; const float* src; int ldw, ldt, nkb; bf16_t* dst;
    if (r < 4608) { src = w_in + 0; ldw = INC; dst = (bf16_t*)(ws + WS_WT1); ldt = DM; nkb = 32; }
    else if ((r -= 4608) < 1536) { src = w_in + 4608; ldw = INC; dst = (bf16_t*)(ws + WS_WT2); ldt = DM; nkb = 32; }
    else if ((r -= 1536) < 3072) { src = w_in + 6144; ldw = INC; dst = (bf16_t*)(ws + WS_WT1) + (size_t)4608 * DM; ldt = DM; nkb = 32; }
    else if ((r -= 3072) < 1024) { src = w_in + 9216; ldw = INC; dst = (bf16_t*)(ws + WS_WT2) + (size_t)1536 * DM; ldt = DM; nkb = 32; }
    else if ((r -= 1024) < 1024) { src = w_in + 10248; ldw = INC; dst = (bf16_t*)(ws + WS_WT1) + (size_t)7680 * DM; ldt = DM; nkb = 32; }
    else if ((r -= 1024) < 1024) { src = w_in + 11272; ldw = INC; dst = (bf16_t*)(ws + WS_WT2) + (size_t)2560 * DM; ldt = DM; nkb = 32; }
    else if ((r -= 1024) < 6144) { src = w_in + 12296; ldw = INC; dst = (bf16_t*)(ws + WS_WT2) + (size_t)3584 * DM; ldt = DM; nkb = 32; }
    else if ((r -= 6144) < 2048) { src = args->in[14]; ldw = 2048; dst = (bf16_t*)(ws + WS_WTKV); ldt = DM; nkb = 32; }
    else if ((r -= 2048) < 1536) { src = args->in[15]; ldw = DM; dst = (bf16_t*)(ws + WS_WTP); ldt = KP; nkb = 24; }
    else if ((r -= 1536) < 1024) { src = args->in[16]; ldw = DM; dst = (bf16_t*)(ws + WS_WTP) + 1536; ldt = KP; nkb = 16; }
    else if ((r -= 1024) < 1024) { src = args->in[17]; ldw = DM; dst = (bf16_t*)(ws + WS_WTP) + 2560; ldt = KP; nkb = 16; }
    else { r -= 1024; src = args->in[18]; ldw = DM; dst = (bf16_t*)(ws + WS_WTO); ldt = DM; nkb = 32; }
    const int nb = r / nkb, kb = r - nb * nkb, k0 = 64 * kb, n0 = 32 * nb;
    TrItem t; t.wp = src + (size_t)(k0 + (lane >> 3)) * ldw + n0 + 4 * (lane & 7); t.rs = (size_t)ldw;
    t.dp = dst + (size_t)(n0 + (lane >> 3)) * ldt + k0 + 8 * (lane & 7); t.ldt = ldt; return t;
}
#define TR_LD(V, T, idx) do { if ((idx) < tot_) { T = tr_decode(args, ws, lane, MAP_((idx))); tr_load(T, V); } } while (0)
#define TR_STREAM(first, total, stride, MAPF) do { const int tot_ = (total), st_ = (stride); int j_ = (first); \
        f32x4 va_[8], vb_[8], vc_[8], vd_[8]; TrItem ta_, tb_, tc_, td_; ta_.wp = nullptr; tb_ = ta_; tc_ = ta_; td_ = ta_; \
        auto MAP_ = [](int q_) { return MAPF(q_); }; \
        TR_LD(va_, ta_, j_); TR_LD(vb_, tb_, j_ + st_); TR_LD(vc_, tc_, j_ + 2 * st_); \
        while (j_ < tot_) { \
            TR_LD(vd_, td_, j_ + 3 * st_); tr_store(ta_, va_, scr, lane); j_ += st_; if (j_ >= tot_) break; \
            TR_LD(va_, ta_, j_ + 3 * st_); tr_store(tb_, vb_, scr, lane); j_ += st_; if (j_ >= tot_) break; \
            TR_LD(vb_, tb_, j_ + 3 * st_); tr_store(tc_, vc_, scr, lane); j_ += st_; if (j_ >= tot_) break; \
            TR_LD(vc_, tc_, j_ + 3 * st_); tr_store(td_, vd_, scr, lane); j_ += st_; } } while (0)
__device__ __forceinline__ int map_p0(int r) { if (r < 4608) return r; if ((r -= 4608) < 3072) return 6144 + r; if ((r -= 3072) < 1024) return 10240 + r; return 18432 + (r - 1024); }
__device__ __forceinline__ int map_p1(int r) { if (r < 1536) return 4608 + r; if ((r -= 1536) < 1024) return 9216 + r; if ((r -= 1024) < 1024) return 11264 + r; return 12288 + (r - 1024); }
__device__ __forceinline__ int map_p3(int r) { return 20480 + r; }
constexpr int P1_SIDE = 5632;
__device__ __forceinline__ int map_p1b(int r) { return map_p1(P1_SIDE + r); }
__global__ void __launch_bounds__(512, 2) fwd_kernel(Args args_) {
    extern __shared__ __attribute__((aligned(16))) unsigned char lds_raw[];
    LAS unsigned char* lds = (LAS unsigned char*)lds_raw;
    volatile LAS unsigned* MISC = (volatile LAS unsigned*)(lds + MISC_OFF);
    const int wave0_ = __builtin_amdgcn_readfirstlane((int)threadIdx.x >> 6);
    const int G = gridDim.x; const int bx = blockIdx.x; const int vcu = (G % 8 == 0) ? (bx % 8) * (G / 8) + bx / 8 : bx;
    gu32* ctl = (gu32*)(fresh_args()->ws + WS_CTL);
    for (int i = threadIdx.x; i < (LDS_BYTES - LDSCTL_OFF) / 4; i += 512) ((LAS unsigned*)(lds + LDSCTL_OFF))[i] = 0u;
    __syncthreads();
    XcdBarrier bar; bar.bar = (unsigned*)(ctl + 4096); bar.x = 0; bar.st = nullptr;
    const int lo = fresh_args()->ph_lo, hi_ = fresh_args()->ph_hi;
    const bool one_launch = (hi_ - lo) > 1;
    if (one_launch) bar = xcd_barrier_post((unsigned*)(ctl + 4096), MISC + 8, wave0_);
#ifndef ATT_DUP
#define ATT_DUP 0
#endif
#ifndef ATT_MASK
#define ATT_MASK 7
#endif
#ifndef PH_MASK
#define PH_MASK 63
#endif
#define IN(k) (((PH_MASK >> (k)) & 1) && lo <= (k) && (k) < hi_)
#define BOTH(k) (IN(k) && IN((k) + 1))
#define GRID_BAR() xcd_barrier(bar, wave0_)

    if (IN(0)) {
        const KArgP args = fresh_args(); unsigned char* ws = args->ws; const float* x = args->in[0];
        const int tid = opaque_tid(), lane = tid & 63, wave = __builtin_amdgcn_readfirstlane(tid >> 6);
        LAS float* scr = (LAS float*)(lds + wave * 16384);
        const int gw = vcu * 8 + wave, NGW = G * 8;
        const float* w_in = args->in[4];
        TR_STREAM(gw, 10752, NGW, map_p0);
        __syncthreads();
        LAS float* wfT = (LAS float*)lds;
        { f32x4 wa[4], wb[4];
#pragma unroll
          for (int j = 0; j < 4; ++j) { const float* p = w_in + (size_t)(tid + 512 * j) * INC + 10240; wa[j] = *(const f32x4*)p; wb[j] = *(const f32x4*)(p + 4); }
#pragma unroll
          for (int j = 0; j < 4; ++j) { const int k = tid + 512 * j;
#pragma unroll
              for (int e = 0; e < 4; ++e) { wfT[e * DM + k] = wa[j][e]; wfT[(4 + e) * DM + k] = wb[j][e]; } } }
        __syncthreads();
        const float* ng = args->in[2]; const float* bfg = args->in[5];
        { const int lane_h = opaque_tid() & 63;
#define lane lane_h
        bf16_t* H = (bf16_t*)(ws + WS_H); float* F = (float*)(ws + WS_F);
#pragma unroll 1
        for (int m = gw; m < TOK; m += NGW) {
            const f32x4* xr = (const f32x4*)(x + (size_t)m * DM) + lane;
            f32x4 v[8]; float s = 0.f;
#pragma unroll
            for (int j = 0; j < 8; ++j) { v[j] = xr[64 * j]; s += (v[j][0] * v[j][0] + v[j][1] * v[j][1]) + (v[j][2] * v[j][2] + v[j][3] * v[j][3]); }
            const float rstd = 1.0f / sqrtf(wave_sum(s) * (1.f / DM) + EPS);
            u32x2* o8 = (u32x2*)(H + (size_t)m * DM) + lane;
#pragma unroll
            for (int j = 0; j < 8; ++j) { const f32x4 gj = *((const f32x4*)ng + lane + 64 * j); v[j] = (v[j] * rstd) * gj;
                u32x2 w; w.x = pk2(v[j][0], v[j][1]); w.y = pk2(v[j][2], v[j][3]); o8[64 * j] = w; }
            float fb[8];
#pragma unroll
            for (int hh = 0; hh < 8; ++hh) fb[hh] = 0.f;
#pragma unroll
            for (int j = 0; j < 8; ++j) {
#pragma unroll
                for (int hh = 0; hh < 8; ++hh) { const f32x4 w4 = *((const LAS f32x4*)(wfT + hh * DM) + lane + 64 * j); fb[hh] += (v[j][0] * w4[0] + v[j][1] * w4[1]) + (v[j][2] * w4[2] + v[j][3] * w4[3]); }
                asm volatile("" ::: "memory"); }
#pragma unroll
            for (int hh = 0; hh < 8; ++hh) { fb[hh] = wave_sum(fb[hh]); __builtin_amdgcn_sched_barrier(0); }
            if (lane < 8) { float f = fb[0];
#pragma unroll
                for (int hh = 1; hh < 8; ++hh) f = lane == hh ? fb[hh] : f;
                const float xx = f + bfg[lane]; F[(size_t)m * 8 + lane] = fminf(xx, 0.f) - log1pf(expf(-fabsf(xx))); }
        }
#undef lane
        }
        const float* mem = args->in[1]; const float* mg = args->in[3]; bf16_t* MH = (bf16_t*)(ws + WS_MH);
        { const int lane_m = opaque_tid() & 63;
#define lane lane_m
#pragma unroll 1
        for (int m = gw; m < NB * MEML; m += NGW) {
            const f32x4* xr = (const f32x4*)(mem + (size_t)m * DM) + lane;
            f32x4 v[8]; float s = 0.f;
#pragma unroll
            for (int j = 0; j < 8; ++j) { v[j] = xr[64 * j]; s += (v[j][0] * v[j][0] + v[j][1] * v[j][1]) + (v[j][2] * v[j][2] + v[j][3] * v[j][3]); }
            const float rstd = 1.0f / sqrtf(wave_sum(s) * (1.f / DM) + EPS);
            u32x2* o8 = (u32x2*)(MH + (size_t)m * DM) + lane;
#pragma unroll
            for (int j = 0; j < 8; ++j) { const f32x4 gj = *((const f32x4*)mg + lane + 64 * j); v[j] = (v[j] * rstd) * gj;
                u32x2 w; w.x = pk2(v[j][0], v[j][1]); w.y = pk2(v[j][2], v[j][3]); o8[64 * j] = w; }
        }
#undef lane
        }
        if (BOTH(0)) xcd_barrier_arrive(bar, wave0_); else __syncthreads();
        { const KArgP args = fresh_args(); unsigned char* ws = args->ws;
          const int tid = opaque_tid(), lane = tid & 63, wave = __builtin_amdgcn_readfirstlane(tid >> 6);
          LAS float* scr = (LAS float*)(lds + wave * 16384);
          TR_STREAM(vcu * 8 + wave, 9728 - P1_SIDE, G * 8, map_p1b); }
        if (BOTH(0)) xcd_barrier_wait(bar, wave0_); else __syncthreads();
    }

    if (IN(1)) {
        const KArgP args = fresh_args(); unsigned char* ws = args->ws;
        if (bx >= 192 && bx < 256) {                 const int tid = opaque_tid(), lane = tid & 63, wave = __builtin_amdgcn_readfirstlane(tid >> 6);
            const int j = bx - 192, b = j >> 3, hh = j & 7;
            const float* F = (const float*)(ws + WS_F) + ((size_t)b * SEQ) * 8 + hh; float* CS = (float*)(ws + WS_CS) + (size_t)j * SEQ;
            LAS float* wt = (LAS float*)lds;
            float a0 = F[(size_t)(4 * tid + 0) * 8], a1 = F[(size_t)(4 * tid + 1) * 8], a2 = F[(size_t)(4 * tid + 2) * 8], a3 = F[(size_t)(4 * tid + 3) * 8];
            a1 += a0; a2 += a1; a3 += a2;
            float sc = a3;
#pragma unroll
            for (int o = 1; o < 64; o <<= 1) { const float t = __shfl_up(sc, o); if (lane >= o) sc += t; }
            if (lane == 63) wt[wave] = sc;
            __syncthreads();
            float base = 0.f;
            for (int w = 0; w < wave; ++w) base += wt[w];
            const float ex = base + sc - a3;
            CS[4 * tid + 0] = (ex + a0) * LOG2E; CS[4 * tid + 1] = (ex + a1) * LOG2E; CS[4 * tid + 2] = (ex + a2) * LOG2E; CS[4 * tid + 3] = (ex + a3) * LOG2E;
            __syncthreads();
            { LAS float* scr = (LAS float*)(lds + wave * 16384);
              TR_STREAM((bx - 192) * 8 + wave, P1_SIDE, 512, map_p1); }
            __syncthreads();
        }
        EpiQKV E; E.ws = ws; E.gains[0] = args->in[8]; E.gains[1] = args->in[9]; E.gains[2] = args->in[10]; E.gains[3] = args->in[11]; E.gains[4] = args->in[12]; E.gains[5] = args->in[13]; E.lds = lds;
        { E.which = 0; pg8::Gemm g{(const bf16_t*)(ws + WS_H), (const bf16_t*)(ws + WS_WT1), DM, DM}; pg8::StaticOrder S; S.init(TOK, N1, DM, G, bx);
          pg8::gemm_phase<EpiQKV, pg8::StaticOrder>(lds, g, S, E, wave0_); }
        { E.which = 1; pg8::Gemm g{(const bf16_t*)(ws + WS_MH), (const bf16_t*)(ws + WS_WTKV), DM, DM}; pg8::StaticOrder S; S.init(NB * MEML, 2048, DM, G, (bx + 128) % G);
          pg8::gemm_phase<EpiQKV, pg8::StaticOrder>(lds, g, S, E, wave0_); }
        if (BOTH(1)) GRID_BAR();
    }

    if (IN(2)) {
        const KArgP args = fresh_args(); unsigned char* ws = args->ws;
        LAS char* al = (LAS char*)lds;
        const float* CS = (const float*)(ws + WS_CS);
        for (int v = vcu; v < 256; v += G) {
            { const int bh = v >> 2, s = v & 3, b = bh >> 3, h = bh & 7;
              for (int pass = 0; pass < 2; ++pass) { const int qb = pass ? 7 - s : s;
                  att::AU u; u.Q = (const bf16_t*)(ws + WS_QB) + (size_t)b * SEQ * BW + h * 128; u.ldq = BW;
                  u.K = (const bf16_t*)(ws + WS_KB) + (size_t)b * SEQ * BW + h * 128; u.V = (const bf16_t*)(ws + WS_VB) + (size_t)b * SEQ * BW + h * 128; u.ldk = BW;
                  u.O = (bf16_t*)(ws + WS_Y) + (size_t)b * SEQ * KP + AW + h * 128; u.ldo = KP; u.lse = nullptr; u.cs = CS + (size_t)(b * 8 + h) * SEQ; u.relb = nullptr;
                  u.v0 = qb * 256; u.Lm = 0x3fffffff; u.Ls = 30; u.dil = 1; u.kb0 = 0; u.NT = 4 * (qb + 1);
                  if (ATT_MASK & 1) att::attn_unit<1>(al, u, wave0_);
                  if (ATT_DUP & 1) att::attn_unit<1>(al, u, wave0_); } }
            { const int b = v >> 5, h = (v >> 3) & 3, qb = v & 7;
              for (int e = 0; e < 2; ++e) {
                  att::AU u; u.Q = (const bf16_t*)(ws + WS_QM) + (size_t)b * SEQ * MW + h * 256; u.ldq = MW;
                  u.K = (const bf16_t*)(ws + WS_KM) + (size_t)b * MEML * MW + h * 256; u.V = (const bf16_t*)(ws + WS_VM) + (size_t)b * MEML * MW + h * 256 + e * 128; u.ldk = MW;
                  u.O = (bf16_t*)(ws + WS_Y) + (size_t)b * SEQ * KP + AW + BW + h * 256 + e * 128; u.ldo = KP; u.lse = nullptr; u.cs = nullptr; u.relb = nullptr;
                  u.v0 = qb * 256; u.Lm = 0x3fffffff; u.Ls = 30; u.dil = 1; u.kb0 = 0; u.NT = 4;
                  if (ATT_MASK & 2) att::attn_unit<2>(al, u, wave0_);
                  if (ATT_DUP & 2) att::attn_unit<2>(al, u, wave0_); } }
            { float* const outp = args->out; const float* const relbp = args->in[7];
              auto genA = [=](int i, att::AU& u) {
                const int b = v >> 5, w_ = 32 * i + (v & 31), h = w_ / 24, rem_ = w_ - 24 * h, pat = rem_ >> 3, vb = rem_ & 7;
                u.Q = (const bf16_t*)(ws + WS_QA) + (size_t)b * SEQ * AW + h * 128; u.ldq = AW;
                u.K = (const bf16_t*)(ws + WS_KA) + (size_t)b * SEQ * AW + h * 128; u.V = (const bf16_t*)(ws + WS_VA) + (size_t)b * SEQ * AW + h * 128; u.ldk = AW;
                bf16_t* ob = pat == 0 ? (bf16_t*)outp : (pat == 1 ? (bf16_t*)outp + (size_t)TOK * AW : (bf16_t*)(ws + WS_OA2));
                u.O = ob + (size_t)b * SEQ * AW + h * 128; u.ldo = AW;
                u.lse = (float*)(ws + WS_LSE) + ((size_t)pat * TOK + (size_t)b * SEQ) * 12 + h; u.cs = nullptr; u.relb = relbp + h; u.hh = h;
                u.O8 = (unsigned char*)ob + (size_t)b * SEQ * AW + h * 128; u.sc = (float*)(ws + WS_OA2 + 32 * MiB) + ((size_t)pat * TOK + (size_t)b * SEQ) * 12 + h;
                u.v0 = vb * 256; u.Ls = pat == 0 ? 11 : (pat == 1 ? 9 : 7); u.Lm = (1 << u.Ls) - 1; u.dil = pat == 0 ? 1 : (pat == 1 ? 4 : 16);
                if (pat == 2) { u.kb0 = u.v0; u.NT = 2; } else { u.kb0 = u.v0 - 128; u.NT = 4; }
              };
              if (ATT_MASK & 4) att::attn_a2_stream(al, 9, genA, relbp, wave0_);
              if (ATT_DUP & 4) att::attn_a2_stream(al, 9, genA, relbp, wave0_); }
        }
        if (BOTH(2)) xcd_barrier_arrive(bar, wave0_);
    }

    if (IN(3)) {
        const KArgP args = fresh_args(); unsigned char* ws = args->ws;
        if (bx >= 128 && bx < 256) {
            const int tid = opaque_tid(), lane = tid & 63, wave = __builtin_amdgcn_readfirstlane(tid >> 6);
            LAS float* scr = (LAS float*)(lds + wave * 16384);
            TR_STREAM((bx - 128) * 8 + wave, 5632, 1024, map_p3);
            __syncthreads();
        }
        EpiZG E; E.ws = ws; E.oa0 = (const bf16_t*)args->out; E.oa1 = (const bf16_t*)args->out + (size_t)TOK * AW; E.bgate = args->in[6]; E.wb = bar; E.lazy = BOTH(2);
        pg8::Gemm g{(const bf16_t*)(ws + WS_H), (const bf16_t*)(ws + WS_WT2), DM, DM}; pg8::StaticOrder S; S.init(TOK, N2, DM, G, bx, P3_ROT * (bx & 7));
        pg8::gemm_phase<EpiZG, pg8::StaticOrder>(lds, g, S, E, wave0_);
        if (BOTH(3)) GRID_BAR();
    }

    if (IN(4)) {
        const KArgP args = fresh_args(); unsigned char* ws = args->ws;
        EpiMerge E; E.ws = ws;
        pg8::Gemm g{(const bf16_t*)(ws + WS_Y), (const bf16_t*)(ws + WS_WTP), KP, KP}; pg8::Sub3Order S; S.init(TOK, DM, G, bx, bx & 7);
        pg8::gemm_phase<EpiMerge, pg8::Sub3Order>(lds, g, S, E, wave0_);
        if (BOTH(4)) xcd_barrier_arrive(bar, wave0_);
    }

    if (IN(5)) {
        const KArgP args = fresh_args(); unsigned char* ws = args->ws; const float* x = args->in[0];
        EpiOut E; E.x = x; E.out = args->out; E.wb = bar; E.lazy = BOTH(4);
        pg8::Gemm g{(const bf16_t*)(ws + WS_MRG), (const bf16_t*)(ws + WS_WTO), DM, DM}; pg8::StaticOrder S; S.init(TOK, DM, DM, G, bx);
        pg8::gemm_phase<EpiOut, pg8::StaticOrder>(lds, g, S, E, wave0_);
    }
#undef IN
#undef BOTH
#undef GRID_BAR
}

extern "C" void kernel_launch(void* const* d_in, const int* in_sizes, int n_in, void* d_out, int out_size, void* d_ws, size_t ws_size, hipStream_t stream) {
    static int grid = 0;
    if (grid == 0) {
        if (n_in != 19 || in_sizes[0] != TOK * DM || out_size != TOK * DM || ws_size < WS_END) {
            fprintf(stderr, "kernel_launch: shape/workspace mismatch (n_in %d, in0 %d, out %d, ws %zu, need %zu)\n", n_in, n_in > 0 ? in_sizes[0] : -1, out_size, ws_size, (size_t)WS_END); grid = -1; return; }
        int dev = 0, cus = 0;
        if (hipGetDevice(&dev) != hipSuccess || hipDeviceGetAttribute(&cus, hipDeviceAttributeMultiprocessorCount, dev) != hipSuccess) { grid = -1; return; }
        if (hipFuncSetAttribute((const void*)fwd_kernel, hipFuncAttributeMaxDynamicSharedMemorySize, LDS_BYTES) != hipSuccess) { fprintf(stderr, "kernel_launch: hipFuncSetAttribute failed\n"); grid = -1; return; }
        (void)hipGetLastError();
        grid = cus;
    }
    if (grid < 0) return;
    (void)hipMemsetAsync((char*)d_ws + WS_CTL, 0, CTL_ZERO_BYTES, stream);
    Args a{};
    for (int i = 0; i < 19; ++i) a.in[i] = (const float*)d_in[i];
    a.out = (float*)d_out; a.ws = (unsigned char*)d_ws;
#if MK_N_LAUNCHES == 1
    a.ph_lo = 0; a.ph_hi = 6;
    hipLaunchKernelGGL(fwd_kernel, dim3(grid), dim3(512), LDS_BYTES, stream, a);
#else
    for (int p = 0; p < 6; ++p) { a.ph_lo = p; a.ph_hi = p + 1; hipLaunchKernelGGL(fwd_kernel, dim3(grid), dim3(512), LDS_BYTES, stream, a);
#if defined(DUP_PHASE)
        if (p == DUP_PHASE) hipLaunchKernelGGL(fwd_kernel, dim3(grid), dim3(512), LDS_BYTES, stream, a);
#endif
    }
#endif
    const hipError_t le = hipPeekAtLastError();
    if (le != hipSuccess) fprintf(stderr, "kernel_launch: launch failed: %s\n", hipGetErrorName(le));
}
```

```cpp
#pragma clang diagnostic ignored "-Winline-asm"
#include <hip/hip_runtime.h>
#include <hip/hip_bf16.h>
#include <cstdio>
#include <cstdint>

#ifndef P3_ROT
#define P3_ROT 1
#endif
#ifndef DUP_EPI
#define DUP_EPI 0
#endif
#ifndef MK_N_LAUNCHES
#define MK_N_LAUNCHES 1
#endif

#define LAS __attribute__((address_space(3)))
#define GAS __attribute__((address_space(1)))
typedef unsigned short bf16_t;
typedef short bf16x8 __attribute__((ext_vector_type(8)));
typedef short s16x4 __attribute__((ext_vector_type(4)));
typedef float f32x4 __attribute__((ext_vector_type(4)));
typedef float f32x2 __attribute__((ext_vector_type(2)));
typedef float f32x16 __attribute__((ext_vector_type(16)));
typedef unsigned u32x4 __attribute__((ext_vector_type(4)));
typedef unsigned u32x2 __attribute__((ext_vector_type(2)));

constexpr int NB = 8, SEQ = 2048, DM = 2048, TOK = NB * SEQ;
constexpr int AW = 1536, BW = 1024, MW = 1024, MEML = 256, INC = 18440;
constexpr int N1 = 8704, N2 = 9728, KP = 3584;
constexpr float EPS = 1e-6f, LOG2E = 1.4426950408889634f;
constexpr float SCQ128 = 0.08838834764831845f * LOG2E, SCQ256 = 0.0625f * LOG2E;

constexpr size_t MiB = 1u << 20;
constexpr size_t WS_CTL = 0, CTL_ZERO_BYTES = 1 * MiB;
constexpr size_t WS_F = 1 * MiB;
constexpr size_t WS_CS = WS_F + 512 * 1024;
constexpr size_t WS_LSE = 2 * MiB;
constexpr size_t WS_KM = 5 * MiB, WS_VM = 9 * MiB;
constexpr size_t WS_WTP = 13 * MiB;
constexpr size_t WS_WTO = 27 * MiB;
constexpr size_t WS_WT2 = 35 * MiB;
constexpr size_t WS_WT1 = 73 * MiB;
constexpr size_t WS_WTKV = 107 * MiB;
constexpr size_t WS_MH = 115 * MiB;
constexpr size_t WS_OA2 = 73 * MiB;
constexpr size_t WS_H = 123 * MiB;
constexpr size_t WS_MRG = 123 * MiB;
constexpr size_t WS_QA = 187 * MiB, WS_KA = 235 * MiB, WS_VA = 283 * MiB;
constexpr size_t WS_KB = 331 * MiB, WS_VB = 363 * MiB;
constexpr size_t WS_G = 187 * MiB;
constexpr size_t WS_QB = 395 * MiB, WS_QM = 427 * MiB;
constexpr size_t WS_Y = 459 * MiB;
constexpr size_t WS_END = 571 * MiB;

constexpr int RING_BYTES = 131072;
constexpr int LDSCTL_OFF = RING_BYTES, MISC_OFF = LDSCTL_OFF + 320;
constexpr int PSUM_OFF = RING_BYTES + 1024;
constexpr int LDS_BYTES = 147456;

#define LDS_WAIT() asm volatile("s_waitcnt lgkmcnt(0)" ::: "memory")
#define VM_WAIT() asm volatile("s_waitcnt vmcnt(0)" ::: "memory")
#define RLX_AGENT __ATOMIC_RELAXED, __HIP_MEMORY_SCOPE_AGENT
typedef GAS unsigned gu32;

#define opaque_tid() opaque_tid_(wave0_)
__device__ __forceinline__ int opaque_tid_(int wave0) { int l; asm volatile("v_mbcnt_lo_u32_b32 %0, -1, 0\n\tv_mbcnt_hi_u32_b32 %0, -1, %0" : "=v"(l)); return wave0 * 64 + l; }
typedef __bf16 bf16x2_t __attribute__((ext_vector_type(2)));
__device__ __forceinline__ unsigned cvt_pk_bf16(float lo, float hi) { f32x2 v = {lo, hi}; bf16x2_t b = __builtin_convertvector(v, bf16x2_t); return __builtin_bit_cast(unsigned, b); }
template <int CTRL> __device__ __forceinline__ float dpp_f(float v) { return __int_as_float(__builtin_amdgcn_update_dpp(0, __float_as_int(v), CTRL, 0xF, 0xF, true)); }
__device__ __forceinline__ float xor16_add(float v) { auto r = __builtin_amdgcn_permlane16_swap(__float_as_uint(v), __float_as_uint(v), false, false); return __uint_as_float(r[0]) + __uint_as_float(r[1]); }
__device__ __forceinline__ float xor32_add(float v) { auto r = __builtin_amdgcn_permlane32_swap(__float_as_uint(v), __float_as_uint(v), false, false); return __uint_as_float(r[0]) + __uint_as_float(r[1]); }
__device__ __forceinline__ float bf_lo(unsigned w) { return __uint_as_float(w << 16); }
__device__ __forceinline__ float bf_hi(unsigned w) { return __uint_as_float(w & 0xffff0000u); }
__device__ __forceinline__ float fast_sigmoid(float x) { return __builtin_amdgcn_rcpf(1.0f + __builtin_amdgcn_exp2f(-x * LOG2E)); }

#define XB_TMO      128
#define XB_XCNT(j)  (256  + 64 * (j))
#define XB_XSUB(j)  (1280 + 64 * (j))
#define XB_XGEN(j)  (2304 + 64 * (j))
#define XB_TOP      3328
#define XB_TOPGEN   3392
#define XCD_BAR_WORDS 3456
#define XB_SPIN_CAP (1u << 18)
__device__ __forceinline__ unsigned xb_ld(unsigned* p)              { return __hip_atomic_load(p, __ATOMIC_RELAXED, __HIP_MEMORY_SCOPE_AGENT); }
__device__ __forceinline__ unsigned xb_add(unsigned* p, unsigned v) { return __hip_atomic_fetch_add(p, v, __ATOMIC_RELAXED, __HIP_MEMORY_SCOPE_AGENT); }
__device__ __forceinline__ unsigned xb_xcc_id() { return (unsigned)__builtin_amdgcn_s_getreg((3 << 11) | 20) & 0xFu; }
#define XB_SPIN(cond, bar) do { unsigned _sp = 0; while (cond) { __builtin_amdgcn_s_sleep(1); \
    if ((++_sp & 255u) == 0u) { if (xb_ld(&(bar)[XB_TMO])) break; if (_sp > XB_SPIN_CAP) { atomicAdd(&(bar)[XB_TMO], 1u); break; } } } } while (0)
struct XcdBarrier { unsigned* bar; unsigned x; volatile LAS unsigned* st; };
__device__ __forceinline__ XcdBarrier xcd_barrier_post(unsigned* bar, volatile LAS unsigned* st, const int wave0_) {
    XcdBarrier b; b.bar = bar; b.x = xb_xcc_id(); b.st = st;
    if (opaque_tid() == 0) (void)xb_add(&bar[XB_XCNT(b.x)], 1u);
    return b;
}
__device__ __forceinline__ void xcd_barrier_complete(unsigned* bar, unsigned x, unsigned& nloc, unsigned& nx) {
    const unsigned G = gridDim.x * gridDim.y * gridDim.z;
    unsigned sum, cnt, mine, sp = 0u;
    for (;;) {
        sum = 0u; cnt = 0u; mine = 0u;
#pragma unroll
        for (unsigned j = 0; j < 16; ++j) { const unsigned c = xb_ld(&bar[XB_XCNT(j)]); sum += c; cnt += (c > 0u) ? 1u : 0u; mine = (j == x) ? c : mine; }
        if (sum == G) break;
        __builtin_amdgcn_s_sleep(1);
        if ((++sp & 255u) == 0u) { if (xb_ld(&bar[XB_TMO])) break; if (sp > XB_SPIN_CAP) { atomicAdd(&bar[XB_TMO], 1u); break; } }
    }
    nloc = mine > 0u ? mine : 1u; nx = cnt > 0u ? cnt : 1u;
}
__device__ __forceinline__ void xcd_barrier(const XcdBarrier& b, const int wave0_) {
    asm volatile("s_waitcnt vmcnt(0)" ::: "memory");
    __syncthreads();
    if (opaque_tid() == 0) {
        unsigned* bar = b.bar;
        __builtin_amdgcn_s_waitcnt(0);
        unsigned nloc = b.st[0], nx = b.st[1];
        if (nloc == 0u) { xcd_barrier_complete(bar, b.x, nloc, nx); b.st[0] = nloc; b.st[1] = nx; }
        const unsigned old = xb_add(&bar[XB_XSUB(b.x)], 1u);
        const unsigned gen = old / nloc;
        if (old + 1u == (gen + 1u) * nloc) {
            __builtin_amdgcn_fence(__ATOMIC_RELEASE, "agent");
            asm volatile("s_waitcnt vmcnt(0)" ::: "memory");
            const unsigned og = xb_add(&bar[XB_TOP], 1u);
            const unsigned tg = og / nx;
            if (og + 1u == (tg + 1u) * nx) xb_add(&bar[XB_TOPGEN], 1u);
            else XB_SPIN(xb_ld(&bar[XB_TOPGEN]) == tg, bar);
            __builtin_amdgcn_fence(__ATOMIC_ACQUIRE, "agent");
            xb_add(&bar[XB_XGEN(b.x)], 1u);
            asm volatile("s_waitcnt vmcnt(0)" ::: "memory");
        } else {
            XB_SPIN(xb_ld(&bar[XB_XGEN(b.x)]) == gen, bar);
            __builtin_amdgcn_fence(__ATOMIC_ACQUIRE, "agent");
            asm volatile("s_waitcnt vmcnt(0)" ::: "memory");
        }
    }
    __syncthreads();
}

__device__ __forceinline__ void xcd_barrier_arrive(const XcdBarrier& b, const int wave0_) {
    asm volatile("s_waitcnt vmcnt(0)" ::: "memory");
    __syncthreads();
    if (opaque_tid() == 0) {
        unsigned* bar = b.bar;
        __builtin_amdgcn_s_waitcnt(0);
        unsigned nloc = b.st[0], nx = b.st[1];
        if (nloc == 0u) { xcd_barrier_complete(bar, b.x, nloc, nx); b.st[0] = nloc; b.st[1] = nx; }
        const unsigned old = xb_add(&bar[XB_XSUB(b.x)], 1u);
        const unsigned gen = old / nloc;
        unsigned role = 0u, tg = 0u;
        if (old + 1u == (gen + 1u) * nloc) {
            __builtin_amdgcn_fence(__ATOMIC_RELEASE, "agent");
            asm volatile("s_waitcnt vmcnt(0)" ::: "memory");
            const unsigned og = xb_add(&bar[XB_TOP], 1u);
            tg = og / nx;
            if (og + 1u == (tg + 1u) * nx) { xb_add(&bar[XB_TOPGEN], 1u); xb_add(&bar[XB_XGEN(b.x)], 1u); role = 2u; } else role = 1u;
        }
        b.st[2] = gen; b.st[3] = tg; b.st[4] = role;
    }
}
__device__ __forceinline__ void xcd_barrier_wait(const XcdBarrier& b, const int wave0_) {
    if (opaque_tid() == 0) {
        unsigned* bar = b.bar; const unsigned gen = b.st[2], tg = b.st[3], role = b.st[4];
        if (role == 1u) { XB_SPIN(xb_ld(&bar[XB_TOPGEN]) == tg, bar); __builtin_amdgcn_fence(__ATOMIC_ACQUIRE, "agent"); xb_add(&bar[XB_XGEN(b.x)], 1u); }
        else if (role == 0u) { XB_SPIN(xb_ld(&bar[XB_XGEN(b.x)]) == gen, bar); __builtin_amdgcn_fence(__ATOMIC_ACQUIRE, "agent"); }
        else __builtin_amdgcn_fence(__ATOMIC_ACQUIRE, "agent");
    }
    __syncthreads();
}

namespace pg8 {
constexpr int BM = 256, BK = 64, HALF = 128, HTB = HALF * BK * 2, STAGE_BYTES = 8 * HTB, NXCD = 8, WGM = 8;
__host__ __device__ __forceinline__ int lds_byte(int r, int c) { const int st = (r >> 4) * 2 + (c >> 5), rr = r & 15, cc = c & 31, ob = rr * 64 + cc * 2; return st * 1024 + (ob ^ (((ob >> 9) & 1) << 5)); }
__host__ __device__ __forceinline__ void stage_rc(int b, int& R, int& C) { const int st = b / 1024, sb = b % 1024, swz = sb ^ (((sb >> 9) & 1) << 5); R = (st >> 1) * 16 + swz / 64; C = (st & 1) * 32 + (swz % 64) / 2; }
__host__ __device__ __forceinline__ int perm32(int rho) { const int n = rho >> 4, i = rho & 15; return 8 * (i >> 2) + 4 * n + (i & 3); }

struct Unit { int pm, pn, koff, nt, first, tag; };
struct Gemm { const bf16_t* A; const bf16_t* Bt; int lda, ldb; };

__device__ __forceinline__ void tile_of(int L, int nM, int nN, int& pm, int& pn) {
    const int nwg = nM * nN; int wgid = L;
    { const int q = nwg / NXCD, r = nwg % NXCD, xcd = wgid % NXCD, off = wgid / NXCD; wgid = (xcd < r ? xcd * (q + 1) : r * (q + 1) + (xcd - r) * q) + off; }
    const int nig = WGM * nN, gid = wgid / nig, fm = gid * WGM, gsz = (nM - fm) < WGM ? (nM - fm) : WGM;
    pm = fm + ((wgid % nig) % gsz); pn = (wgid % nig) / gsz;
}
struct StaticOrder {
    int nM, nN, nwg, G, c, nt, nu, rot;
    __device__ __forceinline__ void init(int M, int N, int K, int G_, int c_, int rot_ = 0) { nM = M / BM; nN = N / BM; nwg = nM * nN; G = G_; c = c_; nt = K / BK;
        nu = c < nwg ? (nwg - 1 - c) / G + 1 : 0; rot = nu > 0 ? rot_ % nu : 0; }
    __device__ __forceinline__ bool next(int i, Unit& u) const {
        if (i >= nu) return false; int ir = i + rot; if (ir >= nu) ir -= nu;
        const long L = (long)ir * G + c;
        tile_of((int)L, nM, nN, u.pm, u.pn); u.koff = 0; u.nt = nt; u.first = 1; u.tag = 0; return true;
    }
};
struct Sub3Order {
    int nM, nN, nwg, G, c, perm;
    __device__ __forceinline__ void init(int M, int N, int G_, int c_, int perm_) { nM = M / BM; nN = N / BM; nwg = nM * nN; G = G_; c = c_; perm = perm_ % 3; }
    __device__ __forceinline__ bool next(int i, Unit& u) const {
        const int ti = i / 3, s = i - 3 * ti; const long L = (long)ti * G + c; if (L >= nwg) return false;
        tile_of((int)L, nM, nN, u.pm, u.pn);
        int br = s + perm; if (br >= 3) br -= 3; int brn = br + 1; if (brn >= 3) brn -= 3;
        u.koff = br == 0 ? 0 : (br == 1 ? 1536 : 2560); u.nt = br == 0 ? 24 : 16; u.first = s == 0; u.tag = br | (brn << 2) | ((s == 2) << 4); return true;
    }
};

template <class Epi, class Sched>
__device__ __forceinline__ void gemm_phase(LAS unsigned char* lds, const Gemm g, const Sched& S, const Epi& E, const int wave0_) {
    const int tid = opaque_tid(), wid = __builtin_amdgcn_readfirstlane(tid >> 6), lane = tid & 63, wr = wid >> 2, wc = wid & 3, fr = lane & 15, fq = lane >> 4;
    unsigned voffA[2], voffB[2];
#pragma unroll
    for (int i = 0; i < 2; ++i) { int R, C; stage_rc(tid * 16 + i * 8192, R, C); const int Rb = Epi::PERM ? ((R & ~31) + perm32(R & 31)) : R;
        voffA[i] = (unsigned)(R * g.lda + C) * 2u; voffB[i] = (unsigned)(Rb * g.ldb + C) * 2u; }
    const size_t kstep = (size_t)(BK * 2);
    const size_t hstepA = (size_t)HALF * g.lda * 2, hstepB = (size_t)HALF * g.ldb * 2;
    const size_t tstepA = 2 * hstepA, tstepB = 2 * hstepB;
    const unsigned ldsw = (unsigned)wid * 1024u;
    const int aoff = lds_byte(wr * 64 + fr, fq * 8), boff = lds_byte(wc * 32 + fr, fq * 8);
#define PG8_SA(b, h) (((b) * 2 + (h)) * HTB)
#define PG8_SB(b, h) ((4 + (b) * 2 + (h)) * HTB)
#define PG8_STAGE(bufoff, gbase, voff) do { _Pragma("unroll") for (int _i = 0; _i < 2; ++_i) \
        __builtin_amdgcn_global_load_lds((const unsigned*)((const char*)(gbase) + (voff)[_i]), (LAS unsigned*)(lds + (bufoff) + ldsw + _i * 8192), 16, 0, 0); } while (0)
#define PG8_LDA(dst, b, h) do { _Pragma("unroll") for (int m = 0; m < 4; ++m) _Pragma("unroll") for (int k = 0; k < 2; ++k) dst[m][k] = *(const LAS bf16x8*)(lds + PG8_SA(b, h) + aoff + m * 2048 + k * 1024); } while (0)
#define PG8_LDB(dst, b, h) do { _Pragma("unroll") for (int n = 0; n < 2; ++n) _Pragma("unroll") for (int k = 0; k < 2; ++k) dst[n][k] = *(const LAS bf16x8*)(lds + PG8_SB(b, h) + boff + n * 2048 + k * 1024); } while (0)
#define PG8_MMA(ai, bj, At, Bt) do { __builtin_amdgcn_s_setprio(1); _Pragma("unroll") for (int m = 0; m < 4; ++m) _Pragma("unroll") for (int n = 0; n < 2; ++n) _Pragma("unroll") for (int k = 0; k < 2; ++k) \
        acc[ai][bj][m][n] = __builtin_amdgcn_mfma_f32_16x16x32_bf16(Bt[n][k], At[m][k], acc[ai][bj][m][n], 0, 0, 0); __builtin_amdgcn_s_setprio(0); } while (0)
#define PG8_WAIT_V(n) asm volatile("s_waitcnt vmcnt(" #n ")" ::: "memory")
#define PG8_WAIT_L(n) asm volatile("s_waitcnt lgkmcnt(" #n ")" ::: "memory")
#define PG8_BAR __builtin_amdgcn_s_barrier()
#define PG8_SCHED __builtin_amdgcn_sched_barrier(0)
    Unit cur, nxt; int ui = 0;
    if (!S.next(0, cur)) return;
    f32x4 acc[2][2][4][2];
#pragma unroll
    for (int a = 0; a < 2; ++a)
#pragma unroll
        for (int b = 0; b < 2; ++b)
#pragma unroll
            for (int m = 0; m < 4; ++m)
#pragma unroll
                for (int n = 0; n < 2; ++n) acc[a][b][m][n] = (f32x4){0.f, 0.f, 0.f, 0.f};
    if constexpr (Epi::ACCINIT) { E.acc_init(acc, cur, wr, wc, fr, fq); cur.tag |= 256; }
    if constexpr (Epi::PREWAIT) E.pre_wait(wave0_);
    u32x4 carry_[Epi::CARRY ? 8 : 1];
    bf16x8 At[4][2], B0[2][2], B1[2][2];
    const char* cA = (const char*)g.A + (size_t)cur.pm * tstepA + (size_t)cur.koff * 2; const char* cB = (const char*)g.Bt + (size_t)cur.pn * tstepB + (size_t)cur.koff * 2;
    PG8_STAGE(PG8_SB(0, 0), cB, voffB); PG8_STAGE(PG8_SB(0, 1), cB + hstepB, voffB); PG8_STAGE(PG8_SA(0, 0), cA, voffA); PG8_STAGE(PG8_SA(0, 1), cA + hstepA, voffA);
    if (wr == 1) PG8_BAR;
    PG8_WAIT_V(2); PG8_BAR;
    PG8_STAGE(PG8_SB(1, 0), cB + kstep, voffB); PG8_STAGE(PG8_SA(1, 0), cA + kstep, voffA); PG8_STAGE(PG8_SB(1, 1), cB + hstepB + kstep, voffB);
    PG8_WAIT_V(6); PG8_BAR;
    for (;;) {
        const bool has_next = S.next(ui + 1, nxt);
        const char* nA = has_next ? (const char*)g.A + (size_t)nxt.pm * tstepA + (size_t)nxt.koff * 2 : cA; const char* nB = has_next ? (const char*)g.Bt + (size_t)nxt.pn * tstepB + (size_t)nxt.koff * 2 : cB;
        const int nt = cur.nt;
        for (int t = 0; t < nt; t += 2) {
            const bool last = (t == nt - 2);
            const char* a1 = cA + (size_t)(t + 1) * kstep;
            const char* a2 = last ? nA : cA + (size_t)(t + 2) * kstep; const char* b2 = last ? nB : cB + (size_t)(t + 2) * kstep;
            const char* a3 = a2 + kstep; const char* b3 = b2 + kstep;
            PG8_LDB(B0, 0, 0); PG8_LDB(B1, 0, 1); PG8_SCHED; PG8_LDA(At, 0, 0); PG8_STAGE(PG8_SA(1, 1), a1 + hstepA, voffA);
            PG8_WAIT_V(8); PG8_WAIT_L(0); PG8_BAR; PG8_MMA(0, 0, At, B0); PG8_MMA(0, 1, At, B1); PG8_BAR; PG8_SCHED;
            PG8_LDA(At, 0, 1); PG8_STAGE(PG8_SB(0, 0), b2, voffB); PG8_STAGE(PG8_SB(0, 1), b2 + hstepB, voffB); PG8_STAGE(PG8_SA(0, 0), a2, voffA);
            PG8_WAIT_V(8); PG8_WAIT_L(0); PG8_BAR; PG8_MMA(1, 0, At, B0); PG8_MMA(1, 1, At, B1); PG8_BAR; PG8_SCHED;
            PG8_LDB(B0, 1, 0); PG8_LDB(B1, 1, 1); PG8_SCHED; PG8_LDA(At, 1, 0); PG8_STAGE(PG8_SA(0, 1), a2 + hstepA, voffA);
            PG8_WAIT_V(8); PG8_WAIT_L(0); PG8_BAR; PG8_MMA(0, 0, At, B0); PG8_MMA(0, 1, At, B1); PG8_BAR; PG8_SCHED;
            PG8_LDA(At, 1, 1); PG8_STAGE(PG8_SB(1, 0), b3, voffB); PG8_STAGE(PG8_SB(1, 1), b3 + hstepB, voffB); PG8_STAGE(PG8_SA(1, 0), a3, voffA);
            PG8_WAIT_V(8); PG8_WAIT_L(0); PG8_BAR; PG8_MMA(1, 0, At, B0); PG8_MMA(1, 1, At, B1); PG8_BAR; PG8_SCHED;
        }
        if (wr == 0) PG8_BAR;
        if constexpr (Epi::LAZYBAR) { if (ui == 0) E.lazy_wait(wave0_); }
        if constexpr (Epi::CARRY) E.call(acc, cur, wr, wc, fr, fq, wid, lane, carry_);
        else { E(acc, cur, wr, wc, fr, fq, wid, lane);
        if (Epi::DUP) E(acc, cur, wr, wc, fr, fq, wid, lane); }
        if (!has_next) break;
        if (nxt.first) {
#pragma unroll
            for (int a = 0; a < 2; ++a)
#pragma unroll
                for (int b = 0; b < 2; ++b)
#pragma unroll
                    for (int m = 0; m < 4; ++m)
#pragma unroll
                        for (int n = 0; n < 2; ++n) acc[a][b][m][n] = (f32x4){0.f, 0.f, 0.f, 0.f};
        }
        cur = nxt; cA = nA; cB = nB; ++ui;
        if (wr == 1) PG8_BAR;
    }
    PG8_WAIT_V(0);
    PG8_BAR;
#undef PG8_SA
#undef PG8_SB
#undef PG8_STAGE
#undef PG8_LDA
#undef PG8_LDB
#undef PG8_MMA
#undef PG8_WAIT_V
#undef PG8_WAIT_L
#undef PG8_BAR
#undef PG8_SCHED
}
}

typedef f32x4 AccT[2][2][4][2];

struct EpiQKV {
    static constexpr bool PERM = true, DUP = (DUP_EPI == 1), LAZYBAR = false, ACCINIT = false, PREWAIT = false, CARRY = false;
    unsigned char* ws; const float* gains[6]; int which;
    LAS unsigned char* lds;
    __device__ __forceinline__ void operator()(AccT& acc, const pg8::Unit& u, int wr, int wc, int fr, int fq, int wid, int lane) const {
        int mode, ldc, col; bf16_t* O; const float* gain = nullptr; float sc = 1.f; const int pn = u.pn;
        if (which == 0) {
            if (pn < 6)       { mode = 1; O = (bf16_t*)(ws + WS_QA); ldc = AW; col = pn * 256;        gain = gains[0]; sc = SCQ128; }
            else if (pn < 12) { mode = 1; O = (bf16_t*)(ws + WS_KA); ldc = AW; col = (pn - 6) * 256;  gain = gains[1]; }
            else if (pn < 18) { mode = 0; O = (bf16_t*)(ws + WS_VA); ldc = AW; col = (pn - 12) * 256; }
            else if (pn < 22) { mode = 1; O = (bf16_t*)(ws + WS_QB); ldc = BW; col = (pn - 18) * 256; gain = gains[2]; sc = SCQ128; }
            else if (pn < 26) { mode = 1; O = (bf16_t*)(ws + WS_KB); ldc = BW; col = (pn - 22) * 256; gain = gains[3]; }
            else if (pn < 30) { mode = 0; O = (bf16_t*)(ws + WS_VB); ldc = BW; col = (pn - 26) * 256; }
            else              { mode = 2; O = (bf16_t*)(ws + WS_QM); ldc = MW; col = (pn - 30) * 256; gain = gains[4]; sc = SCQ256; }
        } else {
            if (pn < 4)       { mode = 2; O = (bf16_t*)(ws + WS_KM); ldc = MW; col = pn * 256;        gain = gains[5]; }
            else              { mode = 0; O = (bf16_t*)(ws + WS_VM); ldc = MW; col = (pn - 4) * 256; }
        }
        float rs[2][4][2];
        if (mode != 0) {
            LAS float* P = (LAS float*)(lds + PSUM_OFF);
#pragma unroll
            for (int ai = 0; ai < 2; ++ai)
#pragma unroll
                for (int m = 0; m < 4; ++m)
#pragma unroll
                    for (int bj = 0; bj < 2; ++bj) {
                        const f32x4 a = acc[ai][bj][m][0], b = acc[ai][bj][m][1];
                        float s = (a[0] * a[0] + a[1] * a[1]) + (a[2] * a[2] + a[3] * a[3]) + (b[0] * b[0] + b[1] * b[1]) + (b[2] * b[2] + b[3] * b[3]);
                        s = xor16_add(s); s = xor32_add(s);
                        if (fq == 0) P[((ai * 128 + wr * 64 + m * 16 + fr) * 2 + bj) * 4 + wc] = s;
                    }
            asm volatile("s_waitcnt lgkmcnt(0)" ::: "memory"); __builtin_amdgcn_s_barrier(); asm volatile("" ::: "memory");
#pragma unroll
            for (int ai = 0; ai < 2; ++ai)
#pragma unroll
                for (int m = 0; m < 4; ++m) {
                    const LAS f32x4* pr = (const LAS f32x4*)(P + (ai * 128 + wr * 64 + m * 16 + fr) * 8);
                    const f32x4 s0 = pr[0], s1 = pr[1];
                    const float t0 = (s0[0] + s0[1]) + (s0[2] + s0[3]), t1 = (s1[0] + s1[1]) + (s1[2] + s1[3]);
                    if (mode == 1) { rs[ai][m][0] = sc * __builtin_amdgcn_rsqf(t0 * (1.f / 128.f) + EPS); rs[ai][m][1] = sc * __builtin_amdgcn_rsqf(t1 * (1.f / 128.f) + EPS); }
                    else { const float r = sc * __builtin_amdgcn_rsqf((t0 + t1) * (1.f / 256.f) + EPS); rs[ai][m][0] = r; rs[ai][m][1] = r; }
                }
        }
        const int row0 = u.pm * 256 + wr * 64 + fr, col0 = col + wc * 32 + 8 * fq;
        f32x4 gv[2][2];
#pragma unroll
        for (int bj = 0; bj < 2; ++bj)
#pragma unroll
            for (int n = 0; n < 2; ++n) {
                if (mode == 0) gv[bj][n] = (f32x4){1.f, 1.f, 1.f, 1.f};
                else { const int gc = (mode == 1 ? 0 : bj * 128) + wc * 32 + 8 * fq + 4 * n; gv[bj][n] = *(const f32x4*)(gain + gc); }
            }
#pragma unroll
        for (int ai = 0; ai < 2; ++ai)
#pragma unroll
            for (int m = 0; m < 4; ++m) { bf16_t* rowp = O + (size_t)(row0 + ai * 128 + m * 16) * ldc + col0;
#pragma unroll
                for (int bj = 0; bj < 2; ++bj) {
                    f32x4 v0 = acc[ai][bj][m][0] * gv[bj][0], v1 = acc[ai][bj][m][1] * gv[bj][1];
                    if (mode != 0) { const float r = rs[ai][m][bj]; v0 = v0 * r; v1 = v1 * r; }
                    u32x4 w; w.x = cvt_pk_bf16(v0[0], v0[1]); w.y = cvt_pk_bf16(v0[2], v0[3]); w.z = cvt_pk_bf16(v1[0], v1[1]); w.w = cvt_pk_bf16(v1[2], v1[3]);
                    *(u32x4*)(rowp + bj * 128) = w; } }
    }
};

struct EpiZG {
    static constexpr bool PERM = true, DUP = false, LAZYBAR = true, ACCINIT = false, PREWAIT = false, CARRY = false;
    unsigned char* ws; const bf16_t* oa0; const bf16_t* oa1; const float* bgate;
    XcdBarrier wb; bool lazy;
    __device__ __forceinline__ void lazy_wait(const int wave0_) const { if (lazy) xcd_barrier_wait(wb, wave0_); }
    __device__ __forceinline__ void operator()(AccT& acc, const pg8::Unit& u, int wr, int wc, int fr, int fq, int wid, int lane) const {
        const int pn = u.pn; const int row0 = u.pm * 256 + wr * 64 + fr, cw = wc * 32 + 8 * fq;
        bf16_t* Y = (bf16_t*)(ws + WS_Y);
        if (pn < 6) {
            const unsigned char* o0 = (const unsigned char*)oa0; const unsigned char* o1 = (const unsigned char*)oa1; const unsigned char* o2 = (const unsigned char*)(ws + WS_OA2);
            const float* lse = (const float*)(ws + WS_LSE); const float* scl = (const float*)(ws + WS_OA2 + 32 * MiB);
#define UB(w, k) ((float)(((w) >> (8 * (k))) & 0xffu))
#pragma unroll
            for (int ab = 0; ab < 4; ++ab) { const int ai = ab >> 1, m0 = (ab & 1) * 2;
                float L[2][2][3], S[2][2][3]; u32x2 P[2][2][3];
#pragma unroll
                for (int mm = 0; mm < 2; ++mm) { const int row = row0 + ai * 128 + (m0 + mm) * 16;
#pragma unroll
                    for (int bj = 0; bj < 2; ++bj) { const int head = 2 * pn + bj, c = pn * 256 + bj * 128 + cw;
                        L[mm][bj][0] = lse[(size_t)row * 12 + head]; L[mm][bj][1] = lse[((size_t)TOK + row) * 12 + head]; L[mm][bj][2] = lse[((size_t)2 * TOK + row) * 12 + head];
                        S[mm][bj][0] = scl[(size_t)row * 12 + head]; S[mm][bj][1] = scl[((size_t)TOK + row) * 12 + head]; S[mm][bj][2] = scl[((size_t)2 * TOK + row) * 12 + head];
                        P[mm][bj][0] = *(const u32x2*)(o0 + (size_t)row * AW + c); P[mm][bj][1] = *(const u32x2*)(o1 + (size_t)row * AW + c); P[mm][bj][2] = *(const u32x2*)(o2 + (size_t)row * AW + c); } }
                asm volatile("" ::: "memory");
#pragma unroll
                for (int mm = 0; mm < 2; ++mm) { const int m = m0 + mm, row = row0 + ai * 128 + m * 16;
#pragma unroll
                    for (int bj = 0; bj < 2; ++bj) { const int c = pn * 256 + bj * 128 + cw;
                        const float l0 = L[mm][bj][0], l1 = L[mm][bj][1], l2 = L[mm][bj][2];
                        const float mx = fmaxf(l0, fmaxf(l1, l2));
                        float w0 = __builtin_amdgcn_exp2f(l0 - mx), w1 = __builtin_amdgcn_exp2f(l1 - mx), w2 = __builtin_amdgcn_exp2f(l2 - mx);
                        const float inv = __builtin_amdgcn_rcpf(w0 + w1 + w2); w0 *= inv * S[mm][bj][0]; w1 *= inv * S[mm][bj][1]; w2 *= inv * S[mm][bj][2];
                        const float nb = -128.f * (w0 + w1 + w2);
                        const u32x2 p0 = P[mm][bj][0], p1 = P[mm][bj][1], p2 = P[mm][bj][2];
                        const f32x4 z0 = acc[ai][bj][m][0], z1 = acc[ai][bj][m][1]; float y[8];
#pragma unroll
                        for (int j = 0; j < 8; ++j) { const float ov = w0 * UB(p0[j >> 2], j & 3) + w1 * UB(p1[j >> 2], j & 3) + w2 * UB(p2[j >> 2], j & 3) + nb;
                            const float zv = j < 4 ? z0[j] : z1[j - 4];
                            y[j] = ov * zv * fast_sigmoid(zv); }
                        u32x4 w; w.x = cvt_pk_bf16(y[0], y[1]); w.y = cvt_pk_bf16(y[2], y[3]); w.z = cvt_pk_bf16(y[4], y[5]); w.w = cvt_pk_bf16(y[6], y[7]);
                        *(u32x4*)(Y + (size_t)row * KP + c) = w; } }
                asm volatile("" ::: "memory"); }
#undef UB
        } else if (pn < 14) {
            const int cb = (pn < 10 ? AW + (pn - 6) * 256 : AW + BW + (pn - 10) * 256) + cw;
            const unsigned char* O8 = (const unsigned char*)oa0 + 72 * MiB; const float* scb = (const float*)(ws + WS_OA2 + 36 * MiB);
#pragma unroll
            for (int ai = 0; ai < 2; ++ai) { u32x2 P[4][2]; float S[4][2];
#pragma unroll
                for (int m = 0; m < 4; ++m) { const size_t row = (size_t)(row0 + ai * 128 + m * 16);
#pragma unroll
                    for (int bj = 0; bj < 2; ++bj) { P[m][bj] = *(const u32x2*)(O8 + row * DM + (pn - 6) * 256 + bj * 128 + cw); S[m][bj] = scb[row * 16 + (pn - 6) * 2 + bj]; } }
                asm volatile("" ::: "memory");
#pragma unroll
                for (int m = 0; m < 4; ++m) { bf16_t* rowp = Y + (size_t)(row0 + ai * 128 + m * 16) * KP + cb;
#pragma unroll
                    for (int bj = 0; bj < 2; ++bj) { const u32x2 p = P[m][bj]; const float sc_ = S[m][bj], nb = -128.f * sc_;
                        const f32x4 z0 = acc[ai][bj][m][0], z1 = acc[ai][bj][m][1]; float y[8];
#pragma unroll
                        for (int j = 0; j < 8; ++j) { const float zv = j < 4 ? z0[j] : z1[j - 4];
                            y[j] = __builtin_fmaf((float)((p[j >> 2] >> (8 * (j & 3))) & 0xffu), sc_, nb) * zv * fast_sigmoid(zv); }
                        u32x4 w; w.x = cvt_pk_bf16(y[0], y[1]); w.y = cvt_pk_bf16(y[2], y[3]); w.z = cvt_pk_bf16(y[4], y[5]); w.w = cvt_pk_bf16(y[6], y[7]);
                        *(u32x4*)(rowp + bj * 128) = w; } }
                asm volatile("" ::: "memory"); }
        } else {
            const int idx = pn - 14, br = idx >> 3, cg = (idx & 7) * 256 + cw;
            unsigned char* G8 = (unsigned char*)(ws + WS_G) + (size_t)br * TOK * DM + (idx & 7) * 256 + (wc * 4 + fq) * 16; const float* bg = bgate + br * DM + cg;
            f32x4 bv[2][2];
#pragma unroll
            for (int bj = 0; bj < 2; ++bj)
#pragma unroll
                for (int n = 0; n < 2; ++n) bv[bj][n] = *(const f32x4*)(bg + bj * 128 + 4 * n);
#define GQ8(x) fmaxf(255.f * fast_sigmoid(x), 1.f)
#define PK8(v) __builtin_amdgcn_cvt_pk_u8_f32(GQ8(v[3]), 3, __builtin_amdgcn_cvt_pk_u8_f32(GQ8(v[2]), 2, __builtin_amdgcn_cvt_pk_u8_f32(GQ8(v[1]), 1, __builtin_amdgcn_cvt_pk_u8_f32(GQ8(v[0]), 0, 0u))))
#pragma unroll
            for (int ai = 0; ai < 2; ++ai)
#pragma unroll
                for (int m = 0; m < 4; ++m) { u32x4 w;
                    { const f32x4 v0 = acc[ai][0][m][0] + bv[0][0], v1 = acc[ai][0][m][1] + bv[0][1]; w.x = PK8(v0); w.y = PK8(v1); }
                    { const f32x4 v0 = acc[ai][1][m][0] + bv[1][0], v1 = acc[ai][1][m][1] + bv[1][1]; w.z = PK8(v0); w.w = PK8(v1); }
                    *(u32x4*)(G8 + (size_t)(row0 + ai * 128 + m * 16) * DM) = w; }
#undef PK8
#undef GQ8
        }
    }
};

struct EpiMerge {
    static constexpr bool PERM = true, DUP = false, LAZYBAR = false, ACCINIT = false, PREWAIT = false, CARRY = true;
    unsigned char* ws;
    __device__ __forceinline__ void call(AccT& acc, const pg8::Unit& u, int wr, int wc, int fr, int fq, int wid, int lane, u32x4 (&cy)[8]) const {
        const int br = u.tag & 3, brn = (u.tag >> 2) & 3; const bool last = (u.tag >> 4) != 0, first = u.first != 0;
        const int row0 = u.pm * 256 + wr * 64 + fr, c0 = u.pn * 256 + wc * 32 + 8 * fq;
        const unsigned char* Ga = (const unsigned char*)(ws + WS_G) + (size_t)br * TOK * DM + u.pn * 256 + (wc * 4 + fq) * 16;
        const unsigned char* Gb = (const unsigned char*)(ws + WS_G) + (size_t)brn * TOK * DM + u.pn * 256 + (wc * 4 + fq) * 16;
        bf16_t* Mg = (bf16_t*)(ws + WS_MRG);
#define UB(w, k) ((float)(((w) >> (8 * (k))) & 0xffu))
#pragma unroll
        for (int ai = 0; ai < 2; ++ai) { u32x4 ga[4], gb[4];
            if (first) {
#pragma unroll
                for (int m = 0; m < 4; ++m) ga[m] = *(const u32x4*)(Ga + (size_t)(row0 + ai * 128 + m * 16) * DM);
            } else {
#pragma unroll
                for (int m = 0; m < 4; ++m) ga[m] = cy[ai * 4 + m];
            }
            if (!last) {
#pragma unroll
                for (int m = 0; m < 4; ++m) gb[m] = *(const u32x4*)(Gb + (size_t)(row0 + ai * 128 + m * 16) * DM);
            } else {
#pragma unroll
                for (int m = 0; m < 4; ++m) gb[m] = ga[m];
            }
            asm volatile("" ::: "memory");
#pragma unroll
            for (int m = 0; m < 4; ++m) { const size_t off = (size_t)(row0 + ai * 128 + m * 16) * DM + c0;
#pragma unroll
                for (int bj = 0; bj < 2; ++bj) { float f[8];
#pragma unroll
                    for (int j = 0; j < 8; ++j) { const unsigned wa = ga[m][2 * bj + (j >> 2)], wb = gb[m][2 * bj + (j >> 2)];
                        f[j] = UB(wa, j & 3) * (last ? (1.f / 255.f) : __builtin_amdgcn_rcpf(UB(wb, j & 3))); }
                    f32x4 v0 = acc[ai][bj][m][0], v1 = acc[ai][bj][m][1];
                    v0 = v0 * (f32x4){f[0], f[1], f[2], f[3]}; v1 = v1 * (f32x4){f[4], f[5], f[6], f[7]};
                    acc[ai][bj][m][0] = v0; acc[ai][bj][m][1] = v1;
                    if (last) { u32x4 w; w.x = cvt_pk_bf16(v0[0], v0[1]); w.y = cvt_pk_bf16(v0[2], v0[3]); w.z = cvt_pk_bf16(v1[0], v1[1]); w.w = cvt_pk_bf16(v1[2], v1[3]);
                        *(u32x4*)(Mg + off + bj * 128) = w; } }
                cy[ai * 4 + m] = gb[m]; }
            asm volatile("" ::: "memory"); }
#undef UB
    }
    __device__ __forceinline__ void operator()(AccT&, const pg8::Unit&, int, int, int, int, int, int) const {}
};

struct EpiOut {
    static constexpr bool PERM = false, DUP = (DUP_EPI == 5), LAZYBAR = false, ACCINIT = true, PREWAIT = true, CARRY = false;
    const float* x; float* out;
    XcdBarrier wb; bool lazy;
    __device__ __forceinline__ void pre_wait(const int wave0_) const { if (lazy) xcd_barrier_wait(wb, wave0_); }
    __device__ __forceinline__ void acc_init(AccT& acc, const pg8::Unit& u, int wr, int wc, int fr, int fq) const {
        const int row0 = u.pm * 256 + wr * 64 + fr, col0 = u.pn * 256 + wc * 32 + 4 * fq;
#pragma unroll
        for (int ai = 0; ai < 2; ++ai)
#pragma unroll
            for (int m = 0; m < 4; ++m) { const size_t off = (size_t)(row0 + ai * 128 + m * 16) * DM + col0;
#pragma unroll
                for (int bj = 0; bj < 2; ++bj)
#pragma unroll
                    for (int n = 0; n < 2; ++n) acc[ai][bj][m][n] = *(const f32x4*)(x + off + bj * 128 + n * 16); }
    }
    __device__ __forceinline__ void operator()(AccT& acc, const pg8::Unit& u, int wr, int wc, int fr, int fq, int wid, int lane) const {
        const int row0 = u.pm * 256 + wr * 64 + fr, col0 = u.pn * 256 + wc * 32 + 4 * fq;
        if (u.tag & 256) {
#pragma unroll
            for (int ai = 0; ai < 2; ++ai)
#pragma unroll
                for (int m = 0; m < 4; ++m) { const size_t off = (size_t)(row0 + ai * 128 + m * 16) * DM + col0;
#pragma unroll
                    for (int bj = 0; bj < 2; ++bj)
#pragma unroll
                        for (int n = 0; n < 2; ++n) *(f32x4*)(out + off + bj * 128 + n * 16) = acc[ai][bj][m][n]; }
            return;
        }
#pragma unroll
        for (int ab = 0; ab < 2; ++ab) { const int ai = ab, m0 = 0; f32x4 xv[4][2][2];
#pragma unroll
            for (int mm = 0; mm < 4; ++mm) { const size_t off = (size_t)(row0 + ai * 128 + (m0 + mm) * 16) * DM + col0;
#pragma unroll
                for (int bj = 0; bj < 2; ++bj)
#pragma unroll
                    for (int n = 0; n < 2; ++n) xv[mm][bj][n] = *(const f32x4*)(x + off + bj * 128 + n * 16); }
            asm volatile("" ::: "memory");
#pragma unroll
            for (int mm = 0; mm < 4; ++mm) { const size_t off = (size_t)(row0 + ai * 128 + (m0 + mm) * 16) * DM + col0;
#pragma unroll
                for (int bj = 0; bj < 2; ++bj)
#pragma unroll
                    for (int n = 0; n < 2; ++n) *(f32x4*)(out + off + bj * 128 + n * 16) = xv[mm][bj][n] + acc[ai][bj][m0 + mm][n]; }
            asm volatile("" ::: "memory"); }
    }
};

namespace att {
#define KSWZ(row, colB) ((row) * 256 + ((colB) ^ (((row) & 7) << 4)))
#define SBAR() __builtin_amdgcn_sched_barrier(0)
constexpr int SHM_V = 16384, SHM_K = 16384;
constexpr int V_OFF = 0, K_OFF = 49152, WS_OFF = 114688, TAB_OFF = 116736, CSL_OFF = 118784;
constexpr float THR2 = 8.f;
__device__ __forceinline__ int crow(int r, int hi) { return (r & 3) + 8 * (r >> 2) + 4 * hi; }
__device__ __forceinline__ int v_st(int k, int c) { const int kk = (k & ~0xC) | ((k & 4) << 1) | ((k & 8) >> 1); return ((kk >> 3) * 4 + (c >> 5)) * 512 + ((kk & 7) * 32 + (c & 31)) * 2; }
__device__ __forceinline__ int swap23(int k) { return (k & ~0xC) | ((k & 4) << 1) | ((k & 8) >> 1); }
#define GLDS(src, dst) asm volatile("s_mov_b32 m0, %1\n\tglobal_load_lds_dwordx4 %0, off" :: "v"(src), "s"((unsigned)(uintptr_t)(dst)) : "memory", "m0")
__device__ __forceinline__ int v_rd_base(int lane) { return ((lane & 3) << 3) | (((lane >> 2) & 3) << 6) | (((lane >> 4) & 1) << 5) | (((lane >> 5) & 1) << 8); }
constexpr int v_rd_off(int d0, int ks, int half) { return d0 * 512 + ks * 4096 + half * 2048; }

template <bool ACCUM>
__device__ __forceinline__ void qkt(f32x16& p0, f32x16& p1, const LAS char* Kimg, int r32, int hi, const bf16x8* qr) {
    if (!ACCUM) { p0 = f32x16{}; p1 = f32x16{}; }
    const LAS char* kb[4];
#pragma unroll
    for (int dd = 0; dd < 4; ++dd) kb[dd] = Kimg + KSWZ(r32, (dd * 16 + hi * 8) * 2);
    __builtin_amdgcn_s_setprio(1);
    bf16x8 f0[8], f1[8];
#pragma unroll
    for (int d0 = 0; d0 < 8; ++d0) { const LAS char* a = kb[d0 & 3] + (d0 >> 2) * 128; f0[d0] = *(const LAS bf16x8*)(a); f1[d0] = *(const LAS bf16x8*)(a + 32 * 256); }
#pragma unroll
    for (int d0 = 0; d0 < 8; ++d0) { p0 = __builtin_amdgcn_mfma_f32_32x32x16_bf16(f0[d0], qr[d0], p0, 0, 0, 0); p1 = __builtin_amdgcn_mfma_f32_32x32x16_bf16(f1[d0], qr[d0], p1, 0, 0, 0); }
    __builtin_amdgcn_sched_group_barrier(0x100, 4, 0);
#pragma unroll
    for (int d0 = 0; d0 < 6; ++d0) { __builtin_amdgcn_sched_group_barrier(0x008, 2, 0); __builtin_amdgcn_sched_group_barrier(0x100, 2, 0); }
    __builtin_amdgcn_sched_group_barrier(0x008, 4, 0);
    __builtin_amdgcn_s_setprio(0);
}
typedef short v4i16_t __attribute__((ext_vector_type(4)));
__device__ __forceinline__ s16x4 vtr(int addr) { return __builtin_bit_cast(s16x4, __builtin_amdgcn_ds_read_tr16_b64_v4i16((LAS v4i16_t*)(uintptr_t)(unsigned)addr)); }
__device__ __forceinline__ void pv_tile(f32x16* o, int vb, bf16x8 pa0, bf16x8 pa1, bf16x8 pa2, bf16x8 pa3) {
#define PV_D0(d0) do { constexpr int b_ = v_rd_off(d0, 0, 0); \
        const s16x4 l0 = vtr(vb + b_), h0 = vtr(vb + b_ + 2048), l1 = vtr(vb + b_ + 4096), h1 = vtr(vb + b_ + 6144), l2 = vtr(vb + b_ + 8192), h2 = vtr(vb + b_ + 10240), l3 = vtr(vb + b_ + 12288), h3 = vtr(vb + b_ + 14336); \
        o[d0] = __builtin_amdgcn_mfma_f32_32x32x16_bf16((bf16x8){l0[0], l0[1], l0[2], l0[3], h0[0], h0[1], h0[2], h0[3]}, pa0, o[d0], 0, 0, 0);   \
        o[d0] = __builtin_amdgcn_mfma_f32_32x32x16_bf16((bf16x8){l1[0], l1[1], l1[2], l1[3], h1[0], h1[1], h1[2], h1[3]}, pa1, o[d0], 0, 0, 0);   \
        o[d0] = __builtin_amdgcn_mfma_f32_32x32x16_bf16((bf16x8){l2[0], l2[1], l2[2], l2[3], h2[0], h2[1], h2[2], h2[3]}, pa2, o[d0], 0, 0, 0);   \
        o[d0] = __builtin_amdgcn_mfma_f32_32x32x16_bf16((bf16x8){l3[0], l3[1], l3[2], l3[3], h3[0], h3[1], h3[2], h3[3]}, pa3, o[d0], 0, 0, 0); } while (0)
    __builtin_amdgcn_s_setprio(1);
    PV_D0(0); PV_D0(1); PV_D0(2); PV_D0(3);
    __builtin_amdgcn_s_setprio(0);
#undef PV_D0
}
__device__ __forceinline__ void store_o_rows(bf16_t* rowp, const f32x16* o, const float rl) {
#pragma unroll
    for (int d0 = 0; d0 < 4; ++d0)
#pragma unroll
        for (int j = 0; j < 2; ++j) { const int a = 8 * j, b = 8 * j + 4;
            const unsigned A0 = cvt_pk_bf16(o[d0][a] * rl, o[d0][a + 1] * rl), A1 = cvt_pk_bf16(o[d0][a + 2] * rl, o[d0][a + 3] * rl);
            const unsigned B0 = cvt_pk_bf16(o[d0][b] * rl, o[d0][b + 1] * rl), B1 = cvt_pk_bf16(o[d0][b + 2] * rl, o[d0][b + 3] * rl);
            auto r0 = __builtin_amdgcn_permlane32_swap(A0, B0, false, false); auto r1 = __builtin_amdgcn_permlane32_swap(A1, B1, false, false);
            const u32x4 w = {r0[0], r1[0], r0[1], r1[1]};
            *(u32x4*)(rowp + d0 * 32 + j * 16) = w; }
}
__device__ __forceinline__ void store_o_rows_u8(unsigned char* rowp, float* scp, const int hi, const f32x16* o, const float rl) {
    float am = 0.f;
#pragma unroll
    for (int d_ = 0; d_ < 4; ++d_)
#pragma unroll
        for (int r = 0; r < 16; ++r) am = fmaxf(am, fabsf(o[d_][r]));
    am *= rl;
    { auto rr = __builtin_amdgcn_permlane32_swap(__float_as_uint(am), __float_as_uint(am), false, false); am = fmaxf(__uint_as_float(rr[0]), __uint_as_float(rr[1])); }
    const float k_ = am > 0.f ? rl * 127.f * __builtin_amdgcn_rcpf(am) : 0.f;
    if (hi == 0) *scp = am * (1.f / 127.f);
#define Q8(x) __builtin_fmaf((x), k_, 128.f)
#define PK4Q(d0, g) __builtin_amdgcn_cvt_pk_u8_f32(Q8(o[d0][4 * (g) + 3]), 3, __builtin_amdgcn_cvt_pk_u8_f32(Q8(o[d0][4 * (g) + 2]), 2, __builtin_amdgcn_cvt_pk_u8_f32(Q8(o[d0][4 * (g) + 1]), 1, __builtin_amdgcn_cvt_pk_u8_f32(Q8(o[d0][4 * (g)]), 0, 0u))))
#pragma unroll
    for (int d0 = 0; d0 < 4; ++d0) { const unsigned W0 = PK4Q(d0, 0), W1 = PK4Q(d0, 1), W2 = PK4Q(d0, 2), W3 = PK4Q(d0, 3);
        auto r0 = __builtin_amdgcn_permlane32_swap(W0, W2, false, false); auto r1 = __builtin_amdgcn_permlane32_swap(W1, W3, false, false);
        const u32x4 w = {r0[0], r0[1], r1[0], r1[1]};
        *(u32x4*)(rowp + 32 * d0) = w; }
#undef PK4Q
#undef Q8
}
__device__ __forceinline__ void softmax_tile(f32x16& p0, f32x16& p1, float& m_reg, float& l_reg, float& alpha, bf16x8& pa0, bf16x8& pa1, bf16x8& pa2, bf16x8& pa3) {
    float pmax = p0[0];
#pragma unroll
    for (int r = 1; r < 16; ++r) pmax = fmaxf(pmax, p0[r]);
#pragma unroll
    for (int r = 0; r < 16; ++r) pmax = fmaxf(pmax, p1[r]);
    { auto rr = __builtin_amdgcn_permlane32_swap(__float_as_uint(pmax), __float_as_uint(pmax), false, false);
      pmax = fmaxf(__uint_as_float(rr[0]), __uint_as_float(rr[1])); }
    float mn;
    if (__builtin_expect(__all(pmax - m_reg <= THR2), 1)) { mn = m_reg; alpha = 1.f; }
    else { mn = fmaxf(m_reg, pmax); alpha = __builtin_amdgcn_exp2f(m_reg - mn); m_reg = mn; }
    const f32x2 mn2 = {mn, mn}; f32x2 ps2a = {0.f, 0.f}, ps2b = {0.f, 0.f};
#pragma unroll
    for (int r = 0; r < 8; ++r) { f32x2 v = {p0[2 * r], p0[2 * r + 1]}; v = v - mn2; v[0] = __builtin_amdgcn_exp2f(v[0]); v[1] = __builtin_amdgcn_exp2f(v[1]); p0[2 * r] = v[0]; p0[2 * r + 1] = v[1]; ps2a += v; }
#pragma unroll
    for (int r = 0; r < 8; ++r) { f32x2 v = {p1[2 * r], p1[2 * r + 1]}; v = v - mn2; v[0] = __builtin_amdgcn_exp2f(v[0]); v[1] = __builtin_amdgcn_exp2f(v[1]); p1[2 * r] = v[0]; p1[2 * r + 1] = v[1]; ps2b += v; }
    ps2a += ps2b; float ps = ps2a[0] + ps2a[1];
    { auto rr = __builtin_amdgcn_permlane32_swap(__float_as_uint(ps), __float_as_uint(ps), false, false);
      ps = __uint_as_float(rr[0]) + __uint_as_float(rr[1]); }
    l_reg = l_reg * alpha + ps;
#define PK4(P, B_, OUT) do { unsigned a0 = cvt_pk_bf16(P[B_+0], P[B_+1]), a1 = cvt_pk_bf16(P[B_+2], P[B_+3]);                          \
        unsigned b0 = cvt_pk_bf16(P[B_+4], P[B_+5]), b1 = cvt_pk_bf16(P[B_+6], P[B_+7]);                                             \
        auto r0 = __builtin_amdgcn_permlane32_swap(a0, b0, false, false); auto r1 = __builtin_amdgcn_permlane32_swap(a1, b1, false, false); \
        u32x4 w = {r0[0], r1[0], r0[1], r1[1]}; OUT = *reinterpret_cast<bf16x8*>(&w); } while (0)
    PK4(p0, 0, pa0); PK4(p0, 8, pa1); PK4(p1, 0, pa2); PK4(p1, 8, pa3);
#undef PK4
}

struct AU {
    const bf16_t* Q; int ldq;
    const bf16_t* K; const bf16_t* V; int ldk;
    bf16_t* O; int ldo;
    float* lse;
    unsigned char* O8; float* sc;
    const float* cs;
    const float* relb;
    int hh;
    int v0;
    int Lm, Ls, dil;
    int kb0, NT;
};

__device__ __forceinline__ void pv_softmax(f32x16* o, const int vb, const bf16x8 q0, const bf16x8 q1, const bf16x8 q2, const bf16x8 q3,
                                           f32x16& p0, f32x16& p1, float& m_reg, float& l_reg, float& alpha, bf16x8& pa0, bf16x8& pa1, bf16x8& pa2, bf16x8& pa3) {
#define PVQ_D0(d0) do { constexpr int b_ = v_rd_off(d0, 0, 0); \
        const s16x4 l0 = vtr(vb + b_), h0 = vtr(vb + b_ + 2048), l1 = vtr(vb + b_ + 4096), h1 = vtr(vb + b_ + 6144), l2 = vtr(vb + b_ + 8192), h2 = vtr(vb + b_ + 10240), l3 = vtr(vb + b_ + 12288), h3 = vtr(vb + b_ + 14336); \
        o[d0] = __builtin_amdgcn_mfma_f32_32x32x16_bf16((bf16x8){l0[0], l0[1], l0[2], l0[3], h0[0], h0[1], h0[2], h0[3]}, q0, o[d0], 0, 0, 0);   \
        o[d0] = __builtin_amdgcn_mfma_f32_32x32x16_bf16((bf16x8){l1[0], l1[1], l1[2], l1[3], h1[0], h1[1], h1[2], h1[3]}, q1, o[d0], 0, 0, 0);   \
        o[d0] = __builtin_amdgcn_mfma_f32_32x32x16_bf16((bf16x8){l2[0], l2[1], l2[2], l2[3], h2[0], h2[1], h2[2], h2[3]}, q2, o[d0], 0, 0, 0);   \
        o[d0] = __builtin_amdgcn_mfma_f32_32x32x16_bf16((bf16x8){l3[0], l3[1], l3[2], l3[3], h3[0], h3[1], h3[2], h3[3]}, q3, o[d0], 0, 0, 0); } while (0)
    PVQ_D0(0); PVQ_D0(1); PVQ_D0(2); PVQ_D0(3);
#undef PVQ_D0
    float pmax = p0[0];
#pragma unroll
    for (int r = 1; r < 16; ++r) pmax = fmaxf(pmax, p0[r]);
#pragma unroll
    for (int r = 0; r < 16; ++r) pmax = fmaxf(pmax, p1[r]);
    { auto rr = __builtin_amdgcn_permlane32_swap(__float_as_uint(pmax), __float_as_uint(pmax), false, false);
      pmax = fmaxf(__uint_as_float(rr[0]), __uint_as_float(rr[1])); }
    const bool ok = __all(pmax - m_reg <= THR2);
    const float mn = ok ? m_reg : fmaxf(m_reg, pmax);
    alpha = __builtin_amdgcn_exp2f(m_reg - mn); m_reg = mn;
    const f32x2 mn2 = {mn, mn}; f32x2 ps2a = {0.f, 0.f}, ps2b = {0.f, 0.f};
#pragma unroll
    for (int r = 0; r < 8; ++r) { f32x2 v = {p0[2 * r], p0[2 * r + 1]}; v = v - mn2; v[0] = __builtin_amdgcn_exp2f(v[0]); v[1] = __builtin_amdgcn_exp2f(v[1]); p0[2 * r] = v[0]; p0[2 * r + 1] = v[1]; ps2a += v; }
#pragma unroll
    for (int r = 0; r < 8; ++r) { f32x2 v = {p1[2 * r], p1[2 * r + 1]}; v = v - mn2; v[0] = __builtin_amdgcn_exp2f(v[0]); v[1] = __builtin_amdgcn_exp2f(v[1]); p1[2 * r] = v[0]; p1[2 * r + 1] = v[1]; ps2b += v; }
    ps2a += ps2b; float ps = ps2a[0] + ps2a[1];
    { auto rr = __builtin_amdgcn_permlane32_swap(__float_as_uint(ps), __float_as_uint(ps), false, false);
      ps = __uint_as_float(rr[0]) + __uint_as_float(rr[1]); }
    l_reg = l_reg * alpha + ps;
#define PK4(P, B_, OUT) do { unsigned a0 = cvt_pk_bf16(P[B_+0], P[B_+1]), a1 = cvt_pk_bf16(P[B_+2], P[B_+3]);                          \
        unsigned b0 = cvt_pk_bf16(P[B_+4], P[B_+5]), b1 = cvt_pk_bf16(P[B_+6], P[B_+7]);                                             \
        auto r0 = __builtin_amdgcn_permlane32_swap(a0, b0, false, false); auto r1 = __builtin_amdgcn_permlane32_swap(a1, b1, false, false); \
        u32x4 w = {r0[0], r1[0], r0[1], r1[1]}; OUT = *reinterpret_cast<bf16x8*>(&w); } while (0)
    PK4(p0, 0, pa0); PK4(p0, 8, pa1); PK4(p1, 0, pa2); PK4(p1, 8, pa3);
#undef PK4
    __builtin_amdgcn_sched_group_barrier(0x100, 8, 0);
#pragma unroll
    for (int i = 0; i < 16; ++i) { __builtin_amdgcn_sched_group_barrier(0x008, 1, 0); __builtin_amdgcn_sched_group_barrier(0x002, 6, 0); __builtin_amdgcn_sched_group_barrier(0x400, 2, 0);
        __builtin_amdgcn_sched_group_barrier(0x100, 2, 0); }
}
template <int MODE>
__device__ __forceinline__ void attn_unit(LAS char* lds, const AU& u, const int wave0_) {
    constexpr int NKH = MODE == 2 ? 2 : 1;
    const int tid = opaque_tid(), wid = __builtin_amdgcn_readfirstlane(tid >> 6), lane = tid & 63, r32 = lane & 31, hi = lane >> 5;
    LAS char* V_lds = lds + V_OFF; LAS char* K_lds = lds + K_OFF;
    LAS float* tab = (LAS float*)(lds + TAB_OFF); LAS float* csl = (LAS float*)(lds + CSL_OFF);
    const int Lm = u.Lm, Ls = u.Ls, dil = u.dil;
#define TOKV(v) ((((v) & Lm) * dil) + ((v) >> Ls))
    const int vw = u.v0 + wid * 32, vq = vw + r32, qm = vq - 4 * hi;
    bf16x8 qr[8 * NKH];
    { const bf16_t* qp = u.Q + (size_t)TOKV(vq) * u.ldq + hi * 8;
#pragma unroll
      for (int d0 = 0; d0 < 8 * NKH; ++d0) qr[d0] = *(const bf16x8*)(qp + d0 * 16); }
    if (MODE == 0) {
        const int delta = tid - 160; float val = -__builtin_inff();
        if (delta >= 0 && delta <= 128) { const int dist = delta * dil; int bk = dist;
            if (dist >= 16) { bk = 16 + (int)(log2f((float)dist * 0.0625f) * (16.0f / 7.0f)); bk = bk > 31 ? 31 : bk; }
            val = u.relb[bk * 12] * LOG2E; }
        tab[tid] = val;
    }
    float m_reg = -1e30f, l_reg = 0.f; f32x16 o[4] = {};
    const int l4 = lane >> 4, kr0 = 8 * wid + l4, kc0 = ((lane & 15) ^ l4) * 8, kc1 = ((lane & 15) ^ (4 + l4)) * 8;
    const int vrow = swap23(8 * wid + ((lane & 31) >> 2)), vc0 = (lane >> 5) * 32 + (lane & 3) * 8;
    const int vb0 = (int)(uintptr_t)V_lds + v_rd_base(lane);
    float st_c = 0.f;
#define SLOAD(kbv, kbf, vbf) do { int a0_ = (kbv) + kr0, a1_ = a0_ + 4, av_ = (kbv) + vrow; a0_ = a0_ < 0 ? 0 : a0_; a1_ = a1_ < 0 ? 0 : a1_; av_ = av_ < 0 ? 0 : av_; \
        const bf16_t* k0_ = u.K + (size_t)TOKV(a0_) * u.ldk + kc0; const bf16_t* k1_ = u.K + (size_t)TOKV(a1_) * u.ldk + kc1; const bf16_t* v0_ = u.V + (size_t)TOKV(av_) * u.ldk + vc0; \
        LAS char* kd_ = K_lds + (kbf) * (NKH * SHM_K) + wid * 2048; LAS char* vd_ = V_lds + (vbf) * SHM_V + wid * 2048; \
        GLDS(k0_, kd_); GLDS(k1_, kd_ + 1024); if (NKH == 2) { GLDS(k0_ + 128, kd_ + SHM_K); GLDS(k1_ + 128, kd_ + SHM_K + 1024); } \
        GLDS(v0_, vd_); GLDS(v0_ + 64, vd_ + 1024); \
        if (MODE == 1) { if (tid < 64) st_c = u.cs[(kbv) + tid]; } } while (0)
#define SWRITE(kbf) do { if (MODE == 1) { if (tid < 64) csl[(kbf) * 64 + tid] = -st_c; } } while (0)
#define RESC(a) do { if (__any((a) < 1.f)) { _Pragma("unroll") for (int d_ = 0; d_ < 4; ++d_) _Pragma("unroll") for (int r = 0; r < 16; ++r) o[d_][r] *= (a); } } while (0)
    const bool need_lim = MODE == 0 && (vw & Lm) < 128; const int lim = vq & Lm;
    f32x16 p0, p1; bf16x8 pa0, pa1, pa2, pa3; float alpha;
    bf16x8 q0, q1, q2, q3;
    SLOAD(u.kb0, 0, 0); VM_WAIT(); SWRITE(0);
#pragma unroll
    for (int d0 = 0; d0 < 8 * NKH; ++d0) asm volatile("" :: "v"(qr[d0]));
    __syncthreads();
    bool act_prev = false; int vcur = 0, vprev = 0;
    for (int t = 0; t < u.NT; ++t) {
        int kbo_ = u.kb0 + 64 * t; asm volatile("" : "+s"(kbo_)); const int kb_ = kbo_;
        const int kbf = t & 1, vnext = vcur == 2 ? 0 : vcur + 1; const bool HN = t + 1 < u.NT;
        if (HN) SLOAD(kb_ + 64, kbf ^ 1, vnext);
        bool act_ = true;
        if (MODE == 0) act_ = (kb_ <= vw + 31) && (kb_ + 63 >= vw - 128);
        if (MODE == 1) act_ = (kb_ <= vw + 31);
        if (act_) {
            SBAR();
            if (MODE == 1) { const LAS f32x4* cp_ = (const LAS f32x4*)(csl + kbf * 64 + 4 * hi);
#pragma unroll
                for (int g_ = 0; g_ < 4; ++g_) { const f32x4 c0_ = cp_[2 * g_], c1_ = cp_[2 * g_ + 8];
#pragma unroll
                    for (int i_ = 0; i_ < 4; ++i_) { p0[4 * g_ + i_] = c0_[i_]; p1[4 * g_ + i_] = c1_[i_]; } }
                qkt<true>(p0, p1, K_lds + kbf * (NKH * SHM_K), r32, hi, qr); }
            else qkt<false>(p0, p1, K_lds + kbf * (NKH * SHM_K), r32, hi, qr);
            if (NKH == 2) qkt<true>(p0, p1, K_lds + kbf * (NKH * SHM_K) + SHM_K, r32, hi, qr + 8);
            const int dq_ = qm - kb_;
            if (MODE == 0) { const LAS float* tb_ = tab + (dq_ + 101);
#pragma unroll
                for (int r = 0; r < 16; ++r) { const int c_ = (r & 3) + 8 * (r >> 2); p0[r] += tb_[59 - c_]; p1[r] += tb_[27 - c_]; }
                if (need_lim) {
#pragma unroll
                    for (int r = 0; r < 16; ++r) { const int c_ = (r & 3) + 8 * (r >> 2);
                        if (dq_ - c_ > lim) p0[r] = -__builtin_inff(); if (dq_ - c_ - 32 > lim) p1[r] = -__builtin_inff(); } } }
            if (MODE == 1) {
                if (kb_ + 63 > vw) {
#pragma unroll
                    for (int r = 0; r < 16; ++r) { const int c_ = (r & 3) + 8 * (r >> 2);
                        if (dq_ - c_ < 0) p0[r] = -__builtin_inff(); if (dq_ - c_ - 32 < 0) p1[r] = -__builtin_inff(); } } }
            SBAR();
            if (act_prev) pv_softmax(o, vb0 + vprev * SHM_V, q0, q1, q2, q3, p0, p1, m_reg, l_reg, alpha, pa0, pa1, pa2, pa3);
            else softmax_tile(p0, p1, m_reg, l_reg, alpha, pa0, pa1, pa2, pa3);
            SBAR(); RESC(alpha); SBAR();
            q0 = pa0; q1 = pa1; q2 = pa2; q3 = pa3;
        } else if (act_prev) { SBAR(); pv_tile(o, vb0 + vprev * SHM_V, q0, q1, q2, q3); SBAR(); }
        if (HN) { VM_WAIT(); SWRITE(kbf ^ 1); }
        __syncthreads();
        act_prev = act_; vprev = vcur; vcur = vnext;
    }
    if (act_prev) { SBAR(); pv_tile(o, vb0 + vprev * SHM_V, q0, q1, q2, q3); }
    if (MODE == 0) { if (hi == 0) u.lse[(size_t)TOKV(vq) * 12] = m_reg + log2f(l_reg); }
    if (MODE == 0) store_o_rows(u.O + (size_t)TOKV(vq) * u.ldo + 8 * hi, o, __builtin_amdgcn_rcpf(l_reg));
    else store_o_rows_u8(u.O8 + (size_t)TOKV(vq) * DM + 16 * hi, u.sc + (size_t)TOKV(vq) * 16, hi, o, __builtin_amdgcn_rcpf(l_reg));
    __syncthreads();
#undef TOKV
#undef SLOAD
#undef SWRITE
#undef RESC
}
constexpr int A2_GRP = 65536, A2_WS = 132096, A2_TAB = 134144;
template <class Gen>
__device__ __forceinline__ void attn_a2_stream(LAS char* lds, const int NU, const Gen& gen, const float* relb_g, const int wave0_) {
    const int tid = opaque_tid(), wid = __builtin_amdgcn_readfirstlane(tid >> 6), lane = tid & 63, r32 = lane & 31, hi = lane >> 5;
    const int grp = wid >> 2;
    LAS char* V_lds = lds + grp * A2_GRP; LAS char* K_lds = V_lds + 32768;
    const int wg = wid & 3, l4 = lane >> 4, kr0 = 16 * wg + l4, kc0 = ((lane & 15) ^ l4) * 8, kc1 = ((lane & 15) ^ (4 + l4)) * 8;
    const int vr0 = swap23(16 * wg + ((lane & 31) >> 2)), vr1 = swap23(16 * wg + 8 + ((lane & 31) >> 2)), vc0 = (lane >> 5) * 32 + (lane & 3) * 8;
    const int vb0 = (int)(uintptr_t)V_lds + v_rd_base(lane);
#define TOKU(U, v) ((((v) & (U).Lm) * (U).dil) + ((v) >> (U).Ls))
#define SLOADU(U, kbv, bf) do { LAS char* kd_ = K_lds + (bf) * SHM_K + wg * 4096; LAS char* vd_ = V_lds + (bf) * SHM_V + wg * 4096; \
        _Pragma("unroll") for (int i_ = 0; i_ < 4; ++i_) { int a_ = (kbv) + kr0 + 4 * i_; a_ = a_ < 0 ? 0 : a_; GLDS((U).K + (size_t)TOKU(U, a_) * (U).ldk + ((i_ & 1) ? kc1 : kc0), kd_ + i_ * 1024); } \
        _Pragma("unroll") for (int h_ = 0; h_ < 2; ++h_) { int a_ = (kbv) + (h_ ? vr1 : vr0); a_ = a_ < 0 ? 0 : a_; const bf16_t* p_ = (U).V + (size_t)TOKU(U, a_) * (U).ldk + vc0; \
            GLDS(p_, vd_ + h_ * 2048); GLDS(p_ + 64, vd_ + h_ * 2048 + 1024); } } while (0)
#define LOADQU(U) do { const bf16_t* qp_ = (U).Q + (size_t)TOKU(U, (U).v0 + wid * 32 + r32) * (U).ldq + hi * 8; \
        _Pragma("unroll") for (int d0 = 0; d0 < 8; ++d0) qr[d0] = *(const bf16x8*)(qp_ + d0 * 16); } while (0)
#define TABU(U, tb) do { const int delta = tid - 160; float val = -__builtin_inff();          \
        if (delta >= 0 && delta <= 128) { const int dist = delta * (U).dil; int bk = dist; \
            if (dist >= 16) { bk = 16 + (int)(log2f((float)dist * 0.0625f) * (16.0f / 7.0f)); bk = bk > 31 ? 31 : bk; } \
            val = relb_l[bk * 12 + (U).hh] * LOG2E; } \
        ((LAS float*)(lds + A2_TAB))[(tb) * 512 + tid] = val; } while (0)
#define RESC(a) do { if (__any((a) < 1.f)) { _Pragma("unroll") for (int d_ = 0; d_ < 4; ++d_) _Pragma("unroll") for (int r = 0; r < 16; ++r) o[d_][r] *= (a); } } while (0)
    AU u; gen(0, u);
    LAS float* relb_l = (LAS float*)(lds + A2_TAB) + 1024;
    if (tid < 384) relb_l[tid] = relb_g[tid];
    __syncthreads();
    bf16x8 qr[8];
    LOADQU(u); TABU(u, 0); SLOADU(u, u.kb0 + 128 * grp + ((grp != 0 && u.NT == 4) ? 128 : 0), 0);
    for (int iu = 0; iu < NU; ++iu) {
        const bool hasn = iu + 1 < NU; AU un = u; if (hasn) gen(iu + 1, un);
        const LAS float* tab = (const LAS float*)(lds + A2_TAB) + (iu & 1) * 512;
        const int Lm = u.Lm;
        const int vw = u.v0 + wid * 32, vq = vw + r32, qm = vq - 4 * hi;
        const int cstart = vw - (vw & Lm);
        const bool need_lim = (vw & Lm) < 128; const int lim = vq & Lm;
        const int kbg = u.kb0 + 128 * grp;
        const int ntm = u.NT - 1, rot = (grp != 0 && u.NT == 4) ? 2 : 0;
        float m_reg = -1e30f, l_reg = 0.f; f32x16 o[4] = {};
        f32x16 p0, p1; bf16x8 pa0, pa1, pa2, pa3; float alpha;
        VM_WAIT();
#pragma unroll
        for (int d0 = 0; d0 < 8; ++d0) asm volatile("" :: "v"(qr[d0]));
        __syncthreads();
#define TILE2(t, BF, LAST) do { int kbo_ = kbg + 64 * (((t) + rot) & ntm); asm volatile("" : "+s"(kbo_)); const int kb_ = kbo_; \
        const bool shr_ = rot != 0 && (t) >= 2;                       \
        const LAS char* kimg_ = (shr_ ? lds + 32768 : K_lds) + (BF) * SHM_K; const int vimg_ = (shr_ ? vb0 - A2_GRP : vb0) + (BF) * SHM_V; \
        if (!(LAST)) { if (!(rot != 0 && (t) + 1 >= 2)) SLOADU(u, kbg + 64 * (((t) + 1 + rot) & ntm), (BF) ^ 1); } \
        else if (hasn) SLOADU(un, un.kb0 + 128 * grp + ((grp != 0 && un.NT == 4) ? 128 : 0), 0); \
        const bool act_ = (kb_ <= vw + 31) && (kb_ + 63 >= vw - 128) && (kb_ + 63 >= cstart); \
        if (act_) { \
            const int dq_ = qm - kb_; SBAR(); \
            { const LAS float* tb_ = tab + (dq_ + 101);                \
              _Pragma("unroll") for (int r = 0; r < 16; ++r) { const int c_ = (r & 3) + 8 * (r >> 2); p0[r] = tb_[59 - c_]; p1[r] = tb_[27 - c_]; } \
              qkt<true>(p0, p1, kimg_, r32, hi, qr); \
              if (need_lim) { _Pragma("unroll") for (int r = 0; r < 16; ++r) { const int c_ = (r & 3) + 8 * (r >> 2); \
                  if (dq_ - c_ > lim) p0[r] = -__builtin_inff(); if (dq_ - c_ - 32 > lim) p1[r] = -__builtin_inff(); } } } } \
        if ((LAST) && hasn) { SBAR(); LOADQU(un); TABU(un, (iu + 1) & 1); SBAR(); } \
        if (act_) { \
            SBAR(); softmax_tile(p0, p1, m_reg, l_reg, alpha, pa0, pa1, pa2, pa3); \
            RESC(alpha); SBAR(); \
            pv_tile(o, vimg_, pa0, pa1, pa2, pa3); } \
        if (!(LAST)) { VM_WAIT(); __syncthreads(); } } while (0)
        int t = 0;
        for (; t + 2 < u.NT; t += 2) { TILE2(t, 0, false); TILE2(t + 1, 1, false); }
        TILE2(t, 0, false); TILE2(t + 1, 1, true);
#undef TILE2
        if (hi == 0) u.lse[(size_t)TOKU(u, vq) * 12] = m_reg + log2f(l_reg);
        {
          const float rl_ = __builtin_amdgcn_rcpf(l_reg); float am = 0.f;
#pragma unroll
          for (int d_ = 0; d_ < 4; ++d_)
#pragma unroll
            for (int r = 0; r < 16; ++r) am = fmaxf(am, fabsf(o[d_][r]));
          am *= rl_;
          { auto rr = __builtin_amdgcn_permlane32_swap(__float_as_uint(am), __float_as_uint(am), false, false); am = fmaxf(__uint_as_float(rr[0]), __uint_as_float(rr[1])); }
          const float k_ = am > 0.f ? rl_ * 127.f * __builtin_amdgcn_rcpf(am) : 0.f;
          if (hi == 0) u.sc[(size_t)TOKU(u, vq) * 12] = am * (1.f / 127.f);
          unsigned char* rowp = u.O8 + (size_t)TOKU(u, vq) * u.ldo + 16 * hi;
#define Q8(x) __builtin_fmaf((x), k_, 128.f)
#define PK4Q(d0, g) __builtin_amdgcn_cvt_pk_u8_f32(Q8(o[d0][4 * (g) + 3]), 3, __builtin_amdgcn_cvt_pk_u8_f32(Q8(o[d0][4 * (g) + 2]), 2, __builtin_amdgcn_cvt_pk_u8_f32(Q8(o[d0][4 * (g) + 1]), 1, __builtin_amdgcn_cvt_pk_u8_f32(Q8(o[d0][4 * (g)]), 0, 0u))))
#pragma unroll
          for (int d0 = 0; d0 < 4; ++d0) { const unsigned W0 = PK4Q(d0, 0), W1 = PK4Q(d0, 1), W2 = PK4Q(d0, 2), W3 = PK4Q(d0, 3);
              auto r0 = __builtin_amdgcn_permlane32_swap(W0, W2, false, false); auto r1 = __builtin_amdgcn_permlane32_swap(W1, W3, false, false);
              const u32x4 w = {r0[0], r0[1], r1[0], r1[1]};
              *(u32x4*)(rowp + 32 * d0) = w; }
#undef PK4Q
#undef Q8
        }
        u = un;
    }
    __syncthreads();
#undef TOKU
#undef SLOADU
#undef LOADQU
#undef TABU
#undef RESC
}
}

__device__ __forceinline__ unsigned f2bf(float f) { unsigned u = __builtin_bit_cast(unsigned, f); return (u + 0x7fffu + ((u >> 16) & 1u)) >> 16; }
__device__ __forceinline__ unsigned pk2(float lo, float hi) { return f2bf(lo) | (f2bf(hi) << 16); }
__device__ __forceinline__ float wave_sum(float v) {
    v += dpp_f<0xB1>(v); v += dpp_f<0x4E>(v);
    v += dpp_f<0x141>(v); v += dpp_f<0x140>(v);
    v = xor16_add(v); v = xor32_add(v);
    return v;
}
struct TrItem { const float* wp; size_t rs; bf16_t* dp; int ldt; };
__device__ __forceinline__ void tr_load(const TrItem& t, f32x4 (&v)[8]) {
#pragma unroll
    for (int i = 0; i < 8; ++i) v[i] = *(const f32x4*)(t.wp + (size_t)(8 * i) * t.rs);
}
__device__ __forceinline__ void tr_store(const TrItem& t, const f32x4 (&v)[8], LAS float* scr, int lane) {
    const int r = lane >> 3, c4 = lane & 7;
#pragma unroll
    for (int i = 0; i < 8; ++i) { LAS float* d = scr + (8 * i + r) * 33 + 4 * c4; d[0] = v[i][0]; d[1] = v[i][1]; d[2] = v[i][2]; d[3] = v[i][3]; }
    LDS_WAIT(); asm volatile("" ::: "memory");
    const int c = lane & 7;
#pragma unroll
    for (int j = 0; j < 4; ++j) { const int n = (lane >> 3) + 8 * j; const LAS float* s = scr + (8 * c) * 33 + n;
        u32x4 o; o.x = pk2(s[0 * 33], s[1 * 33]); o.y = pk2(s[2 * 33], s[3 * 33]); o.z = pk2(s[4 * 33], s[5 * 33]); o.w = pk2(s[6 * 33], s[7 * 33]);
        *(u32x4*)(t.dp + (size_t)(8 * j) * t.ldt) = o; }
    LDS_WAIT(); asm volatile("" ::: "memory");
}
struct Args { const float* in[19]; float* out; unsigned char* ws; int ph_lo, ph_hi; };
typedef __attribute__((address_space(4))) const Args* KArgP;
__device__ __forceinline__ KArgP fresh_args() { KArgP p = (KArgP)__builtin_amdgcn_kernarg_segment_ptr(); asm volatile("" : "+s"(p)); return p; }

__device__ __forceinline__ TrItem tr_decode(KArgP args, unsigned char* ws, int lane, int it) {
    const float* w_in = args->in[4];
    int r = it; const float* src; int ldw, ldt, nkb; bf16_t* dst;
    if (r < 4608) { src = w_in + 0; ldw = INC; dst = (bf16_t*)(ws + WS_WT1); ldt = DM; nkb = 32; }
    else if ((r -= 4608) < 1536) { src = w_in + 4608; ldw = INC; dst = (bf16_t*)(ws + WS_WT2); ldt = DM; nkb = 32; }
    else if ((r -= 1536) < 3072) { src = w_in + 6144; ldw = INC; dst = (bf16_t*)(ws + WS_WT1) + (size_t)4608 * DM; ldt = DM; nkb = 32; }
    else if ((r -= 3072) < 1024) { src = w_in + 9216; ldw = INC; dst = (bf16_t*)(ws + WS_WT2) + (size_t)1536 * DM; ldt = DM; nkb = 32; }
    else if ((r -= 1024) < 1024) { src = w_in + 10248; ldw = INC; dst = (bf16_t*)(ws + WS_WT1) + (size_t)7680 * DM; ldt = DM; nkb = 32; }
    else if ((r -= 1024) < 1024) { src = w_in + 11272; ldw = INC; dst = (bf16_t*)(ws + WS_WT2) + (size_t)2560 * DM; ldt = DM; nkb = 32; }
    else if ((r -= 1024) < 6144) { src = w_in + 12296; ldw = INC; dst = (bf16_t*)(ws + WS_WT2) + (size_t)3584 * DM; ldt = DM; nkb = 32; }
    else if ((r -= 6144) < 2048) { src = args->in[14]; ldw = 2048; dst = (bf16_t*)(ws + WS_WTKV); ldt = DM; nkb = 32; }
    else if ((r -= 2048) < 1536) { src = args->in[15]; ldw = DM; dst = (bf16_t*)(ws + WS_WTP); ldt = KP; nkb = 24; }
    else if ((r -= 1536) < 1024) { src = args->in[16]; ldw = DM; dst = (bf16_t*)(ws + WS_WTP) + 1536; ldt = KP; nkb = 16; }
    else if ((r -= 1024) < 1024) { src = args->in[17]; ldw = DM; dst = (bf16_t*)(ws + WS_WTP) + 2560; ldt = KP; nkb = 16; }
    else { r -= 1024; src = args->in[18]; ldw = DM; dst = (bf16_t*)(ws + WS_WTO); ldt = DM; nkb = 32; }
    const int nb = r / nkb, kb = r - nb * nkb, k0 = 64 * kb, n0 = 32 * nb;
    TrItem t; t.wp = src + (size_t)(k0 + (lane >> 3)) * ldw + n0 + 4 * (lane & 7); t.rs = (size_t)ldw;
    t.dp = dst + (size_t)(n0 + (lane >> 3)) * ldt + k0 + 8 * (lane & 7); t.ldt = ldt; return t;
}
#define TR_LD(V, T, idx) do { if ((idx) < tot_) { T = tr_decode(args, ws, lane, MAP_((idx))); tr_load(T, V); } } while (0)
#define TR_STREAM(first, total, stride, MAPF) do { const int tot_ = (total), st_ = (stride); int j_ = (first); \
        f32x4 va_[8], vb_[8], vc_[8], vd_[8]; TrItem ta_, tb_, tc_, td_; ta_.wp = nullptr; tb_ = ta_; tc_ = ta_; td_ = ta_; \
        auto MAP_ = [](int q_) { return MAPF(q_); }; \
        TR_LD(va_, ta_, j_); TR_LD(vb_, tb_, j_ + st_); TR_LD(vc_, tc_, j_ + 2 * st_); \
        while (j_ < tot_) { \
            TR_LD(vd_, td_, j_ + 3 * st_); tr_store(ta_, va_, scr, lane); j_ += st_; if (j_ >= tot_) break; \
            TR_LD(va_, ta_, j_ + 3 * st_); tr_store(tb_, vb_, scr, lane); j_ += st_; if (j_ >= tot_) break; \
            TR_LD(vb_, tb_, j_ + 3 * st_); tr_store(tc_, vc_, scr, lane); j_ += st_; if (j_ >= tot_) break; \
            TR_LD(vc_, tc_, j_ + 3 * st_); tr_store(td_, vd_, scr, lane); j_ += st_; } } while (0)
__device__ __forceinline__ int map_p0(int r) { if (r < 4608) return r; if ((r -= 4608) < 3072) return 6144 + r; if ((r -= 3072) < 1024) return 10240 + r; return 18432 + (r - 1024); }
__device__ __forceinline__ int map_p1(int r) { if (r < 1536) return 4608 + r; if ((r -= 1536) < 1024) return 9216 + r; if ((r -= 1024) < 1024) return 11264 + r; return 12288 + (r - 1024); }
__device__ __forceinline__ int map_p3(int r) { return 20480 + r; }
constexpr int P1_SIDE = 5632;
__device__ __forceinline__ int map_p1b(int r) { return map_p1(P1_SIDE + r); }
__global__ void __launch_bounds__(512, 2) fwd_kernel(Args args_) {
    extern __shared__ __attribute__((aligned(16))) unsigned char lds_raw[];
    LAS unsigned char* lds = (LAS unsigned char*)lds_raw;
    volatile LAS unsigned* MISC = (volatile LAS unsigned*)(lds + MISC_OFF);
    const int wave0_ = __builtin_amdgcn_readfirstlane((int)threadIdx.x >> 6);
    const int G = gridDim.x; const int bx = blockIdx.x; const int vcu = (G % 8 == 0) ? (bx % 8) * (G / 8) + bx / 8 : bx;
    gu32* ctl = (gu32*)(fresh_args()->ws + WS_CTL);
    for (int i = threadIdx.x; i < (LDS_BYTES - LDSCTL_OFF) / 4; i += 512) ((LAS unsigned*)(lds + LDSCTL_OFF))[i] = 0u;
    __syncthreads();
    XcdBarrier bar; bar.bar = (unsigned*)(ctl + 4096); bar.x = 0; bar.st = nullptr;
    const int lo = fresh_args()->ph_lo, hi_ = fresh_args()->ph_hi;
    const bool one_launch = (hi_ - lo) > 1;
    if (one_launch) bar = xcd_barrier_post((unsigned*)(ctl + 4096), MISC + 8, wave0_);
#ifndef ATT_DUP
#define ATT_DUP 0
#endif
#ifndef ATT_MASK
#define ATT_MASK 7
#endif
#ifndef PH_MASK
#define PH_MASK 63
#endif
#define IN(k) (((PH_MASK >> (k)) & 1) && lo <= (k) && (k) < hi_)
#define BOTH(k) (IN(k) && IN((k) + 1))
#define GRID_BAR() xcd_barrier(bar, wave0_)

    if (IN(0)) {
        const KArgP args = fresh_args(); unsigned char* ws = args->ws; const float* x = args->in[0];
        const int tid = opaque_tid(), lane = tid & 63, wave = __builtin_amdgcn_readfirstlane(tid >> 6);
        LAS float* scr = (LAS float*)(lds + wave * 16384);
        const int gw = vcu * 8 + wave, NGW = G * 8;
        const float* w_in = args->in[4];
        TR_STREAM(gw, 10752, NGW, map_p0);
        __syncthreads();
        LAS float* wfT = (LAS float*)lds;
        { f32x4 wa[4], wb[4];
#pragma unroll
          for (int j = 0; j < 4; ++j) { const float* p = w_in + (size_t)(tid + 512 * j) * INC + 10240; wa[j] = *(const f32x4*)p; wb[j] = *(const f32x4*)(p + 4); }
#pragma unroll
          for (int j = 0; j < 4; ++j) { const int k = tid + 512 * j;
#pragma unroll
              for (int e = 0; e < 4; ++e) { wfT[e * DM + k] = wa[j][e]; wfT[(4 + e) * DM + k] = wb[j][e]; } } }
        __syncthreads();
        const float* ng = args->in[2]; const float* bfg = args->in[5];
        { const int lane_h = opaque_tid() & 63;
#define lane lane_h
        bf16_t* H = (bf16_t*)(ws + WS_H); float* F = (float*)(ws + WS_F);
#pragma unroll 1
        for (int m = gw; m < TOK; m += NGW) {
            const f32x4* xr = (const f32x4*)(x + (size_t)m * DM) + lane;
            f32x4 v[8]; float s = 0.f;
#pragma unroll
            for (int j = 0; j < 8; ++j) { v[j] = xr[64 * j]; s += (v[j][0] * v[j][0] + v[j][1] * v[j][1]) + (v[j][2] * v[j][2] + v[j][3] * v[j][3]); }
            const float rstd = 1.0f / sqrtf(wave_sum(s) * (1.f / DM) + EPS);
            u32x2* o8 = (u32x2*)(H + (size_t)m * DM) + lane;
#pragma unroll
            for (int j = 0; j < 8; ++j) { const f32x4 gj = *((const f32x4*)ng + lane + 64 * j); v[j] = (v[j] * rstd) * gj;
                u32x2 w; w.x = pk2(v[j][0], v[j][1]); w.y = pk2(v[j][2], v[j][3]); o8[64 * j] = w; }
            float fb[8];
#pragma unroll
            for (int hh = 0; hh < 8; ++hh) fb[hh] = 0.f;
#pragma unroll
            for (int j = 0; j < 8; ++j) {
#pragma unroll
                for (int hh = 0; hh < 8; ++hh) { const f32x4 w4 = *((const LAS f32x4*)(wfT + hh * DM) + lane + 64 * j); fb[hh] += (v[j][0] * w4[0] + v[j][1] * w4[1]) + (v[j][2] * w4[2] + v[j][3] * w4[3]); }
                asm volatile("" ::: "memory"); }
#pragma unroll
            for (int hh = 0; hh < 8; ++hh) { fb[hh] = wave_sum(fb[hh]); __builtin_amdgcn_sched_barrier(0); }
            if (lane < 8) { float f = fb[0];
#pragma unroll
                for (int hh = 1; hh < 8; ++hh) f = lane == hh ? fb[hh] : f;
                const float xx = f + bfg[lane]; F[(size_t)m * 8 + lane] = fminf(xx, 0.f) - log1pf(expf(-fabsf(xx))); }
        }
#undef lane
        }
        const float* mem = args->in[1]; const float* mg = args->in[3]; bf16_t* MH = (bf16_t*)(ws + WS_MH);
        { const int lane_m = opaque_tid() & 63;
#define lane lane_m
#pragma unroll 1
        for (int m = gw; m < NB * MEML; m += NGW) {
            const f32x4* xr = (const f32x4*)(mem + (size_t)m * DM) + lane;
            f32x4 v[8]; float s = 0.f;
#pragma unroll
            for (int j = 0; j < 8; ++j) { v[j] = xr[64 * j]; s += (v[j][0] * v[j][0] + v[j][1] * v[j][1]) + (v[j][2] * v[j][2] + v[j][3] * v[j][3]); }
            const float rstd = 1.0f / sqrtf(wave_sum(s) * (1.f / DM) + EPS);
            u32x2* o8 = (u32x2*)(MH + (size_t)m * DM) + lane;
#pragma unroll
            for (int j = 0; j < 8; ++j) { const f32x4 gj = *((const f32x4*)mg + lane + 64 * j); v[j] = (v[j] * rstd) * gj;
                u32x2 w; w.x = pk2(v[j][0], v[j][1]); w.y = pk2(v[j][2], v[j][3]); o8[64 * j] = w; }
        }
#undef lane
        }
        if (BOTH(0)) xcd_barrier_arrive(bar, wave0_); else __syncthreads();
        { const KArgP args = fresh_args(); unsigned char* ws = args->ws;
          const int tid = opaque_tid(), lane = tid & 63, wave = __builtin_amdgcn_readfirstlane(tid >> 6);
          LAS float* scr = (LAS float*)(lds + wave * 16384);
          TR_STREAM(vcu * 8 + wave, 9728 - P1_SIDE, G * 8, map_p1b); }
        if (BOTH(0)) xcd_barrier_wait(bar, wave0_); else __syncthreads();
    }

    if (IN(1)) {
        const KArgP args = fresh_args(); unsigned char* ws = args->ws;
        if (bx >= 192 && bx < 256) {                 const int tid = opaque_tid(), lane = tid & 63, wave = __builtin_amdgcn_readfirstlane(tid >> 6);
            const int j = bx - 192, b = j >> 3, hh = j & 7;
            const float* F = (const float*)(ws + WS_F) + ((size_t)b * SEQ) * 8 + hh; float* CS = (float*)(ws + WS_CS) + (size_t)j * SEQ;
            LAS float* wt = (LAS float*)lds;
            float a0 = F[(size_t)(4 * tid + 0) * 8], a1 = F[(size_t)(4 * tid + 1) * 8], a2 = F[(size_t)(4 * tid + 2) * 8], a3 = F[(size_t)(4 * tid + 3) * 8];
            a1 += a0; a2 += a1; a3 += a2;
            float sc = a3;
#pragma unroll
            for (int o = 1; o < 64; o <<= 1) { const float t = __shfl_up(sc, o); if (lane >= o) sc += t; }
            if (lane == 63) wt[wave] = sc;
            __syncthreads();
            float base = 0.f;
            for (int w = 0; w < wave; ++w) base += wt[w];
            const float ex = base + sc - a3;
            CS[4 * tid + 0] = (ex + a0) * LOG2E; CS[4 * tid + 1] = (ex + a1) * LOG2E; CS[4 * tid + 2] = (ex + a2) * LOG2E; CS[4 * tid + 3] = (ex + a3) * LOG2E;
            __syncthreads();
            { LAS float* scr = (LAS float*)(lds + wave * 16384);
              TR_STREAM((bx - 192) * 8 + wave, P1_SIDE, 512, map_p1); }
            __syncthreads();
        }
        EpiQKV E; E.ws = ws; E.gains[0] = args->in[8]; E.gains[1] = args->in[9]; E.gains[2] = args->in[10]; E.gains[3] = args->in[11]; E.gains[4] = args->in[12]; E.gains[5] = args->in[13]; E.lds = lds;
        { E.which = 0; pg8::Gemm g{(const bf16_t*)(ws + WS_H), (const bf16_t*)(ws + WS_WT1), DM, DM}; pg8::StaticOrder S; S.init(TOK, N1, DM, G, bx);
          pg8::gemm_phase<EpiQKV, pg8::StaticOrder>(lds, g, S, E, wave0_); }
        { E.which = 1; pg8::Gemm g{(const bf16_t*)(ws + WS_MH), (const bf16_t*)(ws + WS_WTKV), DM, DM}; pg8::StaticOrder S; S.init(NB * MEML, 2048, DM, G, (bx + 128) % G);
          pg8::gemm_phase<EpiQKV, pg8::StaticOrder>(lds, g, S, E, wave0_); }
        if (BOTH(1)) GRID_BAR();
    }

    if (IN(2)) {
        const KArgP args = fresh_args(); unsigned char* ws = args->ws;
        LAS char* al = (LAS char*)lds;
        const float* CS = (const float*)(ws + WS_CS);
        for (int v = vcu; v < 256; v += G) {
            { const int bh = v >> 2, s = v & 3, b = bh >> 3, h = bh & 7;
              for (int pass = 0; pass < 2; ++pass) { const int qb = pass ? 7 - s : s;
                  att::AU u; u.Q = (const bf16_t*)(ws + WS_QB) + (size_t)b * SEQ * BW + h * 128; u.ldq = BW;
                  u.K = (const bf16_t*)(ws + WS_KB) + (size_t)b * SEQ * BW + h * 128; u.V = (const bf16_t*)(ws + WS_VB) + (size_t)b * SEQ * BW + h * 128; u.ldk = BW;
                  u.O = (bf16_t*)(ws + WS_Y) + (size_t)b * SEQ * KP + AW + h * 128; u.ldo = KP; u.lse = nullptr; u.cs = CS + (size_t)(b * 8 + h) * SEQ; u.relb = nullptr;
                  u.O8 = (unsigned char*)args->out + 72 * MiB + (size_t)b * SEQ * DM + h * 128; u.sc = (float*)(ws + WS_OA2 + 36 * MiB) + (size_t)b * SEQ * 16 + h;
                  u.v0 = qb * 256; u.Lm = 0x3fffffff; u.Ls = 30; u.dil = 1; u.kb0 = 0; u.NT = 4 * (qb + 1);
                  if (ATT_MASK & 1) att::attn_unit<1>(al, u, wave0_);
                  if (ATT_DUP & 1) att::attn_unit<1>(al, u, wave0_); } }
            { const int b = v >> 5, h = (v >> 3) & 3, qb = v & 7;
              for (int e = 0; e < 2; ++e) {
                  att::AU u; u.Q = (const bf16_t*)(ws + WS_QM) + (size_t)b * SEQ * MW + h * 256; u.ldq = MW;
                  u.K = (const bf16_t*)(ws + WS_KM) + (size_t)b * MEML * MW + h * 256; u.V = (const bf16_t*)(ws + WS_VM) + (size_t)b * MEML * MW + h * 256 + e * 128; u.ldk = MW;
                  u.O = (bf16_t*)(ws + WS_Y) + (size_t)b * SEQ * KP + AW + BW + h * 256 + e * 128; u.ldo = KP; u.lse = nullptr; u.cs = nullptr; u.relb = nullptr;
                  u.O8 = (unsigned char*)args->out + 72 * MiB + (size_t)b * SEQ * DM + 1024 + h * 256 + e * 128; u.sc = (float*)(ws + WS_OA2 + 36 * MiB) + (size_t)b * SEQ * 16 + 8 + h * 2 + e;
                  u.v0 = qb * 256; u.Lm = 0x3fffffff; u.Ls = 30; u.dil = 1; u.kb0 = 0; u.NT = 4;
                  if (ATT_MASK & 2) att::attn_unit<2>(al, u, wave0_);
                  if (ATT_DUP & 2) att::attn_unit<2>(al, u, wave0_); } }
            { float* const outp = args->out; const float* const relbp = args->in[7];
              auto genA = [=](int i, att::AU& u) {
                const int b = v >> 5, w_ = 32 * i + (v & 31), h = w_ / 24, rem_ = w_ - 24 * h, pat = rem_ >> 3, vb = rem_ & 7;
                u.Q = (const bf16_t*)(ws + WS_QA) + (size_t)b * SEQ * AW + h * 128; u.ldq = AW;
                u.K = (const bf16_t*)(ws + WS_KA) + (size_t)b * SEQ * AW + h * 128; u.V = (const bf16_t*)(ws + WS_VA) + (size_t)b * SEQ * AW + h * 128; u.ldk = AW;
                bf16_t* ob = pat == 0 ? (bf16_t*)outp : (pat == 1 ? (bf16_t*)outp + (size_t)TOK * AW : (bf16_t*)(ws + WS_OA2));
                u.O = ob + (size_t)b * SEQ * AW + h * 128; u.ldo = AW;
                u.lse = (float*)(ws + WS_LSE) + ((size_t)pat * TOK + (size_t)b * SEQ) * 12 + h; u.cs = nullptr; u.relb = relbp + h; u.hh = h;
                u.O8 = (unsigned char*)ob + (size_t)b * SEQ * AW + h * 128; u.sc = (float*)(ws + WS_OA2 + 32 * MiB) + ((size_t)pat * TOK + (size_t)b * SEQ) * 12 + h;
                u.v0 = vb * 256; u.Ls = pat == 0 ? 11 : (pat == 1 ? 9 : 7); u.Lm = (1 << u.Ls) - 1; u.dil = pat == 0 ? 1 : (pat == 1 ? 4 : 16);
                if (pat == 2) { u.kb0 = u.v0; u.NT = 2; } else { u.kb0 = u.v0 - 128; u.NT = 4; }
              };
              if (ATT_MASK & 4) att::attn_a2_stream(al, 9, genA, relbp, wave0_);
              if (ATT_DUP & 4) att::attn_a2_stream(al, 9, genA, relbp, wave0_); }
        }
        if (BOTH(2)) xcd_barrier_arrive(bar, wave0_);
    }

    if (IN(3)) {
        const KArgP args = fresh_args(); unsigned char* ws = args->ws;
        if (bx >= 128 && bx < 256) {
            const int tid = opaque_tid(), lane = tid & 63, wave = __builtin_amdgcn_readfirstlane(tid >> 6);
            LAS float* scr = (LAS float*)(lds + wave * 16384);
            TR_STREAM((bx - 128) * 8 + wave, 5632, 1024, map_p3);
            __syncthreads();
        }
        EpiZG E; E.ws = ws; E.oa0 = (const bf16_t*)args->out; E.oa1 = (const bf16_t*)args->out + (size_t)TOK * AW; E.bgate = args->in[6]; E.wb = bar; E.lazy = BOTH(2);
        pg8::Gemm g{(const bf16_t*)(ws + WS_H), (const bf16_t*)(ws + WS_WT2), DM, DM}; pg8::StaticOrder S; S.init(TOK, N2, DM, G, bx, P3_ROT * (bx & 7));
        pg8::gemm_phase<EpiZG, pg8::StaticOrder>(lds, g, S, E, wave0_);
        if (BOTH(3)) GRID_BAR();
    }

    if (IN(4)) {
        const KArgP args = fresh_args(); unsigned char* ws = args->ws;
        EpiMerge E; E.ws = ws;
        pg8::Gemm g{(const bf16_t*)(ws + WS_Y), (const bf16_t*)(ws + WS_WTP), KP, KP}; pg8::Sub3Order S; S.init(TOK, DM, G, bx, bx & 7);
        pg8::gemm_phase<EpiMerge, pg8::Sub3Order>(lds, g, S, E, wave0_);
        if (BOTH(4)) xcd_barrier_arrive(bar, wave0_);
    }

    if (IN(5)) {
        const KArgP args = fresh_args(); unsigned char* ws = args->ws; const float* x = args->in[0];
        EpiOut E; E.x = x; E.out = args->out; E.wb = bar; E.lazy = BOTH(4);
        pg8::Gemm g{(const bf16_t*)(ws + WS_MRG), (const bf16_t*)(ws + WS_WTO), DM, DM}; pg8::StaticOrder S; S.init(TOK, DM, DM, G, bx);
        pg8::gemm_phase<EpiOut, pg8::StaticOrder>(lds, g, S, E, wave0_);
    }
#undef IN
#undef BOTH
#undef GRID_BAR
}

extern "C" void kernel_launch(void* const* d_in, const int* in_sizes, int n_in, void* d_out, int out_size, void* d_ws, size_t ws_size, hipStream_t stream) {
    static int grid = 0;
    if (grid == 0) {
        if (n_in != 19 || in_sizes[0] != TOK * DM || out_size != TOK * DM || ws_size < WS_END) {
            fprintf(stderr, "kernel_launch: shape/workspace mismatch (n_in %d, in0 %d, out %d, ws %zu, need %zu)\n", n_in, n_in > 0 ? in_sizes[0] : -1, out_size, ws_size, (size_t)WS_END); grid = -1; return; }
        int dev = 0, cus = 0;
        if (hipGetDevice(&dev) != hipSuccess || hipDeviceGetAttribute(&cus, hipDeviceAttributeMultiprocessorCount, dev) != hipSuccess) { grid = -1; return; }
        if (hipFuncSetAttribute((const void*)fwd_kernel, hipFuncAttributeMaxDynamicSharedMemorySize, LDS_BYTES) != hipSuccess) { fprintf(stderr, "kernel_launch: hipFuncSetAttribute failed\n"); grid = -1; return; }
        (void)hipGetLastError();
        grid = cus;
    }
    if (grid < 0) return;
    (void)hipMemsetAsync((char*)d_ws + WS_CTL, 0, CTL_ZERO_BYTES, stream);
    Args a{};
    for (int i = 0; i < 19; ++i) a.in[i] = (const float*)d_in[i];
    a.out = (float*)d_out; a.ws = (unsigned char*)d_ws;
#if MK_N_LAUNCHES == 1
    a.ph_lo = 0; a.ph_hi = 6;
    hipLaunchKernelGGL(fwd_kernel, dim3(grid), dim3(512), LDS_BYTES, stream, a);
#else
    for (int p = 0; p < 6; ++p) { a.ph_lo = p; a.ph_hi = p + 1; hipLaunchKernelGGL(fwd_kernel, dim3(grid), dim3(512), LDS_BYTES, stream, a);
#if defined(DUP_PHASE)
        if (p == DUP_PHASE) hipLaunchKernelGGL(fwd_kernel, dim3(grid), dim3(512), LDS_BYTES, stream, a);
#endif
    }
#endif
    const hipError_t le = hipPeekAtLastError();
    if (le != hipSuccess) fprintf(stderr, "kernel_launch: launch failed: %s\n", hipGetErrorName(le));
}
```

```cpp
#pragma clang diagnostic ignored "-Winline-asm"
#include <hip/hip_runtime.h>
#include <hip/hip_bf16.h>
#include <cstdio>
#include <cstdint>

#ifndef P3_ROT
#define P3_ROT 1
#endif
#ifndef DUP_EPI
#define DUP_EPI 0
#endif
#ifndef MK_N_LAUNCHES
#define MK_N_LAUNCHES 1
#endif

#define LAS __attribute__((address_space(3)))
#define GAS __attribute__((address_space(1)))
typedef unsigned short bf16_t;
typedef short bf16x8 __attribute__((ext_vector_type(8)));
typedef short s16x4 __attribute__((ext_vector_type(4)));
typedef float f32x4 __attribute__((ext_vector_type(4)));
typedef float f32x2 __attribute__((ext_vector_type(2)));
typedef float f32x16 __attribute__((ext_vector_type(16)));
typedef unsigned u32x4 __attribute__((ext_vector_type(4)));
typedef unsigned u32x2 __attribute__((ext_vector_type(2)));

constexpr int NB = 8, SEQ = 2048, DM = 2048, TOK = NB * SEQ;
constexpr int AW = 1536, BW = 1024, MW = 1024, MEML = 256, INC = 18440;
constexpr int N1 = 8704, N2 = 9728, KP = 3584;
constexpr float EPS = 1e-6f, LOG2E = 1.4426950408889634f;
constexpr float SCQ128 = 0.08838834764831845f * LOG2E, SCQ256 = 0.0625f * LOG2E;

constexpr size_t MiB = 1u << 20;
constexpr size_t WS_CTL = 0, CTL_ZERO_BYTES = 1 * MiB;
constexpr size_t WS_F = 1 * MiB;
constexpr size_t WS_CS = WS_F + 512 * 1024;
constexpr size_t WS_LSE = 2 * MiB;
constexpr size_t WS_KM = 5 * MiB, WS_VM = 9 * MiB;
constexpr size_t WS_WTP = 13 * MiB;
constexpr size_t WS_WTO = 27 * MiB;
constexpr size_t WS_WT2 = 35 * MiB;
constexpr size_t WS_WT1 = 73 * MiB;
constexpr size_t WS_WTKV = 107 * MiB;
constexpr size_t WS_MH = 115 * MiB;
constexpr size_t WS_OA2 = 73 * MiB;
constexpr size_t WS_H = 123 * MiB;
constexpr size_t WS_MRG = 123 * MiB;
constexpr size_t WS_QA = 187 * MiB, WS_KA = 235 * MiB, WS_VA = 283 * MiB;
constexpr size_t WS_KB = 331 * MiB, WS_VB = 363 * MiB;
constexpr size_t WS_G = 187 * MiB;
constexpr size_t WS_QB = 395 * MiB, WS_QM = 427 * MiB;
constexpr size_t WS_Y = 459 * MiB;
constexpr size_t WS_END = 571 * MiB;

constexpr int RING_BYTES = 131072;
constexpr int LDSCTL_OFF = RING_BYTES, MISC_OFF = LDSCTL_OFF + 320;
constexpr int PSUM_OFF = RING_BYTES + 1024;
constexpr int LDS_BYTES = 147456;

#define LDS_WAIT() asm volatile("s_waitcnt lgkmcnt(0)" ::: "memory")
#define VM_WAIT() asm volatile("s_waitcnt vmcnt(0)" ::: "memory")
#define RLX_AGENT __ATOMIC_RELAXED, __HIP_MEMORY_SCOPE_AGENT
typedef GAS unsigned gu32;

#define opaque_tid() opaque_tid_(wave0_)
__device__ __forceinline__ int opaque_tid_(int wave0) { int l; asm volatile("v_mbcnt_lo_u32_b32 %0, -1, 0\n\tv_mbcnt_hi_u32_b32 %0, -1, %0" : "=v"(l)); return wave0 * 64 + l; }
typedef __bf16 bf16x2_t __attribute__((ext_vector_type(2)));
__device__ __forceinline__ unsigned cvt_pk_bf16(float lo, float hi) { f32x2 v = {lo, hi}; bf16x2_t b = __builtin_convertvector(v, bf16x2_t); return __builtin_bit_cast(unsigned, b); }
template <int CTRL> __device__ __forceinline__ float dpp_f(float v) { return __int_as_float(__builtin_amdgcn_update_dpp(0, __float_as_int(v), CTRL, 0xF, 0xF, true)); }
__device__ __forceinline__ float xor16_add(float v) { auto r = __builtin_amdgcn_permlane16_swap(__float_as_uint(v), __float_as_uint(v), false, false); return __uint_as_float(r[0]) + __uint_as_float(r[1]); }
__device__ __forceinline__ float xor32_add(float v) { auto r = __builtin_amdgcn_permlane32_swap(__float_as_uint(v), __float_as_uint(v), false, false); return __uint_as_float(r[0]) + __uint_as_float(r[1]); }
__device__ __forceinline__ float bf_lo(unsigned w) { return __uint_as_float(w << 16); }
__device__ __forceinline__ float bf_hi(unsigned w) { return __uint_as_float(w & 0xffff0000u); }
__device__ __forceinline__ float fast_sigmoid(float x) { return __builtin_amdgcn_rcpf(1.0f + __builtin_amdgcn_exp2f(-x * LOG2E)); }

#define XB_TMO      128
#define XB_XCNT(j)  (256  + 64 * (j))
#define XB_XSUB(j)  (1280 + 64 * (j))
#define XB_XGEN(j)  (2304 + 64 * (j))
#define XB_TOP      3328
#define XB_TOPGEN   3392
#define XCD_BAR_WORDS 3456
#define XB_SPIN_CAP (1u << 18)
__device__ __forceinline__ unsigned xb_ld(unsigned* p)              { return __hip_atomic_load(p, __ATOMIC_RELAXED, __HIP_MEMORY_SCOPE_AGENT); }
__device__ __forceinline__ unsigned xb_add(unsigned* p, unsigned v) { return __hip_atomic_fetch_add(p, v, __ATOMIC_RELAXED, __HIP_MEMORY_SCOPE_AGENT); }
__device__ __forceinline__ unsigned xb_xcc_id() { return (unsigned)__builtin_amdgcn_s_getreg((3 << 11) | 20) & 0xFu; }
#define XB_SPIN(cond, bar) do { unsigned _sp = 0; while (cond) { __builtin_amdgcn_s_sleep(1); \
    if ((++_sp & 255u) == 0u) { if (xb_ld(&(bar)[XB_TMO])) break; if (_sp > XB_SPIN_CAP) { atomicAdd(&(bar)[XB_TMO], 1u); break; } } } } while (0)
struct XcdBarrier { unsigned* bar; unsigned x; volatile LAS unsigned* st; };
__device__ __forceinline__ XcdBarrier xcd_barrier_post(unsigned* bar, volatile LAS unsigned* st, const int wave0_) {
    XcdBarrier b; b.bar = bar; b.x = xb_xcc_id(); b.st = st;
    if (opaque_tid() == 0) (void)xb_add(&bar[XB_XCNT(b.x)], 1u);
    return b;
}
__device__ __forceinline__ void xcd_barrier_complete(unsigned* bar, unsigned x, unsigned& nloc, unsigned& nx) {
    const unsigned G = gridDim.x * gridDim.y * gridDim.z;
    unsigned sum, cnt, mine, sp = 0u;
    for (;;) {
        sum = 0u; cnt = 0u; mine = 0u;
#pragma unroll
        for (unsigned j = 0; j < 16; ++j) { const unsigned c = xb_ld(&bar[XB_XCNT(j)]); sum += c; cnt += (c > 0u) ? 1u : 0u; mine = (j == x) ? c : mine; }
        if (sum == G) break;
        __builtin_amdgcn_s_sleep(1);
        if ((++sp & 255u) == 0u) { if (xb_ld(&bar[XB_TMO])) break; if (sp > XB_SPIN_CAP) { atomicAdd(&bar[XB_TMO], 1u); break; } }
    }
    nloc = mine > 0u ? mine : 1u; nx = cnt > 0u ? cnt : 1u;
}
__device__ __forceinline__ void xcd_barrier(const XcdBarrier& b, const int wave0_) {
    asm volatile("s_waitcnt vmcnt(0)" ::: "memory");
    __syncthreads();
    if (opaque_tid() == 0) {
        unsigned* bar = b.bar;
        __builtin_amdgcn_s_waitcnt(0);
        unsigned nloc = b.st[0], nx = b.st[1];
        if (nloc == 0u) { xcd_barrier_complete(bar, b.x, nloc, nx); b.st[0] = nloc; b.st[1] = nx; }
        const unsigned old = xb_add(&bar[XB_XSUB(b.x)], 1u);
        const unsigned gen = old / nloc;
        if (old + 1u == (gen + 1u) * nloc) {
            __builtin_amdgcn_fence(__ATOMIC_RELEASE, "agent");
            asm volatile("s_waitcnt vmcnt(0)" ::: "memory");
            const unsigned og = xb_add(&bar[XB_TOP], 1u);
            const unsigned tg = og / nx;
            if (og + 1u == (tg + 1u) * nx) xb_add(&bar[XB_TOPGEN], 1u);
            else XB_SPIN(xb_ld(&bar[XB_TOPGEN]) == tg, bar);
            __builtin_amdgcn_fence(__ATOMIC_ACQUIRE, "agent");
            xb_add(&bar[XB_XGEN(b.x)], 1u);
            asm volatile("s_waitcnt vmcnt(0)" ::: "memory");
        } else {
            XB_SPIN(xb_ld(&bar[XB_XGEN(b.x)]) == gen, bar);
            __builtin_amdgcn_fence(__ATOMIC_ACQUIRE, "agent");
            asm volatile("s_waitcnt vmcnt(0)" ::: "memory");
        }
    }
    __syncthreads();
}

__device__ __forceinline__ void xcd_barrier_arrive(const XcdBarrier& b, const int wave0_) {
    asm volatile("s_waitcnt vmcnt(0)" ::: "memory");
    __syncthreads();
    if (opaque_tid() == 0) {
        unsigned* bar = b.bar;
        __builtin_amdgcn_s_waitcnt(0);
        unsigned nloc = b.st[0], nx = b.st[1];
        if (nloc == 0u) { xcd_barrier_complete(bar, b.x, nloc, nx); b.st[0] = nloc; b.st[1] = nx; }
        const unsigned old = xb_add(&bar[XB_XSUB(b.x)], 1u);
        const unsigned gen = old / nloc;
        unsigned role = 0u, tg = 0u;
        if (old + 1u == (gen + 1u) * nloc) {
            __builtin_amdgcn_fence(__ATOMIC_RELEASE, "agent");
            asm volatile("s_waitcnt vmcnt(0)" ::: "memory");
            const unsigned og = xb_add(&bar[XB_TOP], 1u);
            tg = og / nx;
            if (og + 1u == (tg + 1u) * nx) { xb_add(&bar[XB_TOPGEN], 1u); xb_add(&bar[XB_XGEN(b.x)], 1u); role = 2u; } else role = 1u;
        }
        b.st[2] = gen; b.st[3] = tg; b.st[4] = role;
    }
}
__device__ __forceinline__ void xcd_barrier_wait(const XcdBarrier& b, const int wave0_) {
    if (opaque_tid() == 0) {
        unsigned* bar = b.bar; const unsigned gen = b.st[2], tg = b.st[3], role = b.st[4];
        if (role == 1u) { XB_SPIN(xb_ld(&bar[XB_TOPGEN]) == tg, bar); __builtin_amdgcn_fence(__ATOMIC_ACQUIRE, "agent"); xb_add(&bar[XB_XGEN(b.x)], 1u); }
        else if (role == 0u) { XB_SPIN(xb_ld(&bar[XB_XGEN(b.x)]) == gen, bar); __builtin_amdgcn_fence(__ATOMIC_ACQUIRE, "agent"); }
        else __builtin_amdgcn_fence(__ATOMIC_ACQUIRE, "agent");
    }
    __syncthreads();
}

namespace pg8 {
constexpr int BM = 256, BK = 64, HALF = 128, HTB = HALF * BK * 2, STAGE_BYTES = 8 * HTB, NXCD = 8, WGM = 8;
__host__ __device__ __forceinline__ int lds_byte(int r, int c) { const int st = (r >> 4) * 2 + (c >> 5), rr = r & 15, cc = c & 31, ob = rr * 64 + cc * 2; return st * 1024 + (ob ^ (((ob >> 9) & 1) << 5)); }
__host__ __device__ __forceinline__ void stage_rc(int b, int& R, int& C) { const int st = b / 1024, sb = b % 1024, swz = sb ^ (((sb >> 9) & 1) << 5); R = (st >> 1) * 16 + swz / 64; C = (st & 1) * 32 + (swz % 64) / 2; }
__host__ __device__ __forceinline__ int perm32(int rho) { const int n = rho >> 4, i = rho & 15; return 8 * (i >> 2) + 4 * n + (i & 3); }

struct Unit { int pm, pn, koff, nt, first, tag; };
struct Gemm { const bf16_t* A; const bf16_t* Bt; int lda, ldb; };

__device__ __forceinline__ void tile_of(int L, int nM, int nN, int& pm, int& pn) {
    const int nwg = nM * nN; int wgid = L;
    { const int q = nwg / NXCD, r = nwg % NXCD, xcd = wgid % NXCD, off = wgid / NXCD; wgid = (xcd < r ? xcd * (q + 1) : r * (q + 1) + (xcd - r) * q) + off; }
    const int nig = WGM * nN, gid = wgid / nig, fm = gid * WGM, gsz = (nM - fm) < WGM ? (nM - fm) : WGM;
    pm = fm + ((wgid % nig) % gsz); pn = (wgid % nig) / gsz;
}
struct StaticOrder {
    int nM, nN, nwg, G, c, nt, nu, rot;
    __device__ __forceinline__ void init(int M, int N, int K, int G_, int c_, int rot_ = 0) { nM = M / BM; nN = N / BM; nwg = nM * nN; G = G_; c = c_; nt = K / BK;
        nu = c < nwg ? (nwg - 1 - c) / G + 1 : 0; rot = nu > 0 ? rot_ % nu : 0; }
    __device__ __forceinline__ bool next(int i, Unit& u) const {
        if (i >= nu) return false; int ir = i + rot; if (ir >= nu) ir -= nu;
        const long L = (long)ir * G + c;
        tile_of((int)L, nM, nN, u.pm, u.pn); u.koff = 0; u.nt = nt; u.first = 1; u.tag = 0; return true;
    }
};
struct Sub3Order {
    int nM, nN, nwg, G, c, perm;
    __device__ __forceinline__ void init(int M, int N, int G_, int c_, int perm_) { nM = M / BM; nN = N / BM; nwg = nM * nN; G = G_; c = c_; perm = perm_ % 3; }
    __device__ __forceinline__ bool next(int i, Unit& u) const {
        const int ti = i / 3, s = i - 3 * ti; const long L = (long)ti * G + c; if (L >= nwg) return false;
        tile_of((int)L, nM, nN, u.pm, u.pn);
        int br = s + perm; if (br >= 3) br -= 3; int brn = br + 1; if (brn >= 3) brn -= 3;
        u.koff = br == 0 ? 0 : (br == 1 ? 1536 : 2560); u.nt = br == 0 ? 24 : 16; u.first = s == 0; u.tag = br | (brn << 2) | ((s == 2) << 4); return true;
    }
};

template <class Epi, class Sched>
__device__ __forceinline__ void gemm_phase(LAS unsigned char* lds, const Gemm g, const Sched& S, const Epi& E, const int wave0_) {
    const int tid = opaque_tid(), wid = __builtin_amdgcn_readfirstlane(tid >> 6), lane = tid & 63, wr = wid >> 2, wc = wid & 3, fr = lane & 15, fq = lane >> 4;
    unsigned voffA[2], voffB[2];
#pragma unroll
    for (int i = 0; i < 2; ++i) { int R, C; stage_rc(tid * 16 + i * 8192, R, C); const int Rb = Epi::PERM ? ((R & ~31) + perm32(R & 31)) : R;
        voffA[i] = (unsigned)(R * g.lda + C) * 2u; voffB[i] = (unsigned)(Rb * g.ldb + C) * 2u; }
    const size_t kstep = (size_t)(BK * 2);
    const size_t hstepA = (size_t)HALF * g.lda * 2, hstepB = (size_t)HALF * g.ldb * 2;
    const size_t tstepA = 2 * hstepA, tstepB = 2 * hstepB;
    const unsigned ldsw = (unsigned)wid * 1024u;
    const int aoff = lds_byte(wr * 64 + fr, fq * 8), boff = lds_byte(wc * 32 + fr, fq * 8);
#define PG8_SA(b, h) (((b) * 2 + (h)) * HTB)
#define PG8_SB(b, h) ((4 + (b) * 2 + (h)) * HTB)
#define PG8_STAGE(bufoff, gbase, voff) do { _Pragma("unroll") for (int _i = 0; _i < 2; ++_i) \
        __builtin_amdgcn_global_load_lds((const unsigned*)((const char*)(gbase) + (voff)[_i]), (LAS unsigned*)(lds + (bufoff) + ldsw + _i * 8192), 16, 0, 0); } while (0)
#define PG8_LDA(dst, b, h) do { _Pragma("unroll") for (int m = 0; m < 4; ++m) _Pragma("unroll") for (int k = 0; k < 2; ++k) dst[m][k] = *(const LAS bf16x8*)(lds + PG8_SA(b, h) + aoff + m * 2048 + k * 1024); } while (0)
#define PG8_LDB(dst, b, h) do { _Pragma("unroll") for (int n = 0; n < 2; ++n) _Pragma("unroll") for (int k = 0; k < 2; ++k) dst[n][k] = *(const LAS bf16x8*)(lds + PG8_SB(b, h) + boff + n * 2048 + k * 1024); } while (0)
#define PG8_MMA(ai, bj, At, Bt) do { __builtin_amdgcn_s_setprio(1); _Pragma("unroll") for (int m = 0; m < 4; ++m) _Pragma("unroll") for (int n = 0; n < 2; ++n) _Pragma("unroll") for (int k = 0; k < 2; ++k) \
        acc[ai][bj][m][n] = __builtin_amdgcn_mfma_f32_16x16x32_bf16(Bt[n][k], At[m][k], acc[ai][bj][m][n], 0, 0, 0); __builtin_amdgcn_s_setprio(0); } while (0)
#define PG8_WAIT_V(n) asm volatile("s_waitcnt vmcnt(" #n ")" ::: "memory")
#define PG8_WAIT_L(n) asm volatile("s_waitcnt lgkmcnt(" #n ")" ::: "memory")
#define PG8_BAR __builtin_amdgcn_s_barrier()
#define PG8_SCHED __builtin_amdgcn_sched_barrier(0)
    Unit cur, nxt; int ui = 0;
    if (!S.next(0, cur)) return;
    f32x4 acc[2][2][4][2];
#pragma unroll
    for (int a = 0; a < 2; ++a)
#pragma unroll
        for (int b = 0; b < 2; ++b)
#pragma unroll
            for (int m = 0; m < 4; ++m)
#pragma unroll
                for (int n = 0; n < 2; ++n) acc[a][b][m][n] = (f32x4){0.f, 0.f, 0.f, 0.f};
    if constexpr (Epi::ACCINIT) { E.acc_init(acc, cur, wr, wc, fr, fq); cur.tag |= 256; }
    if constexpr (Epi::PREWAIT) E.pre_wait(wave0_);
    u32x4 carry_[Epi::CARRY ? 8 : 1];
    bf16x8 At[4][2], B0[2][2], B1[2][2];
    const char* cA = (const char*)g.A + (size_t)cur.pm * tstepA + (size_t)cur.koff * 2; const char* cB = (const char*)g.Bt + (size_t)cur.pn * tstepB + (size_t)cur.koff * 2;
    PG8_STAGE(PG8_SB(0, 0), cB, voffB); PG8_STAGE(PG8_SB(0, 1), cB + hstepB, voffB); PG8_STAGE(PG8_SA(0, 0), cA, voffA); PG8_STAGE(PG8_SA(0, 1), cA + hstepA, voffA);
    if (wr == 1) PG8_BAR;
    PG8_WAIT_V(2); PG8_BAR;
    PG8_STAGE(PG8_SB(1, 0), cB + kstep, voffB); PG8_STAGE(PG8_SA(1, 0), cA + kstep, voffA); PG8_STAGE(PG8_SB(1, 1), cB + hstepB + kstep, voffB);
    PG8_WAIT_V(6); PG8_BAR;
    for (;;) {
        const bool has_next = S.next(ui + 1, nxt);
        const char* nA = has_next ? (const char*)g.A + (size_t)nxt.pm * tstepA + (size_t)nxt.koff * 2 : cA; const char* nB = has_next ? (const char*)g.Bt + (size_t)nxt.pn * tstepB + (size_t)nxt.koff * 2 : cB;
        const int nt = cur.nt;
        for (int t = 0; t < nt; t += 2) {
            const bool last = (t == nt - 2);
            const char* a1 = cA + (size_t)(t + 1) * kstep;
            const char* a2 = last ? nA : cA + (size_t)(t + 2) * kstep; const char* b2 = last ? nB : cB + (size_t)(t + 2) * kstep;
            const char* a3 = a2 + kstep; const char* b3 = b2 + kstep;
            PG8_LDB(B0, 0, 0); PG8_LDB(B1, 0, 1); PG8_SCHED; PG8_LDA(At, 0, 0); PG8_STAGE(PG8_SA(1, 1), a1 + hstepA, voffA);
            PG8_WAIT_V(8); PG8_WAIT_L(0); PG8_BAR; PG8_MMA(0, 0, At, B0); PG8_MMA(0, 1, At, B1); PG8_BAR; PG8_SCHED;
            PG8_LDA(At, 0, 1); PG8_STAGE(PG8_SB(0, 0), b2, voffB); PG8_STAGE(PG8_SB(0, 1), b2 + hstepB, voffB); PG8_STAGE(PG8_SA(0, 0), a2, voffA);
            PG8_WAIT_V(8); PG8_WAIT_L(0); PG8_BAR; PG8_MMA(1, 0, At, B0); PG8_MMA(1, 1, At, B1); PG8_BAR; PG8_SCHED;
            PG8_LDB(B0, 1, 0); PG8_LDB(B1, 1, 1); PG8_SCHED; PG8_LDA(At, 1, 0); PG8_STAGE(PG8_SA(0, 1), a2 + hstepA, voffA);
            PG8_WAIT_V(8); PG8_WAIT_L(0); PG8_BAR; PG8_MMA(0, 0, At, B0); PG8_MMA(0, 1, At, B1); PG8_BAR; PG8_SCHED;
            PG8_LDA(At, 1, 1); PG8_STAGE(PG8_SB(1, 0), b3, voffB); PG8_STAGE(PG8_SB(1, 1), b3 + hstepB, voffB); PG8_STAGE(PG8_SA(1, 0), a3, voffA);
            PG8_WAIT_V(8); PG8_WAIT_L(0); PG8_BAR; PG8_MMA(1, 0, At, B0); PG8_MMA(1, 1, At, B1); PG8_BAR; PG8_SCHED;
        }
        if (wr == 0) PG8_BAR;
        if constexpr (Epi::LAZYBAR) { if (ui == 0) E.lazy_wait(wave0_); }
        if constexpr (Epi::CARRY) E.call(acc, cur, wr, wc, fr, fq, wid, lane, carry_);
        else { E(acc, cur, wr, wc, fr, fq, wid, lane);
        if (Epi::DUP) E(acc, cur, wr, wc, fr, fq, wid, lane); }
        if (!has_next) break;
        if (nxt.first) {
#pragma unroll
            for (int a = 0; a < 2; ++a)
#pragma unroll
                for (int b = 0; b < 2; ++b)
#pragma unroll
                    for (int m = 0; m < 4; ++m)
#pragma unroll
                        for (int n = 0; n < 2; ++n) acc[a][b][m][n] = (f32x4){0.f, 0.f, 0.f, 0.f};
        }
        cur = nxt; cA = nA; cB = nB; ++ui;
        if (wr == 1) PG8_BAR;
    }
    PG8_WAIT_V(0);
    PG8_BAR;
#undef PG8_SA
#undef PG8_SB
#undef PG8_STAGE
#undef PG8_LDA
#undef PG8_LDB
#undef PG8_MMA
#undef PG8_WAIT_V
#undef PG8_WAIT_L
#undef PG8_BAR
#undef PG8_SCHED
}
}

typedef f32x4 AccT[2][2][4][2];

struct EpiQKV {
    static constexpr bool PERM = true, DUP = (DUP_EPI == 1), LAZYBAR = false, ACCINIT = false, PREWAIT = false, CARRY = false;
    unsigned char* ws; const float* gains[6]; int which;
    LAS unsigned char* lds;
    __device__ __forceinline__ void operator()(AccT& acc, const pg8::Unit& u, int wr, int wc, int fr, int fq, int wid, int lane) const {
        int mode, ldc, col; bf16_t* O; const float* gain = nullptr; float sc = 1.f; const int pn = u.pn;
        if (which == 0) {
            if (pn < 6)       { mode = 1; O = (bf16_t*)(ws + WS_QA); ldc = AW; col = pn * 256;        gain = gains[0]; sc = SCQ128; }
            else if (pn < 12) { mode = 1; O = (bf16_t*)(ws + WS_KA); ldc = AW; col = (pn - 6) * 256;  gain = gains[1]; }
            else if (pn < 18) { mode = 0; O = (bf16_t*)(ws + WS_VA); ldc = AW; col = (pn - 12) * 256; }
            else if (pn < 22) { mode = 1; O = (bf16_t*)(ws + WS_QB); ldc = BW; col = (pn - 18) * 256; gain = gains[2]; sc = SCQ128; }
            else if (pn < 26) { mode = 1; O = (bf16_t*)(ws + WS_KB); ldc = BW; col = (pn - 22) * 256; gain = gains[3]; }
            else if (pn < 30) { mode = 0; O = (bf16_t*)(ws + WS_VB); ldc = BW; col = (pn - 26) * 256; }
            else              { mode = 2; O = (bf16_t*)(ws + WS_QM); ldc = MW; col = (pn - 30) * 256; gain = gains[4]; sc = SCQ256; }
        } else {
            if (pn < 4)       { mode = 2; O = (bf16_t*)(ws + WS_KM); ldc = MW; col = pn * 256;        gain = gains[5]; }
            else              { mode = 0; O = (bf16_t*)(ws + WS_VM); ldc = MW; col = (pn - 4) * 256; }
        }
        float rs[2][4][2];
        if (mode != 0) {
            LAS float* P = (LAS float*)(lds + PSUM_OFF);
#pragma unroll
            for (int ai = 0; ai < 2; ++ai)
#pragma unroll
                for (int m = 0; m < 4; ++m)
#pragma unroll
                    for (int bj = 0; bj < 2; ++bj) {
                        const f32x4 a = acc[ai][bj][m][0], b = acc[ai][bj][m][1];
                        float s = (a[0] * a[0] + a[1] * a[1]) + (a[2] * a[2] + a[3] * a[3]) + (b[0] * b[0] + b[1] * b[1]) + (b[2] * b[2] + b[3] * b[3]);
                        s = xor16_add(s); s = xor32_add(s);
                        if (fq == 0) P[((ai * 128 + wr * 64 + m * 16 + fr) * 2 + bj) * 4 + wc] = s;
                    }
            asm volatile("s_waitcnt lgkmcnt(0)" ::: "memory"); __builtin_amdgcn_s_barrier(); asm volatile("" ::: "memory");
#pragma unroll
            for (int ai = 0; ai < 2; ++ai)
#pragma unroll
                for (int m = 0; m < 4; ++m) {
                    const LAS f32x4* pr = (const LAS f32x4*)(P + (ai * 128 + wr * 64 + m * 16 + fr) * 8);
                    const f32x4 s0 = pr[0], s1 = pr[1];
                    const float t0 = (s0[0] + s0[1]) + (s0[2] + s0[3]), t1 = (s1[0] + s1[1]) + (s1[2] + s1[3]);
                    if (mode == 1) { rs[ai][m][0] = sc * __builtin_amdgcn_rsqf(t0 * (1.f / 128.f) + EPS); rs[ai][m][1] = sc * __builtin_amdgcn_rsqf(t1 * (1.f / 128.f) + EPS); }
                    else { const float r = sc * __builtin_amdgcn_rsqf((t0 + t1) * (1.f / 256.f) + EPS); rs[ai][m][0] = r; rs[ai][m][1] = r; }
                }
        }
        const int row0 = u.pm * 256 + wr * 64 + fr, col0 = col + wc * 32 + 8 * fq;
        f32x4 gv[2][2];
#pragma unroll
        for (int bj = 0; bj < 2; ++bj)
#pragma unroll
            for (int n = 0; n < 2; ++n) {
                if (mode == 0) gv[bj][n] = (f32x4){1.f, 1.f, 1.f, 1.f};
                else { const int gc = (mode == 1 ? 0 : bj * 128) + wc * 32 + 8 * fq + 4 * n; gv[bj][n] = *(const f32x4*)(gain + gc); }
            }
#pragma unroll
        for (int ai = 0; ai < 2; ++ai)
#pragma unroll
            for (int m = 0; m < 4; ++m) { bf16_t* rowp = O + (size_t)(row0 + ai * 128 + m * 16) * ldc + col0;
#pragma unroll
                for (int bj = 0; bj < 2; ++bj) {
                    f32x4 v0 = acc[ai][bj][m][0] * gv[bj][0], v1 = acc[ai][bj][m][1] * gv[bj][1];
                    if (mode != 0) { const float r = rs[ai][m][bj]; v0 = v0 * r; v1 = v1 * r; }
                    u32x4 w; w.x = cvt_pk_bf16(v0[0], v0[1]); w.y = cvt_pk_bf16(v0[2], v0[3]); w.z = cvt_pk_bf16(v1[0], v1[1]); w.w = cvt_pk_bf16(v1[2], v1[3]);
                    *(u32x4*)(rowp + bj * 128) = w; } }
    }
};

struct EpiZG {
    static constexpr bool PERM = true, DUP = false, LAZYBAR = true, ACCINIT = false, PREWAIT = false, CARRY = false;
    unsigned char* ws; const bf16_t* oa0; const bf16_t* oa1; const float* bgate;
    XcdBarrier wb; bool lazy;
    __device__ __forceinline__ void lazy_wait(const int wave0_) const { if (lazy) xcd_barrier_wait(wb, wave0_); }
    __device__ __forceinline__ void operator()(AccT& acc, const pg8::Unit& u, int wr, int wc, int fr, int fq, int wid, int lane) const {
        const int pn = u.pn; const int row0 = u.pm * 256 + wr * 64 + fr, cw = wc * 32 + 8 * fq;
        bf16_t* Y = (bf16_t*)(ws + WS_Y);
        if (pn < 6) {
            const unsigned char* o0 = (const unsigned char*)oa0; const unsigned char* o1 = (const unsigned char*)oa1; const unsigned char* o2 = (const unsigned char*)(ws + WS_OA2);
            const float* lse = (const float*)(ws + WS_LSE); const float* scl = (const float*)(ws + WS_OA2 + 32 * MiB);
#define UB(w, k) ((float)(((w) >> (8 * (k))) & 0xffu))
#pragma unroll
            for (int ab = 0; ab < 4; ++ab) { const int ai = ab >> 1, m0 = (ab & 1) * 2;
                float L[2][2][3], S[2][2][3]; u32x2 P[2][2][3];
#pragma unroll
                for (int mm = 0; mm < 2; ++mm) { const int row = row0 + ai * 128 + (m0 + mm) * 16;
#pragma unroll
                    for (int bj = 0; bj < 2; ++bj) { const int head = 2 * pn + bj, c = pn * 256 + bj * 128 + cw;
                        L[mm][bj][0] = lse[(size_t)row * 12 + head]; L[mm][bj][1] = lse[((size_t)TOK + row) * 12 + head]; L[mm][bj][2] = lse[((size_t)2 * TOK + row) * 12 + head];
                        S[mm][bj][0] = scl[(size_t)row * 12 + head]; S[mm][bj][1] = scl[((size_t)TOK + row) * 12 + head]; S[mm][bj][2] = scl[((size_t)2 * TOK + row) * 12 + head];
                        P[mm][bj][0] = *(const u32x2*)(o0 + (size_t)row * AW + c); P[mm][bj][1] = *(const u32x2*)(o1 + (size_t)row * AW + c); P[mm][bj][2] = *(const u32x2*)(o2 + (size_t)row * AW + c); } }
                asm volatile("" ::: "memory");
#pragma unroll
                for (int mm = 0; mm < 2; ++mm) { const int m = m0 + mm, row = row0 + ai * 128 + m * 16;
#pragma unroll
                    for (int bj = 0; bj < 2; ++bj) { const int c = pn * 256 + bj * 128 + cw;
                        const float l0 = L[mm][bj][0], l1 = L[mm][bj][1], l2 = L[mm][bj][2];
                        const float mx = fmaxf(l0, fmaxf(l1, l2));
                        float w0 = __builtin_amdgcn_exp2f(l0 - mx), w1 = __builtin_amdgcn_exp2f(l1 - mx), w2 = __builtin_amdgcn_exp2f(l2 - mx);
                        const float inv = __builtin_amdgcn_rcpf(w0 + w1 + w2); w0 *= inv * S[mm][bj][0]; w1 *= inv * S[mm][bj][1]; w2 *= inv * S[mm][bj][2];
                        const float nb = -128.f * (w0 + w1 + w2);
                        const u32x2 p0 = P[mm][bj][0], p1 = P[mm][bj][1], p2 = P[mm][bj][2];
                        const f32x4 z0 = acc[ai][bj][m][0], z1 = acc[ai][bj][m][1]; float y[8];
#pragma unroll
                        for (int j = 0; j < 8; ++j) { const float ov = w0 * UB(p0[j >> 2], j & 3) + w1 * UB(p1[j >> 2], j & 3) + w2 * UB(p2[j >> 2], j & 3) + nb;
                            const float zv = j < 4 ? z0[j] : z1[j - 4];
                            y[j] = ov * zv * fast_sigmoid(zv); }
                        u32x4 w; w.x = cvt_pk_bf16(y[0], y[1]); w.y = cvt_pk_bf16(y[2], y[3]); w.z = cvt_pk_bf16(y[4], y[5]); w.w = cvt_pk_bf16(y[6], y[7]);
                        *(u32x4*)(Y + (size_t)row * KP + c) = w; } }
                asm volatile("" ::: "memory"); }
#undef UB
        } else if (pn < 14) {
            const int cb = (pn < 10 ? AW + (pn - 6) * 256 : AW + BW + (pn - 10) * 256) + cw;
            const unsigned char* O8 = (const unsigned char*)oa0 + 72 * MiB; const float* scb = (const float*)(ws + WS_OA2 + 36 * MiB);
#pragma unroll
            for (int ai = 0; ai < 2; ++ai) { u32x2 P[4][2]; float S[4][2];
#pragma unroll
                for (int m = 0; m < 4; ++m) { const size_t row = (size_t)(row0 + ai * 128 + m * 16);
#pragma unroll
                    for (int bj = 0; bj < 2; ++bj) { P[m][bj] = *(const u32x2*)(O8 + row * DM + (pn - 6) * 256 + bj * 128 + cw); S[m][bj] = scb[row * 16 + (pn - 6) * 2 + bj]; } }
                asm volatile("" ::: "memory");
#pragma unroll
                for (int m = 0; m < 4; ++m) { bf16_t* rowp = Y + (size_t)(row0 + ai * 128 + m * 16) * KP + cb;
#pragma unroll
                    for (int bj = 0; bj < 2; ++bj) { const u32x2 p = P[m][bj]; const float sc_ = S[m][bj], nb = -128.f * sc_;
                        const f32x4 z0 = acc[ai][bj][m][0], z1 = acc[ai][bj][m][1]; float y[8];
#pragma unroll
                        for (int j = 0; j < 8; ++j) { const float zv = j < 4 ? z0[j] : z1[j - 4];
                            y[j] = __builtin_fmaf((float)((p[j >> 2] >> (8 * (j & 3))) & 0xffu), sc_, nb) * zv * fast_sigmoid(zv); }
                        u32x4 w; w.x = cvt_pk_bf16(y[0], y[1]); w.y = cvt_pk_bf16(y[2], y[3]); w.z = cvt_pk_bf16(y[4], y[5]); w.w = cvt_pk_bf16(y[6], y[7]);
                        *(u32x4*)(rowp + bj * 128) = w; } }
                asm volatile("" ::: "memory"); }
        } else {
            const int idx = pn - 14, br = idx >> 3, cg = (idx & 7) * 256 + cw;
            unsigned char* G8 = (unsigned char*)(ws + WS_G) + (size_t)br * TOK * DM + (idx & 7) * 256 + (wc * 4 + fq) * 16; const float* bg = bgate + br * DM + cg;
            f32x4 bv[2][2];
#pragma unroll
            for (int bj = 0; bj < 2; ++bj)
#pragma unroll
                for (int n = 0; n < 2; ++n) bv[bj][n] = *(const f32x4*)(bg + bj * 128 + 4 * n);
#define GQ8(x) fmaxf(255.f * fast_sigmoid(x), 1.f)
#define PK8(v) __builtin_amdgcn_cvt_pk_u8_f32(GQ8(v[3]), 3, __builtin_amdgcn_cvt_pk_u8_f32(GQ8(v[2]), 2, __builtin_amdgcn_cvt_pk_u8_f32(GQ8(v[1]), 1, __builtin_amdgcn_cvt_pk_u8_f32(GQ8(v[0]), 0, 0u))))
#pragma unroll
            for (int ai = 0; ai < 2; ++ai)
#pragma unroll
                for (int m = 0; m < 4; ++m) { u32x4 w;
                    { const f32x4 v0 = acc[ai][0][m][0] + bv[0][0], v1 = acc[ai][0][m][1] + bv[0][1]; w.x = PK8(v0); w.y = PK8(v1); }
                    { const f32x4 v0 = acc[ai][1][m][0] + bv[1][0], v1 = acc[ai][1][m][1] + bv[1][1]; w.z = PK8(v0); w.w = PK8(v1); }
                    *(u32x4*)(G8 + (size_t)(row0 + ai * 128 + m * 16) * DM) = w; }
#undef PK8
#undef GQ8
        }
    }
};

struct EpiMerge {
    static constexpr bool PERM = true, DUP = false, LAZYBAR = false, ACCINIT = false, PREWAIT = false, CARRY = true;
    unsigned char* ws;
    __device__ __forceinline__ void call(AccT& acc, const pg8::Unit& u, int wr, int wc, int fr, int fq, int wid, int lane, u32x4 (&cy)[8]) const {
        const int br = u.tag & 3, brn = (u.tag >> 2) & 3; const bool last = (u.tag >> 4) != 0, first = u.first != 0;
        const int row0 = u.pm * 256 + wr * 64 + fr, c0 = u.pn * 256 + wc * 32 + 8 * fq;
        const unsigned char* Ga = (const unsigned char*)(ws + WS_G) + (size_t)br * TOK * DM + u.pn * 256 + (wc * 4 + fq) * 16;
        const unsigned char* Gb = (const unsigned char*)(ws + WS_G) + (size_t)brn * TOK * DM + u.pn * 256 + (wc * 4 + fq) * 16;
        bf16_t* Mg = (bf16_t*)(ws + WS_MRG);
#define UB(w, k) ((float)(((w) >> (8 * (k))) & 0xffu))
#pragma unroll
        for (int ai = 0; ai < 2; ++ai) { u32x4 ga[4], gb[4];
            if (first) {
#pragma unroll
                for (int m = 0; m < 4; ++m) ga[m] = *(const u32x4*)(Ga + (size_t)(row0 + ai * 128 + m * 16) * DM);
            } else {
#pragma unroll
                for (int m = 0; m < 4; ++m) ga[m] = cy[ai * 4 + m];
            }
            if (!last) {
#pragma unroll
                for (int m = 0; m < 4; ++m) gb[m] = *(const u32x4*)(Gb + (size_t)(row0 + ai * 128 + m * 16) * DM);
            } else {
#pragma unroll
                for (int m = 0; m < 4; ++m) gb[m] = ga[m];
            }
            asm volatile("" ::: "memory");
#pragma unroll
            for (int m = 0; m < 4; ++m) { const size_t off = (size_t)(row0 + ai * 128 + m * 16) * DM + c0;
#pragma unroll
                for (int bj = 0; bj < 2; ++bj) { float f[8];
#pragma unroll
                    for (int j = 0; j < 8; ++j) { const unsigned wa = ga[m][2 * bj + (j >> 2)], wb = gb[m][2 * bj + (j >> 2)];
                        f[j] = UB(wa, j & 3) * (last ? (1.f / 255.f) : __builtin_amdgcn_rcpf(UB(wb, j & 3))); }
                    f32x4 v0 = acc[ai][bj][m][0], v1 = acc[ai][bj][m][1];
                    v0 = v0 * (f32x4){f[0], f[1], f[2], f[3]}; v1 = v1 * (f32x4){f[4], f[5], f[6], f[7]};
                    acc[ai][bj][m][0] = v0; acc[ai][bj][m][1] = v1;
                    if (last) { u32x4 w; w.x = cvt_pk_bf16(v0[0], v0[1]); w.y = cvt_pk_bf16(v0[2], v0[3]); w.z = cvt_pk_bf16(v1[0], v1[1]); w.w = cvt_pk_bf16(v1[2], v1[3]);
                        *(u32x4*)(Mg + off + bj * 128) = w; } }
                cy[ai * 4 + m] = gb[m]; }
            asm volatile("" ::: "memory"); }
#undef UB
    }
    __device__ __forceinline__ void operator()(AccT&, const pg8::Unit&, int, int, int, int, int, int) const {}
};

struct EpiOut {
    static constexpr bool PERM = false, DUP = (DUP_EPI == 5), LAZYBAR = false, ACCINIT = true, PREWAIT = true, CARRY = false;
    const float* x; float* out;
    XcdBarrier wb; bool lazy;
    __device__ __forceinline__ void pre_wait(const int wave0_) const { if (lazy) xcd_barrier_wait(wb, wave0_); }
    __device__ __forceinline__ void acc_init(AccT& acc, const pg8::Unit& u, int wr, int wc, int fr, int fq) const {
        const int row0 = u.pm * 256 + wr * 64 + fr, col0 = u.pn * 256 + wc * 32 + 4 * fq;
#pragma unroll
        for (int ai = 0; ai < 2; ++ai)
#pragma unroll
            for (int m = 0; m < 4; ++m) { const size_t off = (size_t)(row0 + ai * 128 + m * 16) * DM + col0;
#pragma unroll
                for (int bj = 0; bj < 2; ++bj)
#pragma unroll
                    for (int n = 0; n < 2; ++n) acc[ai][bj][m][n] = *(const f32x4*)(x + off + bj * 128 + n * 16); }
    }
    __device__ __forceinline__ void operator()(AccT& acc, const pg8::Unit& u, int wr, int wc, int fr, int fq, int wid, int lane) const {
        const int row0 = u.pm * 256 + wr * 64 + fr, col0 = u.pn * 256 + wc * 32 + 4 * fq;
        if (u.tag & 256) {
#pragma unroll
            for (int ai = 0; ai < 2; ++ai)
#pragma unroll
                for (int m = 0; m < 4; ++m) { const size_t off = (size_t)(row0 + ai * 128 + m * 16) * DM + col0;
#pragma unroll
                    for (int bj = 0; bj < 2; ++bj)
#pragma unroll
                        for (int n = 0; n < 2; ++n) __builtin_nontemporal_store((f32x4)(acc[ai][bj][m][n]), (f32x4*)(out + off + bj * 128 + n * 16)); }
            return;
        }
#pragma unroll
        for (int ab = 0; ab < 2; ++ab) { const int ai = ab, m0 = 0; f32x4 xv[4][2][2];
#pragma unroll
            for (int mm = 0; mm < 4; ++mm) { const size_t off = (size_t)(row0 + ai * 128 + (m0 + mm) * 16) * DM + col0;
#pragma unroll
                for (int bj = 0; bj < 2; ++bj)
#pragma unroll
                    for (int n = 0; n < 2; ++n) xv[mm][bj][n] = *(const f32x4*)(x + off + bj * 128 + n * 16); }
            asm volatile("" ::: "memory");
#pragma unroll
            for (int mm = 0; mm < 4; ++mm) { const size_t off = (size_t)(row0 + ai * 128 + (m0 + mm) * 16) * DM + col0;
#pragma unroll
                for (int bj = 0; bj < 2; ++bj)
#pragma unroll
                    for (int n = 0; n < 2; ++n) __builtin_nontemporal_store((f32x4)(xv[mm][bj][n] + acc[ai][bj][m0 + mm][n]), (f32x4*)(out + off + bj * 128 + n * 16)); }
            asm volatile("" ::: "memory"); }
    }
};

namespace att {
#define KSWZ(row, colB) ((row) * 256 + ((colB) ^ (((row) & 7) << 4)))
#define SBAR() __builtin_amdgcn_sched_barrier(0)
constexpr int SHM_V = 16384, SHM_K = 16384;
constexpr int V_OFF = 0, K_OFF = 49152, WS_OFF = 114688, TAB_OFF = 116736, CSL_OFF = 118784;
constexpr float THR2 = 8.f;
__device__ __forceinline__ int crow(int r, int hi) { return (r & 3) + 8 * (r >> 2) + 4 * hi; }
__device__ __forceinline__ int v_st(int k, int c) { const int kk = (k & ~0xC) | ((k & 4) << 1) | ((k & 8) >> 1); return ((kk >> 3) * 4 + (c >> 5)) * 512 + ((kk & 7) * 32 + (c & 31)) * 2; }
__device__ __forceinline__ int swap23(int k) { return (k & ~0xC) | ((k & 4) << 1) | ((k & 8) >> 1); }
#define GLDS(src, dst) asm volatile("s_mov_b32 m0, %1\n\tglobal_load_lds_dwordx4 %0, off" :: "v"(src), "s"((unsigned)(uintptr_t)(dst)) : "memory", "m0")
__device__ __forceinline__ int v_rd_base(int lane) { return ((lane & 3) << 3) | (((lane >> 2) & 3) << 6) | (((lane >> 4) & 1) << 5) | (((lane >> 5) & 1) << 8); }
constexpr int v_rd_off(int d0, int ks, int half) { return d0 * 512 + ks * 4096 + half * 2048; }

template <bool ACCUM>
__device__ __forceinline__ void qkt(f32x16& p0, f32x16& p1, const LAS char* Kimg, int r32, int hi, const bf16x8* qr) {
    if (!ACCUM) { p0 = f32x16{}; p1 = f32x16{}; }
    const LAS char* kb[4];
#pragma unroll
    for (int dd = 0; dd < 4; ++dd) kb[dd] = Kimg + KSWZ(r32, (dd * 16 + hi * 8) * 2);
    __builtin_amdgcn_s_setprio(1);
    bf16x8 f0[8], f1[8];
#pragma unroll
    for (int d0 = 0; d0 < 8; ++d0) { const LAS char* a = kb[d0 & 3] + (d0 >> 2) * 128; f0[d0] = *(const LAS bf16x8*)(a); f1[d0] = *(const LAS bf16x8*)(a + 32 * 256); }
#pragma unroll
    for (int d0 = 0; d0 < 8; ++d0) { p0 = __builtin_amdgcn_mfma_f32_32x32x16_bf16(f0[d0], qr[d0], p0, 0, 0, 0); p1 = __builtin_amdgcn_mfma_f32_32x32x16_bf16(f1[d0], qr[d0], p1, 0, 0, 0); }
    __builtin_amdgcn_sched_group_barrier(0x100, 4, 0);
#pragma unroll
    for (int d0 = 0; d0 < 6; ++d0) { __builtin_amdgcn_sched_group_barrier(0x008, 2, 0); __builtin_amdgcn_sched_group_barrier(0x100, 2, 0); }
    __builtin_amdgcn_sched_group_barrier(0x008, 4, 0);
    __builtin_amdgcn_s_setprio(0);
}
typedef short v4i16_t __attribute__((ext_vector_type(4)));
__device__ __forceinline__ s16x4 vtr(int addr) { return __builtin_bit_cast(s16x4, __builtin_amdgcn_ds_read_tr16_b64_v4i16((LAS v4i16_t*)(uintptr_t)(unsigned)addr)); }
__device__ __forceinline__ void pv_tile(f32x16* o, int vb, bf16x8 pa0, bf16x8 pa1, bf16x8 pa2, bf16x8 pa3) {
#define PV_D0(d0) do { constexpr int b_ = v_rd_off(d0, 0, 0); \
        const s16x4 l0 = vtr(vb + b_), h0 = vtr(vb + b_ + 2048), l1 = vtr(vb + b_ + 4096), h1 = vtr(vb + b_ + 6144), l2 = vtr(vb + b_ + 8192), h2 = vtr(vb + b_ + 10240), l3 = vtr(vb + b_ + 12288), h3 = vtr(vb + b_ + 14336); \
        o[d0] = __builtin_amdgcn_mfma_f32_32x32x16_bf16((bf16x8){l0[0], l0[1], l0[2], l0[3], h0[0], h0[1], h0[2], h0[3]}, pa0, o[d0], 0, 0, 0);   \
        o[d0] = __builtin_amdgcn_mfma_f32_32x32x16_bf16((bf16x8){l1[0], l1[1], l1[2], l1[3], h1[0], h1[1], h1[2], h1[3]}, pa1, o[d0], 0, 0, 0);   \
        o[d0] = __builtin_amdgcn_mfma_f32_32x32x16_bf16((bf16x8){l2[0], l2[1], l2[2], l2[3], h2[0], h2[1], h2[2], h2[3]}, pa2, o[d0], 0, 0, 0);   \
        o[d0] = __builtin_amdgcn_mfma_f32_32x32x16_bf16((bf16x8){l3[0], l3[1], l3[2], l3[3], h3[0], h3[1], h3[2], h3[3]}, pa3, o[d0], 0, 0, 0); } while (0)
    __builtin_amdgcn_s_setprio(1);
    PV_D0(0); PV_D0(1); PV_D0(2); PV_D0(3);
    __builtin_amdgcn_s_setprio(0);
#undef PV_D0
}
__device__ __forceinline__ void store_o_rows(bf16_t* rowp, const f32x16* o, const float rl) {
#pragma unroll
    for (int d0 = 0; d0 < 4; ++d0)
#pragma unroll
        for (int j = 0; j < 2; ++j) { const int a = 8 * j, b = 8 * j + 4;
            const unsigned A0 = cvt_pk_bf16(o[d0][a] * rl, o[d0][a + 1] * rl), A1 = cvt_pk_bf16(o[d0][a + 2] * rl, o[d0][a + 3] * rl);
            const unsigned B0 = cvt_pk_bf16(o[d0][b] * rl, o[d0][b + 1] * rl), B1 = cvt_pk_bf16(o[d0][b + 2] * rl, o[d0][b + 3] * rl);
            auto r0 = __builtin_amdgcn_permlane32_swap(A0, B0, false, false); auto r1 = __builtin_amdgcn_permlane32_swap(A1, B1, false, false);
            const u32x4 w = {r0[0], r1[0], r0[1], r1[1]};
            *(u32x4*)(rowp + d0 * 32 + j * 16) = w; }
}
__device__ __forceinline__ void store_o_rows_u8(unsigned char* rowp, float* scp, const int hi, const f32x16* o, const float rl) {
    float am = 0.f;
#pragma unroll
    for (int d_ = 0; d_ < 4; ++d_)
#pragma unroll
        for (int r = 0; r < 16; ++r) am = fmaxf(am, fabsf(o[d_][r]));
    am *= rl;
    { auto rr = __builtin_amdgcn_permlane32_swap(__float_as_uint(am), __float_as_uint(am), false, false); am = fmaxf(__uint_as_float(rr[0]), __uint_as_float(rr[1])); }
    const float k_ = am > 0.f ? rl * 127.f * __builtin_amdgcn_rcpf(am) : 0.f;
    if (hi == 0) *scp = am * (1.f / 127.f);
#define Q8(x) __builtin_fmaf((x), k_, 128.f)
#define PK4Q(d0, g) __builtin_amdgcn_cvt_pk_u8_f32(Q8(o[d0][4 * (g) + 3]), 3, __builtin_amdgcn_cvt_pk_u8_f32(Q8(o[d0][4 * (g) + 2]), 2, __builtin_amdgcn_cvt_pk_u8_f32(Q8(o[d0][4 * (g) + 1]), 1, __builtin_amdgcn_cvt_pk_u8_f32(Q8(o[d0][4 * (g)]), 0, 0u))))
#pragma unroll
    for (int d0 = 0; d0 < 4; ++d0) { const unsigned W0 = PK4Q(d0, 0), W1 = PK4Q(d0, 1), W2 = PK4Q(d0, 2), W3 = PK4Q(d0, 3);
        auto r0 = __builtin_amdgcn_permlane32_swap(W0, W2, false, false); auto r1 = __builtin_amdgcn_permlane32_swap(W1, W3, false, false);
        const u32x4 w = {r0[0], r0[1], r1[0], r1[1]};
        *(u32x4*)(rowp + 32 * d0) = w; }
#undef PK4Q
#undef Q8
}
__device__ __forceinline__ void softmax_tile(f32x16& p0, f32x16& p1, float& m_reg, float& l_reg, float& alpha, bf16x8& pa0, bf16x8& pa1, bf16x8& pa2, bf16x8& pa3) {
    float pmax = p0[0];
#pragma unroll
    for (int r = 1; r < 16; ++r) pmax = fmaxf(pmax, p0[r]);
#pragma unroll
    for (int r = 0; r < 16; ++r) pmax = fmaxf(pmax, p1[r]);
    { auto rr = __builtin_amdgcn_permlane32_swap(__float_as_uint(pmax), __float_as_uint(pmax), false, false);
      pmax = fmaxf(__uint_as_float(rr[0]), __uint_as_float(rr[1])); }
    float mn;
    if (__builtin_expect(__all(pmax - m_reg <= THR2), 1)) { mn = m_reg; alpha = 1.f; }
    else { mn = fmaxf(m_reg, pmax); alpha = __builtin_amdgcn_exp2f(m_reg - mn); m_reg = mn; }
    const f32x2 mn2 = {mn, mn}; f32x2 ps2a = {0.f, 0.f}, ps2b = {0.f, 0.f};
#pragma unroll
    for (int r = 0; r < 8; ++r) { f32x2 v = {p0[2 * r], p0[2 * r + 1]}; v = v - mn2; v[0] = __builtin_amdgcn_exp2f(v[0]); v[1] = __builtin_amdgcn_exp2f(v[1]); p0[2 * r] = v[0]; p0[2 * r + 1] = v[1]; ps2a += v; }
#pragma unroll
    for (int r = 0; r < 8; ++r) { f32x2 v = {p1[2 * r], p1[2 * r + 1]}; v = v - mn2; v[0] = __builtin_amdgcn_exp2f(v[0]); v[1] = __builtin_amdgcn_exp2f(v[1]); p1[2 * r] = v[0]; p1[2 * r + 1] = v[1]; ps2b += v; }
    ps2a += ps2b; float ps = ps2a[0] + ps2a[1];
    { auto rr = __builtin_amdgcn_permlane32_swap(__float_as_uint(ps), __float_as_uint(ps), false, false);
      ps = __uint_as_float(rr[0]) + __uint_as_float(rr[1]); }
    l_reg = l_reg * alpha + ps;
#define PK4(P, B_, OUT) do { unsigned a0 = cvt_pk_bf16(P[B_+0], P[B_+1]), a1 = cvt_pk_bf16(P[B_+2], P[B_+3]);                          \
        unsigned b0 = cvt_pk_bf16(P[B_+4], P[B_+5]), b1 = cvt_pk_bf16(P[B_+6], P[B_+7]);                                             \
        auto r0 = __builtin_amdgcn_permlane32_swap(a0, b0, false, false); auto r1 = __builtin_amdgcn_permlane32_swap(a1, b1, false, false); \
        u32x4 w = {r0[0], r1[0], r0[1], r1[1]}; OUT = *reinterpret_cast<bf16x8*>(&w); } while (0)
    PK4(p0, 0, pa0); PK4(p0, 8, pa1); PK4(p1, 0, pa2); PK4(p1, 8, pa3);
#undef PK4
}

struct AU {
    const bf16_t* Q; int ldq;
    const bf16_t* K; const bf16_t* V; int ldk;
    bf16_t* O; int ldo;
    float* lse;
    unsigned char* O8; float* sc;
    const float* cs;
    const float* relb;
    int hh;
    int v0;
    int Lm, Ls, dil;
    int kb0, NT;
};

__device__ __forceinline__ void pv_softmax(f32x16* o, const int vb, const bf16x8 q0, const bf16x8 q1, const bf16x8 q2, const bf16x8 q3,
                                           f32x16& p0, f32x16& p1, float& m_reg, float& l_reg, float& alpha, bf16x8& pa0, bf16x8& pa1, bf16x8& pa2, bf16x8& pa3) {
#define PVQ_D0(d0) do { constexpr int b_ = v_rd_off(d0, 0, 0); \
        const s16x4 l0 = vtr(vb + b_), h0 = vtr(vb + b_ + 2048), l1 = vtr(vb + b_ + 4096), h1 = vtr(vb + b_ + 6144), l2 = vtr(vb + b_ + 8192), h2 = vtr(vb + b_ + 10240), l3 = vtr(vb + b_ + 12288), h3 = vtr(vb + b_ + 14336); \
        o[d0] = __builtin_amdgcn_mfma_f32_32x32x16_bf16((bf16x8){l0[0], l0[1], l0[2], l0[3], h0[0], h0[1], h0[2], h0[3]}, q0, o[d0], 0, 0, 0);   \
        o[d0] = __builtin_amdgcn_mfma_f32_32x32x16_bf16((bf16x8){l1[0], l1[1], l1[2], l1[3], h1[0], h1[1], h1[2], h1[3]}, q1, o[d0], 0, 0, 0);   \
        o[d0] = __builtin_amdgcn_mfma_f32_32x32x16_bf16((bf16x8){l2[0], l2[1], l2[2], l2[3], h2[0], h2[1], h2[2], h2[3]}, q2, o[d0], 0, 0, 0);   \
        o[d0] = __builtin_amdgcn_mfma_f32_32x32x16_bf16((bf16x8){l3[0], l3[1], l3[2], l3[3], h3[0], h3[1], h3[2], h3[3]}, q3, o[d0], 0, 0, 0); } while (0)
    PVQ_D0(0); PVQ_D0(1); PVQ_D0(2); PVQ_D0(3);
#undef PVQ_D0
    float pmax = p0[0];
#pragma unroll
    for (int r = 1; r < 16; ++r) pmax = fmaxf(pmax, p0[r]);
#pragma unroll
    for (int r = 0; r < 16; ++r) pmax = fmaxf(pmax, p1[r]);
    { auto rr = __builtin_amdgcn_permlane32_swap(__float_as_uint(pmax), __float_as_uint(pmax), false, false);
      pmax = fmaxf(__uint_as_float(rr[0]), __uint_as_float(rr[1])); }
    const bool ok = __all(pmax - m_reg <= THR2);
    const float mn = ok ? m_reg : fmaxf(m_reg, pmax);
    alpha = __builtin_amdgcn_exp2f(m_reg - mn); m_reg = mn;
    const f32x2 mn2 = {mn, mn}; f32x2 ps2a = {0.f, 0.f}, ps2b = {0.f, 0.f};
#pragma unroll
    for (int r = 0; r < 8; ++r) { f32x2 v = {p0[2 * r], p0[2 * r + 1]}; v = v - mn2; v[0] = __builtin_amdgcn_exp2f(v[0]); v[1] = __builtin_amdgcn_exp2f(v[1]); p0[2 * r] = v[0]; p0[2 * r + 1] = v[1]; ps2a += v; }
#pragma unroll
    for (int r = 0; r < 8; ++r) { f32x2 v = {p1[2 * r], p1[2 * r + 1]}; v = v - mn2; v[0] = __builtin_amdgcn_exp2f(v[0]); v[1] = __builtin_amdgcn_exp2f(v[1]); p1[2 * r] = v[0]; p1[2 * r + 1] = v[1]; ps2b += v; }
    ps2a += ps2b; float ps = ps2a[0] + ps2a[1];
    { auto rr = __builtin_amdgcn_permlane32_swap(__float_as_uint(ps), __float_as_uint(ps), false, false);
      ps = __uint_as_float(rr[0]) + __uint_as_float(rr[1]); }
    l_reg = l_reg * alpha + ps;
#define PK4(P, B_, OUT) do { unsigned a0 = cvt_pk_bf16(P[B_+0], P[B_+1]), a1 = cvt_pk_bf16(P[B_+2], P[B_+3]);                          \
        unsigned b0 = cvt_pk_bf16(P[B_+4], P[B_+5]), b1 = cvt_pk_bf16(P[B_+6], P[B_+7]);                                             \
        auto r0 = __builtin_amdgcn_permlane32_swap(a0, b0, false, false); auto r1 = __builtin_amdgcn_permlane32_swap(a1, b1, false, false); \
        u32x4 w = {r0[0], r1[0], r0[1], r1[1]}; OUT = *reinterpret_cast<bf16x8*>(&w); } while (0)
    PK4(p0, 0, pa0); PK4(p0, 8, pa1); PK4(p1, 0, pa2); PK4(p1, 8, pa3);
#undef PK4
    __builtin_amdgcn_sched_group_barrier(0x100, 8, 0);
#pragma unroll
    for (int i = 0; i < 16; ++i) { __builtin_amdgcn_sched_group_barrier(0x008, 1, 0); __builtin_amdgcn_sched_group_barrier(0x002, 6, 0); __builtin_amdgcn_sched_group_barrier(0x400, 2, 0);
        __builtin_amdgcn_sched_group_barrier(0x100, 2, 0); }
}
template <int MODE>
__device__ __forceinline__ void attn_unit(LAS char* lds, const AU& u, const int wave0_) {
    constexpr int NKH = MODE == 2 ? 2 : 1;
    const int tid = opaque_tid(), wid = __builtin_amdgcn_readfirstlane(tid >> 6), lane = tid & 63, r32 = lane & 31, hi = lane >> 5;
    LAS char* V_lds = lds + V_OFF; LAS char* K_lds = lds + K_OFF;
    LAS float* tab = (LAS float*)(lds + TAB_OFF); LAS float* csl = (LAS float*)(lds + CSL_OFF);
    const int Lm = u.Lm, Ls = u.Ls, dil = u.dil;
#define TOKV(v) ((((v) & Lm) * dil) + ((v) >> Ls))
    const int vw = u.v0 + wid * 32, vq = vw + r32, qm = vq - 4 * hi;
    bf16x8 qr[8 * NKH];
    { const bf16_t* qp = u.Q + (size_t)TOKV(vq) * u.ldq + hi * 8;
#pragma unroll
      for (int d0 = 0; d0 < 8 * NKH; ++d0) qr[d0] = *(const bf16x8*)(qp + d0 * 16); }
    if (MODE == 0) {
        const int delta = tid - 160; float val = -__builtin_inff();
        if (delta >= 0 && delta <= 128) { const int dist = delta * dil; int bk = dist;
            if (dist >= 16) { bk = 16 + (int)(log2f((float)dist * 0.0625f) * (16.0f / 7.0f)); bk = bk > 31 ? 31 : bk; }
            val = u.relb[bk * 12] * LOG2E; }
        tab[tid] = val;
    }
    float m_reg = -1e30f, l_reg = 0.f; f32x16 o[4] = {};
    const int l4 = lane >> 4, kr0 = 8 * wid + l4, kc0 = ((lane & 15) ^ l4) * 8, kc1 = ((lane & 15) ^ (4 + l4)) * 8;
    const int vrow = swap23(8 * wid + ((lane & 31) >> 2)), vc0 = (lane >> 5) * 32 + (lane & 3) * 8;
    const int vb0 = (int)(uintptr_t)V_lds + v_rd_base(lane);
    float st_c = 0.f;
#define SLOAD(kbv, kbf, vbf) do { int a0_ = (kbv) + kr0, a1_ = a0_ + 4, av_ = (kbv) + vrow; a0_ = a0_ < 0 ? 0 : a0_; a1_ = a1_ < 0 ? 0 : a1_; av_ = av_ < 0 ? 0 : av_; \
        const bf16_t* k0_ = u.K + (size_t)TOKV(a0_) * u.ldk + kc0; const bf16_t* k1_ = u.K + (size_t)TOKV(a1_) * u.ldk + kc1; const bf16_t* v0_ = u.V + (size_t)TOKV(av_) * u.ldk + vc0; \
        LAS char* kd_ = K_lds + (kbf) * (NKH * SHM_K) + wid * 2048; LAS char* vd_ = V_lds + (vbf) * SHM_V + wid * 2048; \
        GLDS(k0_, kd_); GLDS(k1_, kd_ + 1024); if (NKH == 2) { GLDS(k0_ + 128, kd_ + SHM_K); GLDS(k1_ + 128, kd_ + SHM_K + 1024); } \
        GLDS(v0_, vd_); GLDS(v0_ + 64, vd_ + 1024); \
        if (MODE == 1) { if (tid < 64) st_c = u.cs[(kbv) + tid]; } } while (0)
#define SWRITE(kbf) do { if (MODE == 1) { if (tid < 64) csl[(kbf) * 64 + tid] = -st_c; } } while (0)
#define RESC(a) do { if (__any((a) < 1.f)) { _Pragma("unroll") for (int d_ = 0; d_ < 4; ++d_) _Pragma("unroll") for (int r = 0; r < 16; ++r) o[d_][r] *= (a); } } while (0)
    const bool need_lim = MODE == 0 && (vw & Lm) < 128; const int lim = vq & Lm;
    f32x16 p0, p1; bf16x8 pa0, pa1, pa2, pa3; float alpha;
    bf16x8 q0, q1, q2, q3;
    SLOAD(u.kb0, 0, 0); VM_WAIT(); SWRITE(0);
#pragma unroll
    for (int d0 = 0; d0 < 8 * NKH; ++d0) asm volatile("" :: "v"(qr[d0]));
    __syncthreads();
    bool act_prev = false; int vcur = 0, vprev = 0;
    for (int t = 0; t < u.NT; ++t) {
        int kbo_ = u.kb0 + 64 * t; asm volatile("" : "+s"(kbo_)); const int kb_ = kbo_;
        const int kbf = t & 1, vnext = vcur == 2 ? 0 : vcur + 1; const bool HN = t + 1 < u.NT;
        if (HN) SLOAD(kb_ + 64, kbf ^ 1, vnext);
        bool act_ = true;
        if (MODE == 0) act_ = (kb_ <= vw + 31) && (kb_ + 63 >= vw - 128);
        if (MODE == 1) act_ = (kb_ <= vw + 31);
        if (act_) {
            SBAR();
            if (MODE == 1) { const LAS f32x4* cp_ = (const LAS f32x4*)(csl + kbf * 64 + 4 * hi);
#pragma unroll
                for (int g_ = 0; g_ < 4; ++g_) { const f32x4 c0_ = cp_[2 * g_], c1_ = cp_[2 * g_ + 8];
#pragma unroll
                    for (int i_ = 0; i_ < 4; ++i_) { p0[4 * g_ + i_] = c0_[i_]; p1[4 * g_ + i_] = c1_[i_]; } }
                qkt<true>(p0, p1, K_lds + kbf * (NKH * SHM_K), r32, hi, qr); }
            else qkt<false>(p0, p1, K_lds + kbf * (NKH * SHM_K), r32, hi, qr);
            if (NKH == 2) qkt<true>(p0, p1, K_lds + kbf * (NKH * SHM_K) + SHM_K, r32, hi, qr + 8);
            const int dq_ = qm - kb_;
            if (MODE == 0) { const LAS float* tb_ = tab + (dq_ + 101);
#pragma unroll
                for (int r = 0; r < 16; ++r) { const int c_ = (r & 3) + 8 * (r >> 2); p0[r] += tb_[59 - c_]; p1[r] += tb_[27 - c_]; }
                if (need_lim) {
#pragma unroll
                    for (int r = 0; r < 16; ++r) { const int c_ = (r & 3) + 8 * (r >> 2);
                        if (dq_ - c_ > lim) p0[r] = -__builtin_inff(); if (dq_ - c_ - 32 > lim) p1[r] = -__builtin_inff(); } } }
            if (MODE == 1) {
                if (kb_ + 63 > vw) {
#pragma unroll
                    for (int r = 0; r < 16; ++r) { const int c_ = (r & 3) + 8 * (r >> 2);
                        if (dq_ - c_ < 0) p0[r] = -__builtin_inff(); if (dq_ - c_ - 32 < 0) p1[r] = -__builtin_inff(); } } }
            SBAR();
            if (act_prev) pv_softmax(o, vb0 + vprev * SHM_V, q0, q1, q2, q3, p0, p1, m_reg, l_reg, alpha, pa0, pa1, pa2, pa3);
            else softmax_tile(p0, p1, m_reg, l_reg, alpha, pa0, pa1, pa2, pa3);
            SBAR(); RESC(alpha); SBAR();
            q0 = pa0; q1 = pa1; q2 = pa2; q3 = pa3;
        } else if (act_prev) { SBAR(); pv_tile(o, vb0 + vprev * SHM_V, q0, q1, q2, q3); SBAR(); }
        if (HN) { VM_WAIT(); SWRITE(kbf ^ 1); }
        __syncthreads();
        act_prev = act_; vprev = vcur; vcur = vnext;
    }
    if (act_prev) { SBAR(); pv_tile(o, vb0 + vprev * SHM_V, q0, q1, q2, q3); }
    if (MODE == 0) { if (hi == 0) u.lse[(size_t)TOKV(vq) * 12] = m_reg + log2f(l_reg); }
    if (MODE == 0) store_o_rows(u.O + (size_t)TOKV(vq) * u.ldo + 8 * hi, o, __builtin_amdgcn_rcpf(l_reg));
    else store_o_rows_u8(u.O8 + (size_t)TOKV(vq) * DM + 16 * hi, u.sc + (size_t)TOKV(vq) * 16, hi, o, __builtin_amdgcn_rcpf(l_reg));
    __syncthreads();
#undef TOKV
#undef SLOAD
#undef SWRITE
#undef RESC
}
constexpr int A2_GRP = 65536, A2_WS = 132096, A2_TAB = 134144;
template <class Gen>
__device__ __forceinline__ void attn_a2_stream(LAS char* lds, const int NU, const Gen& gen, const float* relb_g, const int wave0_) {
    const int tid = opaque_tid(), wid = __builtin_amdgcn_readfirstlane(tid >> 6), lane = tid & 63, r32 = lane & 31, hi = lane >> 5;
    const int grp = wid >> 2;
    LAS char* V_lds = lds + grp * A2_GRP; LAS char* K_lds = V_lds + 32768;
    const int wg = wid & 3, l4 = lane >> 4, kr0 = 16 * wg + l4, kc0 = ((lane & 15) ^ l4) * 8, kc1 = ((lane & 15) ^ (4 + l4)) * 8;
    const int vr0 = swap23(16 * wg + ((lane & 31) >> 2)), vr1 = swap23(16 * wg + 8 + ((lane & 31) >> 2)), vc0 = (lane >> 5) * 32 + (lane & 3) * 8;
    const int vb0 = (int)(uintptr_t)V_lds + v_rd_base(lane);
#define TOKU(U, v) ((((v) & (U).Lm) * (U).dil) + ((v) >> (U).Ls))
#define SLOADU(U, kbv, bf) do { LAS char* kd_ = K_lds + (bf) * SHM_K + wg * 4096; LAS char* vd_ = V_lds + (bf) * SHM_V + wg * 4096; \
        _Pragma("unroll") for (int i_ = 0; i_ < 4; ++i_) { int a_ = (kbv) + kr0 + 4 * i_; a_ = a_ < 0 ? 0 : a_; GLDS((U).K + (size_t)TOKU(U, a_) * (U).ldk + ((i_ & 1) ? kc1 : kc0), kd_ + i_ * 1024); } \
        _Pragma("unroll") for (int h_ = 0; h_ < 2; ++h_) { int a_ = (kbv) + (h_ ? vr1 : vr0); a_ = a_ < 0 ? 0 : a_; const bf16_t* p_ = (U).V + (size_t)TOKU(U, a_) * (U).ldk + vc0; \
            GLDS(p_, vd_ + h_ * 2048); GLDS(p_ + 64, vd_ + h_ * 2048 + 1024); } } while (0)
#define LOADQU(U) do { const bf16_t* qp_ = (U).Q + (size_t)TOKU(U, (U).v0 + wid * 32 + r32) * (U).ldq + hi * 8; \
        _Pragma("unroll") for (int d0 = 0; d0 < 8; ++d0) qr[d0] = *(const bf16x8*)(qp_ + d0 * 16); } while (0)
#define TABU(U, tb) do { const int delta = tid - 160; float val = -__builtin_inff();          \
        if (delta >= 0 && delta <= 128) { const int dist = delta * (U).dil; int bk = dist; \
            if (dist >= 16) { bk = 16 + (int)(log2f((float)dist * 0.0625f) * (16.0f / 7.0f)); bk = bk > 31 ? 31 : bk; } \
            val = relb_l[bk * 12 + (U).hh] * LOG2E; } \
        ((LAS float*)(lds + A2_TAB))[(tb) * 512 + tid] = val; } while (0)
#define RESC(a) do { if (__any((a) < 1.f)) { _Pragma("unroll") for (int d_ = 0; d_ < 4; ++d_) _Pragma("unroll") for (int r = 0; r < 16; ++r) o[d_][r] *= (a); } } while (0)
    AU u; gen(0, u);
    LAS float* relb_l = (LAS float*)(lds + A2_TAB) + 1024;
    if (tid < 384) relb_l[tid] = relb_g[tid];
    __syncthreads();
    bf16x8 qr[8];
    LOADQU(u); TABU(u, 0); SLOADU(u, u.kb0 + 128 * grp + ((grp != 0 && u.NT == 4) ? 128 : 0), 0);
    for (int iu = 0; iu < NU; ++iu) {
        const bool hasn = iu + 1 < NU; AU un = u; if (hasn) gen(iu + 1, un);
        const LAS float* tab = (const LAS float*)(lds + A2_TAB) + (iu & 1) * 512;
        const int Lm = u.Lm;
        const int vw = u.v0 + wid * 32, vq = vw + r32, qm = vq - 4 * hi;
        const int cstart = vw - (vw & Lm);
        const bool need_lim = (vw & Lm) < 128; const int lim = vq & Lm;
        const int kbg = u.kb0 + 128 * grp;
        const int ntm = u.NT - 1, rot = (grp != 0 && u.NT == 4) ? 2 : 0;
        float m_reg = -1e30f, l_reg = 0.f; f32x16 o[4] = {};
        f32x16 p0, p1; bf16x8 pa0, pa1, pa2, pa3; float alpha;
        VM_WAIT();
#pragma unroll
        for (int d0 = 0; d0 < 8; ++d0) asm volatile("" :: "v"(qr[d0]));
        __syncthreads();
#define TILE2(t, BF, LAST) do { int kbo_ = kbg + 64 * (((t) + rot) & ntm); asm volatile("" : "+s"(kbo_)); const int kb_ = kbo_; \
        const bool shr_ = rot != 0 && (t) >= 2;                       \
        const LAS char* kimg_ = (shr_ ? lds + 32768 : K_lds) + (BF) * SHM_K; const int vimg_ = (shr_ ? vb0 - A2_GRP : vb0) + (BF) * SHM_V; \
        if (!(LAST)) { if (!(rot != 0 && (t) + 1 >= 2)) SLOADU(u, kbg + 64 * (((t) + 1 + rot) & ntm), (BF) ^ 1); } \
        else if (hasn) SLOADU(un, un.kb0 + 128 * grp + ((grp != 0 && un.NT == 4) ? 128 : 0), 0); \
        const bool act_ = (kb_ <= vw + 31) && (kb_ + 63 >= vw - 128) && (kb_ + 63 >= cstart); \
        if (act_) { \
            const int dq_ = qm - kb_; SBAR(); \
            { const LAS float* tb_ = tab + (dq_ + 101);                \
              _Pragma("unroll") for (int r = 0; r < 16; ++r) { const int c_ = (r & 3) + 8 * (r >> 2); p0[r] = tb_[59 - c_]; p1[r] = tb_[27 - c_]; } \
              qkt<true>(p0, p1, kimg_, r32, hi, qr); \
              if (need_lim) { _Pragma("unroll") for (int r = 0; r < 16; ++r) { const int c_ = (r & 3) + 8 * (r >> 2); \
                  if (dq_ - c_ > lim) p0[r] = -__builtin_inff(); if (dq_ - c_ - 32 > lim) p1[r] = -__builtin_inff(); } } } } \
        if ((LAST) && hasn) { SBAR(); LOADQU(un); TABU(un, (iu + 1) & 1); SBAR(); } \
        if (act_) { \
            SBAR(); softmax_tile(p0, p1, m_reg, l_reg, alpha, pa0, pa1, pa2, pa3); \
            RESC(alpha); SBAR(); \
            pv_tile(o, vimg_, pa0, pa1, pa2, pa3); } \
        if (!(LAST)) { VM_WAIT(); __syncthreads(); } } while (0)
        int t = 0;
        for (; t + 2 < u.NT; t += 2) { TILE2(t, 0, false); TILE2(t + 1, 1, false); }
        TILE2(t, 0, false); TILE2(t + 1, 1, true);
#undef TILE2
        if (hi == 0) u.lse[(size_t)TOKU(u, vq) * 12] = m_reg + log2f(l_reg);
        {
          const float rl_ = __builtin_amdgcn_rcpf(l_reg); float am = 0.f;
#pragma unroll
          for (int d_ = 0; d_ < 4; ++d_)
#pragma unroll
            for (int r = 0; r < 16; ++r) am = fmaxf(am, fabsf(o[d_][r]));
          am *= rl_;
          { auto rr = __builtin_amdgcn_permlane32_swap(__float_as_uint(am), __float_as_uint(am), false, false); am = fmaxf(__uint_as_float(rr[0]), __uint_as_float(rr[1])); }
          const float k_ = am > 0.f ? rl_ * 127.f * __builtin_amdgcn_rcpf(am) : 0.f;
          if (hi == 0) u.sc[(size_t)TOKU(u, vq) * 12] = am * (1.f / 127.f);
          unsigned char* rowp = u.O8 + (size_t)TOKU(u, vq) * u.ldo + 16 * hi;
#define Q8(x) __builtin_fmaf((x), k_, 128.f)
#define PK4Q(d0, g) __builtin_amdgcn_cvt_pk_u8_f32(Q8(o[d0][4 * (g) + 3]), 3, __builtin_amdgcn_cvt_pk_u8_f32(Q8(o[d0][4 * (g) + 2]), 2, __builtin_amdgcn_cvt_pk_u8_f32(Q8(o[d0][4 * (g) + 1]), 1, __builtin_amdgcn_cvt_pk_u8_f32(Q8(o[d0][4 * (g)]), 0, 0u))))
#pragma unroll
          for (int d0 = 0; d0 < 4; ++d0) { const unsigned W0 = PK4Q(d0, 0), W1 = PK4Q(d0, 1), W2 = PK4Q(d0, 2), W3 = PK4Q(d0, 3);
              auto r0 = __builtin_amdgcn_permlane32_swap(W0, W2, false, false); auto r1 = __builtin_amdgcn_permlane32_swap(W1, W3, false, false);
              const u32x4 w = {r0[0], r0[1], r1[0], r1[1]};
              *(u32x4*)(rowp + 32 * d0) = w; }
#undef PK4Q
#undef Q8
        }
        u = un;
    }
    __syncthreads();
#undef TOKU
#undef SLOADU
#undef LOADQU
#undef TABU
#undef RESC
}
}

__device__ __forceinline__ unsigned f2bf(float f) { unsigned u = __builtin_bit_cast(unsigned, f); return (u + 0x7fffu + ((u >> 16) & 1u)) >> 16; }
__device__ __forceinline__ unsigned pk2(float lo, float hi) { return f2bf(lo) | (f2bf(hi) << 16); }
__device__ __forceinline__ float wave_sum(float v) {
    v += dpp_f<0xB1>(v); v += dpp_f<0x4E>(v);
    v += dpp_f<0x141>(v); v += dpp_f<0x140>(v);
    v = xor16_add(v); v = xor32_add(v);
    return v;
}
struct TrItem { const float* wp; size_t rs; bf16_t* dp; int ldt; };
__device__ __forceinline__ void tr_load(const TrItem& t, f32x4 (&v)[8]) {
#pragma unroll
    for (int i = 0; i < 8; ++i) v[i] = *(const f32x4*)(t.wp + (size_t)(8 * i) * t.rs);
}
__device__ __forceinline__ void tr_store(const TrItem& t, const f32x4 (&v)[8], LAS float* scr, int lane) {
    const int r = lane >> 3, c4 = lane & 7;
#pragma unroll
    for (int i = 0; i < 8; ++i) { LAS float* d = scr + (8 * i + r) * 33 + 4 * c4; d[0] = v[i][0]; d[1] = v[i][1]; d[2] = v[i][2]; d[3] = v[i][3]; }
    LDS_WAIT(); asm volatile("" ::: "memory");
    const int c = lane & 7;
#pragma unroll
    for (int j = 0; j < 4; ++j) { const int n = (lane >> 3) + 8 * j; const LAS float* s = scr + (8 * c) * 33 + n;
        u32x4 o; o.x = pk2(s[0 * 33], s[1 * 33]); o.y = pk2(s[2 * 33], s[3 * 33]); o.z = pk2(s[4 * 33], s[5 * 33]); o.w = pk2(s[6 * 33], s[7 * 33]);
        *(u32x4*)(t.dp + (size_t)(8 * j) * t.ldt) = o; }
    LDS_WAIT(); asm volatile("" ::: "memory");
}
struct Args { const float* in[19]; float* out; unsigned char* ws; int ph_lo, ph_hi; };
typedef __attribute__((address_space(4))) const Args* KArgP;
__device__ __forceinline__ KArgP fresh_args() { KArgP p = (KArgP)__builtin_amdgcn_kernarg_segment_ptr(); asm volatile("" : "+s"(p)); return p; }

__device__ __forceinline__ TrItem tr_decode(KArgP args, unsigned char* ws, int lane, int it) {
    const float* w_in = args->in[4];
    int r = it; const float* src; int ldw, ldt, nkb; bf16_t* dst;
    if (r < 4608) { src = w_in + 0; ldw = INC; dst = (bf16_t*)(ws + WS_WT1); ldt = DM; nkb = 32; }
    else if ((r -= 4608) < 1536) { src = w_in + 4608; ldw = INC; dst = (bf16_t*)(ws + WS_WT2); ldt = DM; nkb = 32; }
    else if ((r -= 1536) < 3072) { src = w_in + 6144; ldw = INC; dst = (bf16_t*)(ws + WS_WT1) + (size_t)4608 * DM; ldt = DM; nkb = 32; }
    else if ((r -= 3072) < 1024) { src = w_in + 9216; ldw = INC; dst = (bf16_t*)(ws + WS_WT2) + (size_t)1536 * DM; ldt = DM; nkb = 32; }
    else if ((r -= 1024) < 1024) { src = w_in + 10248; ldw = INC; dst = (bf16_t*)(ws + WS_WT1) + (size_t)7680 * DM; ldt = DM; nkb = 32; }
    else if ((r -= 1024) < 1024) { src = w_in + 11272; ldw = INC; dst = (bf16_t*)(ws + WS_WT2) + (size_t)2560 * DM; ldt = DM; nkb = 32; }
    else if ((r -= 1024) < 6144) { src = w_in + 12296; ldw = INC; dst = (bf16_t*)(ws + WS_WT2) + (size_t)3584 * DM; ldt = DM; nkb = 32; }
    else if ((r -= 6144) < 2048) { src = args->in[14]; ldw = 2048; dst = (bf16_t*)(ws + WS_WTKV); ldt = DM; nkb = 32; }
    else if ((r -= 2048) < 1536) { src = args->in[15]; ldw = DM; dst = (bf16_t*)(ws + WS_WTP); ldt = KP; nkb = 24; }
    else if ((r -= 1536) < 1024) { src = args->in[16]; ldw = DM; dst = (bf16_t*)(ws + WS_WTP) + 1536; ldt = KP; nkb = 16; }
    else if ((r -= 1024) < 1024) { src = args->in[17]; ldw = DM; dst = (bf16_t*)(ws + WS_WTP) + 2560; ldt = KP; nkb = 16; }
    else { r -= 1024; src = args->in[18]; ldw = DM; dst = (bf16_t*)(ws + WS_WTO); ldt = DM; nkb = 32; }
    const int nb = r / nkb, kb = r - nb * nkb, k0 = 64 * kb, n0 = 32 * nb;
    TrItem t; t.wp = src + (size_t)(k0 + (lane >> 3)) * ldw + n0 + 4 * (lane & 7); t.rs = (size_t)ldw;
    t.dp = dst + (size_t)(n0 + (lane >> 3)) * ldt + k0 + 8 * (lane & 7); t.ldt = ldt; return t;
}
#define TR_LD(V, T, idx) do { if ((idx) < tot_) { T = tr_decode(args, ws, lane, MAP_((idx))); tr_load(T, V); } } while (0)
#define TR_STREAM(first, total, stride, MAPF) do { const int tot_ = (total), st_ = (stride); int j_ = (first); \
        f32x4 va_[8], vb_[8], vc_[8], vd_[8]; TrItem ta_, tb_, tc_, td_; ta_.wp = nullptr; tb_ = ta_; tc_ = ta_; td_ = ta_; \
        auto MAP_ = [](int q_) { return MAPF(q_); }; \
        TR_LD(va_, ta_, j_); TR_LD(vb_, tb_, j_ + st_); TR_LD(vc_, tc_, j_ + 2 * st_); \
        while (j_ < tot_) { \
            TR_LD(vd_, td_, j_ + 3 * st_); tr_store(ta_, va_, scr, lane); j_ += st_; if (j_ >= tot_) break; \
            TR_LD(va_, ta_, j_ + 3 * st_); tr_store(tb_, vb_, scr, lane); j_ += st_; if (j_ >= tot_) break; \
            TR_LD(vb_, tb_, j_ + 3 * st_); tr_store(tc_, vc_, scr, lane); j_ += st_; if (j_ >= tot_) break; \
            TR_LD(vc_, tc_, j_ + 3 * st_); tr_store(td_, vd_, scr, lane); j_ += st_; } } while (0)
__device__ __forceinline__ int map_p0(int r) { if (r < 4608) return r; if ((r -= 4608) < 3072) return 6144 + r; if ((r -= 3072) < 1024) return 10240 + r; return 18432 + (r - 1024); }
__device__ __forceinline__ int map_p1(int r) { if (r < 1536) return 4608 + r; if ((r -= 1536) < 1024) return 9216 + r; if ((r -= 1024) < 1024) return 11264 + r; return 12288 + (r - 1024); }
__device__ __forceinline__ int map_p3(int r) { return 20480 + r; }
constexpr int P1_SIDE = 5632;
__device__ __forceinline__ int map_p1b(int r) { return map_p1(P1_SIDE + r); }
__global__ void __launch_bounds__(512, 2) fwd_kernel(Args args_) {
    extern __shared__ __attribute__((aligned(16))) unsigned char lds_raw[];
    LAS unsigned char* lds = (LAS unsigned char*)lds_raw;
    volatile LAS unsigned* MISC = (volatile LAS unsigned*)(lds + MISC_OFF);
    const int wave0_ = __builtin_amdgcn_readfirstlane((int)threadIdx.x >> 6);
    const int G = gridDim.x; const int bx = blockIdx.x; const int vcu = (G % 8 == 0) ? (bx % 8) * (G / 8) + bx / 8 : bx;
    gu32* ctl = (gu32*)(fresh_args()->ws + WS_CTL);
    for (int i = threadIdx.x; i < (LDS_BYTES - LDSCTL_OFF) / 4; i += 512) ((LAS unsigned*)(lds + LDSCTL_OFF))[i] = 0u;
    __syncthreads();
    XcdBarrier bar; bar.bar = (unsigned*)(ctl + 4096); bar.x = 0; bar.st = nullptr;
    const int lo = fresh_args()->ph_lo, hi_ = fresh_args()->ph_hi;
    const bool one_launch = (hi_ - lo) > 1;
    if (one_launch) bar = xcd_barrier_post((unsigned*)(ctl + 4096), MISC + 8, wave0_);
#ifndef ATT_DUP
#define ATT_DUP 0
#endif
#ifndef ATT_MASK
#define ATT_MASK 7
#endif
#ifndef PH_MASK
#define PH_MASK 63
#endif
#define IN(k) (((PH_MASK >> (k)) & 1) && lo <= (k) && (k) < hi_)
#define BOTH(k) (IN(k) && IN((k) + 1))
#define GRID_BAR() xcd_barrier(bar, wave0_)

    if (IN(0)) {
        const KArgP args = fresh_args(); unsigned char* ws = args->ws; const float* x = args->in[0];
        const int tid = opaque_tid(), lane = tid & 63, wave = __builtin_amdgcn_readfirstlane(tid >> 6);
        LAS float* scr = (LAS float*)(lds + wave * 16384);
        const int gw = vcu * 8 + wave, NGW = G * 8;
        const float* w_in = args->in[4];
        TR_STREAM(gw, 10752, NGW, map_p0);
        __syncthreads();
        LAS float* wfT = (LAS float*)lds;
        { f32x4 wa[4], wb[4];
#pragma unroll
          for (int j = 0; j < 4; ++j) { const float* p = w_in + (size_t)(tid + 512 * j) * INC + 10240; wa[j] = *(const f32x4*)p; wb[j] = *(const f32x4*)(p + 4); }
#pragma unroll
          for (int j = 0; j < 4; ++j) { const int k = tid + 512 * j;
#pragma unroll
              for (int e = 0; e < 4; ++e) { wfT[e * DM + k] = wa[j][e]; wfT[(4 + e) * DM + k] = wb[j][e]; } } }
        __syncthreads();
        const float* ng = args->in[2]; const float* bfg = args->in[5];
        { const int lane_h = opaque_tid() & 63;
#define lane lane_h
        bf16_t* H = (bf16_t*)(ws + WS_H); float* F = (float*)(ws + WS_F);
#pragma unroll 1
        for (int m = gw; m < TOK; m += NGW) {
            const f32x4* xr = (const f32x4*)(x + (size_t)m * DM) + lane;
            f32x4 v[8]; float s = 0.f;
#pragma unroll
            for (int j = 0; j < 8; ++j) { v[j] = xr[64 * j]; s += (v[j][0] * v[j][0] + v[j][1] * v[j][1]) + (v[j][2] * v[j][2] + v[j][3] * v[j][3]); }
            const float rstd = 1.0f / sqrtf(wave_sum(s) * (1.f / DM) + EPS);
            u32x2* o8 = (u32x2*)(H + (size_t)m * DM) + lane;
#pragma unroll
            for (int j = 0; j < 8; ++j) { const f32x4 gj = *((const f32x4*)ng + lane + 64 * j); v[j] = (v[j] * rstd) * gj;
                u32x2 w; w.x = pk2(v[j][0], v[j][1]); w.y = pk2(v[j][2], v[j][3]); o8[64 * j] = w; }
            float fb[8];
#pragma unroll
            for (int hh = 0; hh < 8; ++hh) fb[hh] = 0.f;
#pragma unroll
            for (int j = 0; j < 8; ++j) {
#pragma unroll
                for (int hh = 0; hh < 8; ++hh) { const f32x4 w4 = *((const LAS f32x4*)(wfT + hh * DM) + lane + 64 * j); fb[hh] += (v[j][0] * w4[0] + v[j][1] * w4[1]) + (v[j][2] * w4[2] + v[j][3] * w4[3]); }
                asm volatile("" ::: "memory"); }
#pragma unroll
            for (int hh = 0; hh < 8; ++hh) { fb[hh] = wave_sum(fb[hh]); __builtin_amdgcn_sched_barrier(0); }
            if (lane < 8) { float f = fb[0];
#pragma unroll
                for (int hh = 1; hh < 8; ++hh) f = lane == hh ? fb[hh] : f;
                const float xx = f + bfg[lane]; F[(size_t)m * 8 + lane] = fminf(xx, 0.f) - log1pf(expf(-fabsf(xx))); }
        }
#undef lane
        }
        const float* mem = args->in[1]; const float* mg = args->in[3]; bf16_t* MH = (bf16_t*)(ws + WS_MH);
        { const int lane_m = opaque_tid() & 63;
#define lane lane_m
#pragma unroll 1
        for (int m = gw; m < NB * MEML; m += NGW) {
            const f32x4* xr = (const f32x4*)(mem + (size_t)m * DM) + lane;
            f32x4 v[8]; float s = 0.f;
#pragma unroll
            for (int j = 0; j < 8; ++j) { v[j] = xr[64 * j]; s += (v[j][0] * v[j][0] + v[j][1] * v[j][1]) + (v[j][2] * v[j][2] + v[j][3] * v[j][3]); }
            const float rstd = 1.0f / sqrtf(wave_sum(s) * (1.f / DM) + EPS);
            u32x2* o8 = (u32x2*)(MH + (size_t)m * DM) + lane;
#pragma unroll
            for (int j = 0; j < 8; ++j) { const f32x4 gj = *((const f32x4*)mg + lane + 64 * j); v[j] = (v[j] * rstd) * gj;
                u32x2 w; w.x = pk2(v[j][0], v[j][1]); w.y = pk2(v[j][2], v[j][3]); o8[64 * j] = w; }
        }
#undef lane
        }
        if (BOTH(0)) xcd_barrier_arrive(bar, wave0_); else __syncthreads();
        { const KArgP args = fresh_args(); unsigned char* ws = args->ws;
          const int tid = opaque_tid(), lane = tid & 63, wave = __builtin_amdgcn_readfirstlane(tid >> 6);
          LAS float* scr = (LAS float*)(lds + wave * 16384);
          TR_STREAM(vcu * 8 + wave, 9728 - P1_SIDE, G * 8, map_p1b); }
        if (BOTH(0)) xcd_barrier_wait(bar, wave0_); else __syncthreads();
    }

    if (IN(1)) {
        const KArgP args = fresh_args(); unsigned char* ws = args->ws;
        if (bx >= 192 && bx < 256) {                 const int tid = opaque_tid(), lane = tid & 63, wave = __builtin_amdgcn_readfirstlane(tid >> 6);
            const int j = bx - 192, b = j >> 3, hh = j & 7;
            const float* F = (const float*)(ws + WS_F) + ((size_t)b * SEQ) * 8 + hh; float* CS = (float*)(ws + WS_CS) + (size_t)j * SEQ;
            LAS float* wt = (LAS float*)lds;
            float a0 = F[(size_t)(4 * tid + 0) * 8], a1 = F[(size_t)(4 * tid + 1) * 8], a2 = F[(size_t)(4 * tid + 2) * 8], a3 = F[(size_t)(4 * tid + 3) * 8];
            a1 += a0; a2 += a1; a3 += a2;
            float sc = a3;
#pragma unroll
            for (int o = 1; o < 64; o <<= 1) { const float t = __shfl_up(sc, o); if (lane >= o) sc += t; }
            if (lane == 63) wt[wave] = sc;
            __syncthreads();
            float base = 0.f;
            for (int w = 0; w < wave; ++w) base += wt[w];
            const float ex = base + sc - a3;
            CS[4 * tid + 0] = (ex + a0) * LOG2E; CS[4 * tid + 1] = (ex + a1) * LOG2E; CS[4 * tid + 2] = (ex + a2) * LOG2E; CS[4 * tid + 3] = (ex + a3) * LOG2E;
            __syncthreads();
            { LAS float* scr = (LAS float*)(lds + wave * 16384);
              TR_STREAM((bx - 192) * 8 + wave, P1_SIDE, 512, map_p1); }
            __syncthreads();
        }
        EpiQKV E; E.ws = ws; E.gains[0] = args->in[8]; E.gains[1] = args->in[9]; E.gains[2] = args->in[10]; E.gains[3] = args->in[11]; E.gains[4] = args->in[12]; E.gains[5] = args->in[13]; E.lds = lds;
        { E.which = 0; pg8::Gemm g{(const bf16_t*)(ws + WS_H), (const bf16_t*)(ws + WS_WT1), DM, DM}; pg8::StaticOrder S; S.init(TOK, N1, DM, G, bx);
          pg8::gemm_phase<EpiQKV, pg8::StaticOrder>(lds, g, S, E, wave0_); }
        { E.which = 1; pg8::Gemm g{(const bf16_t*)(ws + WS_MH), (const bf16_t*)(ws + WS_WTKV), DM, DM}; pg8::StaticOrder S; S.init(NB * MEML, 2048, DM, G, (bx + 128) % G);
          pg8::gemm_phase<EpiQKV, pg8::StaticOrder>(lds, g, S, E, wave0_); }
        if (BOTH(1)) GRID_BAR();
    }

    if (IN(2)) {
        const KArgP args = fresh_args(); unsigned char* ws = args->ws;
        LAS char* al = (LAS char*)lds;
        const float* CS = (const float*)(ws + WS_CS);
        for (int v = vcu; v < 256; v += G) {
            { const int bh = v >> 2, s = v & 3, b = bh >> 3, h = bh & 7;
              for (int pass = 0; pass < 2; ++pass) { const int qb = pass ? 7 - s : s;
                  att::AU u; u.Q = (const bf16_t*)(ws + WS_QB) + (size_t)b * SEQ * BW + h * 128; u.ldq = BW;
                  u.K = (const bf16_t*)(ws + WS_KB) + (size_t)b * SEQ * BW + h * 128; u.V = (const bf16_t*)(ws + WS_VB) + (size_t)b * SEQ * BW + h * 128; u.ldk = BW;
                  u.O = (bf16_t*)(ws + WS_Y) + (size_t)b * SEQ * KP + AW + h * 128; u.ldo = KP; u.lse = nullptr; u.cs = CS + (size_t)(b * 8 + h) * SEQ; u.relb = nullptr;
                  u.O8 = (unsigned char*)args->out + 72 * MiB + (size_t)b * SEQ * DM + h * 128; u.sc = (float*)(ws + WS_OA2 + 36 * MiB) + (size_t)b * SEQ * 16 + h;
                  u.v0 = qb * 256; u.Lm = 0x3fffffff; u.Ls = 30; u.dil = 1; u.kb0 = 0; u.NT = 4 * (qb + 1);
                  if (ATT_MASK & 1) att::attn_unit<1>(al, u, wave0_);
                  if (ATT_DUP & 1) att::attn_unit<1>(al, u, wave0_); } }
            { const int b = v >> 5, h = (v >> 3) & 3, qb = v & 7;
              for (int e = 0; e < 2; ++e) {
                  att::AU u; u.Q = (const bf16_t*)(ws + WS_QM) + (size_t)b * SEQ * MW + h * 256; u.ldq = MW;
                  u.K = (const bf16_t*)(ws + WS_KM) + (size_t)b * MEML * MW + h * 256; u.V = (const bf16_t*)(ws + WS_VM) + (size_t)b * MEML * MW + h * 256 + e * 128; u.ldk = MW;
                  u.O = (bf16_t*)(ws + WS_Y) + (size_t)b * SEQ * KP + AW + BW + h * 256 + e * 128; u.ldo = KP; u.lse = nullptr; u.cs = nullptr; u.relb = nullptr;
                  u.O8 = (unsigned char*)args->out + 72 * MiB + (size_t)b * SEQ * DM + 1024 + h * 256 + e * 128; u.sc = (float*)(ws + WS_OA2 + 36 * MiB) + (size_t)b * SEQ * 16 + 8 + h * 2 + e;
                  u.v0 = qb * 256; u.Lm = 0x3fffffff; u.Ls = 30; u.dil = 1; u.kb0 = 0; u.NT = 4;
                  if (ATT_MASK & 2) att::attn_unit<2>(al, u, wave0_);
                  if (ATT_DUP & 2) att::attn_unit<2>(al, u, wave0_); } }
            { float* const outp = args->out; const float* const relbp = args->in[7];
              auto genA = [=](int i, att::AU& u) {
                const int b = v >> 5, w_ = 32 * i + (v & 31), h = w_ / 24, rem_ = w_ - 24 * h, pat = rem_ >> 3, vb = rem_ & 7;
                u.Q = (const bf16_t*)(ws + WS_QA) + (size_t)b * SEQ * AW + h * 128; u.ldq = AW;
                u.K = (const bf16_t*)(ws + WS_KA) + (size_t)b * SEQ * AW + h * 128; u.V = (const bf16_t*)(ws + WS_VA) + (size_t)b * SEQ * AW + h * 128; u.ldk = AW;
                bf16_t* ob = pat == 0 ? (bf16_t*)outp : (pat == 1 ? (bf16_t*)outp + (size_t)TOK * AW : (bf16_t*)(ws + WS_OA2));
                u.O = ob + (size_t)b * SEQ * AW + h * 128; u.ldo = AW;
                u.lse = (float*)(ws + WS_LSE) + ((size_t)pat * TOK + (size_t)b * SEQ) * 12 + h; u.cs = nullptr; u.relb = relbp + h; u.hh = h;
                u.O8 = (unsigned char*)ob + (size_t)b * SEQ * AW + h * 128; u.sc = (float*)(ws + WS_OA2 + 32 * MiB) + ((size_t)pat * TOK + (size_t)b * SEQ) * 12 + h;
                u.v0 = vb * 256; u.Ls = pat == 0 ? 11 : (pat == 1 ? 9 : 7); u.Lm = (1 << u.Ls) - 1; u.dil = pat == 0 ? 1 : (pat == 1 ? 4 : 16);
                if (pat == 2) { u.kb0 = u.v0; u.NT = 2; } else { u.kb0 = u.v0 - 128; u.NT = 4; }
              };
              if (ATT_MASK & 4) att::attn_a2_stream(al, 9, genA, relbp, wave0_);
              if (ATT_DUP & 4) att::attn_a2_stream(al, 9, genA, relbp, wave0_); }
        }
        if (BOTH(2)) xcd_barrier_arrive(bar, wave0_);
    }

    if (IN(3)) {
        const KArgP args = fresh_args(); unsigned char* ws = args->ws;
        if (bx >= 128 && bx < 256) {
            const int tid = opaque_tid(), lane = tid & 63, wave = __builtin_amdgcn_readfirstlane(tid >> 6);
            LAS float* scr = (LAS float*)(lds + wave * 16384);
            TR_STREAM((bx - 128) * 8 + wave, 5632, 1024, map_p3);
            __syncthreads();
        }
        EpiZG E; E.ws = ws; E.oa0 = (const bf16_t*)args->out; E.oa1 = (const bf16_t*)args->out + (size_t)TOK * AW; E.bgate = args->in[6]; E.wb = bar; E.lazy = BOTH(2);
        pg8::Gemm g{(const bf16_t*)(ws + WS_H), (const bf16_t*)(ws + WS_WT2), DM, DM}; pg8::StaticOrder S; S.init(TOK, N2, DM, G, bx, P3_ROT * (bx & 7));
        pg8::gemm_phase<EpiZG, pg8::StaticOrder>(lds, g, S, E, wave0_);
        if (BOTH(3)) GRID_BAR();
    }

    if (IN(4)) {
        const KArgP args = fresh_args(); unsigned char* ws = args->ws;
        EpiMerge E; E.ws = ws;
        pg8::Gemm g{(const bf16_t*)(ws + WS_Y), (const bf16_t*)(ws + WS_WTP), KP, KP}; pg8::Sub3Order S; S.init(TOK, DM, G, bx, bx & 7);
        pg8::gemm_phase<EpiMerge, pg8::Sub3Order>(lds, g, S, E, wave0_);
        if (BOTH(4)) xcd_barrier_arrive(bar, wave0_);
    }

    if (IN(5)) {
        const KArgP args = fresh_args(); unsigned char* ws = args->ws; const float* x = args->in[0];
        EpiOut E; E.x = x; E.out = args->out; E.wb = bar; E.lazy = BOTH(4);
        pg8::Gemm g{(const bf16_t*)(ws + WS_MRG), (const bf16_t*)(ws + WS_WTO), DM, DM}; pg8::StaticOrder S; S.init(TOK, DM, DM, G, bx);
        pg8::gemm_phase<EpiOut, pg8::StaticOrder>(lds, g, S, E, wave0_);
    }
#undef IN
#undef BOTH
#undef GRID_BAR
}

extern "C" void kernel_launch(void* const* d_in, const int* in_sizes, int n_in, void* d_out, int out_size, void* d_ws, size_t ws_size, hipStream_t stream) {
    static int grid = 0;
    if (grid == 0) {
        if (n_in != 19 || in_sizes[0] != TOK * DM || out_size != TOK * DM || ws_size < WS_END) {
            fprintf(stderr, "kernel_launch: shape/workspace mismatch (n_in %d, in0 %d, out %d, ws %zu, need %zu)\n", n_in, n_in > 0 ? in_sizes[0] : -1, out_size, ws_size, (size_t)WS_END); grid = -1; return; }
        int dev = 0, cus = 0;
        if (hipGetDevice(&dev) != hipSuccess || hipDeviceGetAttribute(&cus, hipDeviceAttributeMultiprocessorCount, dev) != hipSuccess) { grid = -1; return; }
        if (hipFuncSetAttribute((const void*)fwd_kernel, hipFuncAttributeMaxDynamicSharedMemorySize, LDS_BYTES) != hipSuccess) { fprintf(stderr, "kernel_launch: hipFuncSetAttribute failed\n"); grid = -1; return; }
        (void)hipGetLastError();
        grid = cus;
    }
    if (grid < 0) return;
    (void)hipMemsetAsync((char*)d_ws + WS_CTL, 0, CTL_ZERO_BYTES, stream);
    Args a{};
    for (int i = 0; i < 19; ++i) a.in[i] = (const float*)d_in[i];
    a.out = (float*)d_out; a.ws = (unsigned char*)d_ws;
#if MK_N_LAUNCHES == 1
    a.ph_lo = 0; a.ph_hi = 6;
    hipLaunchKernelGGL(fwd_kernel, dim3(grid), dim3(512), LDS_BYTES, stream, a);
#else
    for (int p = 0; p < 6; ++p) { a.ph_lo = p; a.ph_hi = p + 1; hipLaunchKernelGGL(fwd_kernel, dim3(grid), dim3(512), LDS_BYTES, stream, a);
#if defined(DUP_PHASE)
        if (p == DUP_PHASE) hipLaunchKernelGGL(fwd_kernel, dim3(grid), dim3(512), LDS_BYTES, stream, a);
#endif
    }
#endif
    const hipError_t le = hipPeekAtLastError();
    if (le != hipSuccess) fprintf(stderr, "kernel_launch: launch failed: %s\n", hipGetErrorName(le));
}
```
